# Optimizing an MI355X kernel written in HIP

```python
import jax
import jax.numpy as jnp
from jax import lax
import numpy as np

D_MODEL = 2048
BATCH = 4
SEQ = 4096
DEPTH = 4

GRID_W = 64
CTX_LEN = 256
N_MIXERS = 4
FFN_HIDDEN = ((8 * D_MODEL + 3 * 256 - 1) // (3 * 256)) * 256
RET_DK = 256
RET_DV = 512
RET_HEADS = D_MODEL // RET_DK
RET_CHUNK = 128
GQA_HEAD_DIM = 128
GQA_HEADS = D_MODEL // GQA_HEAD_DIM
GQA_KV_HEADS = GQA_HEADS // 4
MLA_HEADS = D_MODEL // 128
MLA_Q_RANK = 512
MLA_KV_RANK = 512
MLA_NOPE = 128
MLA_ROPE = 64
MLA_V = 128
HGRN_DIM = 128
HGRN_HEADS = D_MODEL // HGRN_DIM
HGRN_CHUNK = 64

ATTN_BLOCK = 128
ROPE_THETA = 10000.0
EPS = 1e-6
DEEPNORM_ALPHA = (2 * DEPTH) ** 0.25
DEEPNORM_BETA = (8 * DEPTH) ** -0.25
F32 = jnp.float32

kernel_name = "hybrid_retention_gqa_mla_hgrn2_diffusion_trunk"


def layer_norm(x, g, b):
    xf = x.astype(F32)
    xc = xf - jnp.mean(xf, -1, keepdims=True)
    var = jnp.mean(xc * xc, -1, keepdims=True)
    return (xc * lax.rsqrt(var + EPS) * g.astype(F32) + b.astype(F32)).astype(x.dtype)


def rms_norm(x, g=None):
    xf = x.astype(F32)
    y = xf * lax.rsqrt(jnp.mean(xf * xf, -1, keepdims=True) + EPS)
    if g is not None:
        y = y * g.astype(F32)
    return y.astype(x.dtype)


def rope_1d(x, ang):
    cos = jnp.cos(ang)[:, None, :]
    sin = jnp.sin(ang)[:, None, :]
    x1, x2 = jnp.split(x.astype(F32), 2, axis=-1)
    return jnp.concatenate([x1 * cos - x2 * sin, x1 * sin + x2 * cos], -1).astype(x.dtype)


def rope_2d(x, row, col):
    half = x.shape[-1] // 2
    freqs = ROPE_THETA ** (-jnp.arange(0, half, 2, dtype=F32) / half)
    a_row = row.astype(F32)[:, None] * freqs
    a_col = col.astype(F32)[:, None] * freqs
    return jnp.concatenate([rope_1d(x[..., :half], a_row), rope_1d(x[..., half:], a_col)], -1)


def modulate(z, shift, scale):
    return z * (1.0 + scale) + shift


def swiglu(z, w_in, w_out):
    a, b = jnp.split(z @ w_in, 2, axis=-1)
    return (jax.nn.silu(a) * b) @ w_out


def attention(q, k, v, scale):
    s = jnp.einsum('bqhgd,bkhd->bhgqk', q, k).astype(F32) * scale
    p = jax.nn.softmax(s, axis=-1).astype(v.dtype)
    return jnp.einsum('bhgqk,bkhv->bqhgv', p, v)


def blocked_attention(q, k, v, scale):
    B, L = q.shape[:2]
    qb = jnp.moveaxis(q.reshape((B, L // ATTN_BLOCK, ATTN_BLOCK) + q.shape[2:]), 1, 0)
    out = lax.map(lambda blk: attention(blk, k, v, scale), qb)
    out = jnp.moveaxis(out, 0, 1)
    return out.reshape((B, L) + out.shape[3:])


def flip_t(t):
    return jnp.flip(t, axis=2)


def retention_scan(q, k, v, log_gamma, state):
    B, H, L, _ = q.shape
    dv = v.shape[-1]
    C = RET_CHUNK
    lg = log_gamma.astype(F32)
    pos = jnp.arange(C, dtype=F32)
    diff = pos[:, None] - pos[None, :]
    decay_mask = jnp.where(diff >= 0, jnp.exp(jnp.maximum(diff, 0.0) * lg[:, None, None]), 0.0)
    q_decay = jnp.exp((pos + 1.0) * lg[:, None])[..., None]
    k_decay = jnp.exp((C - 1.0 - pos) * lg[:, None])[..., None]
    chunk_decay = jnp.exp(C * lg)[:, None, None]

    def to_chunks(t):
        return jnp.moveaxis(t.astype(F32).reshape(B, H, L // C, C, t.shape[-1]), 2, 0)

    def step(S, xs):
        qc, kc, vc = xs
        scores = jnp.einsum('bhcd,bhsd->bhcs', qc, kc) * decay_mask
        o = jnp.einsum('bhcs,bhsv->bhcv', scores, vc) + jnp.einsum('bhcd,bhdv->bhcv', qc * q_decay, S)
        S = S * chunk_decay + jnp.einsum('bhsd,bhsv->bhdv', kc * k_decay, vc)
        return S, o

    S, o = lax.scan(step, state, (to_chunks(q), to_chunks(k), to_chunks(v)))
    return jnp.moveaxis(o, 0, 2).reshape(B, H, L, dv), S


def gla_scan(q, k, v, log_f, state):
    B, H, L, _ = q.shape
    dv = v.shape[-1]
    C = HGRN_CHUNK
    tri = jnp.arange(C)[:, None] >= jnp.arange(C)[None, :]

    def to_chunks(t):
        return jnp.moveaxis(t.reshape(B, H, L // C, C, t.shape[-1]), 2, 0)

    def step(S, xs):
        qc, kc, vc, gc = xs
        b = jnp.cumsum(gc, axis=-2)
        b_last = b[..., -1:, :]
        q_in = qc * jnp.exp(b)
        scores = jnp.where(tri, jnp.einsum('bhcd,bhsd->bhcs', q_in, kc * jnp.exp(-b)), 0.0)
        o = jnp.einsum('bhcd,bhdv->bhcv', q_in, S) + jnp.einsum('bhcs,bhsv->bhcv', scores, vc)
        S = S * jnp.exp(b_last)[..., 0, :, None] + jnp.einsum('bhsd,bhsv->bhdv', kc * jnp.exp(b_last - b), vc)
        return S, o

    S, o = lax.scan(step, state, (to_chunks(q), to_chunks(k), to_chunks(v), to_chunks(log_f)))
    return jnp.moveaxis(o, 0, 2).reshape(B, H, L, dv), S


def retention_mixer(h, hc, w_in, lg_fwd, lg_bwd, w_out, row, col, need_ctx):
    B = h.shape[0]
    hk, hv = RET_HEADS * RET_DK, RET_HEADS * RET_DV

    def project(z, rotate):
        L = z.shape[1]
        q, k, v, g = jnp.split(z @ w_in, [hk, 2 * hk, 2 * hk + hv], axis=-1)
        q = q.reshape(B, L, RET_HEADS, RET_DK)
        k = k.reshape(B, L, RET_HEADS, RET_DK)
        v = v.reshape(B, L, RET_HEADS, RET_DV)
        if rotate:
            q = rope_2d(q, row, col)
            k = rope_2d(k, row, col)
        heads = lambda t: jnp.swapaxes(t, 1, 2).astype(F32)
        return heads(q), heads(k) * RET_DK ** -0.5, heads(v), g

    def bidir(q, k, v, s_f, s_b):
        o_f, s_f = retention_scan(q, k, v, lg_fwd, s_f)
        o_b, s_b = retention_scan(flip_t(q), flip_t(k), flip_t(v), lg_bwd, s_b)
        return o_f + flip_t(o_b), s_f, s_b

    def readout(o, g):
        o = rms_norm(jnp.swapaxes(o, 1, 2))
        o = o.reshape(B, o.shape[1], hv).astype(g.dtype) * jax.nn.silu(g)
        return o @ w_out

    qc, kc, vc, gc = project(hc, False)
    q, k, v, g = project(h, True)
    zero = jnp.zeros((B, RET_HEADS, RET_DK, RET_DV), F32)
    oc, s_f, s_b = bidir(qc, kc, vc, zero, zero)
    o, _, _ = bidir(q, k, v, s_f, s_b)
    y = readout(o, g)
    yc = readout(oc, gc) if need_ctx else None
    return y, yc


def gqa_mixer(h, hc, w_in, q_gain, k_gain, w_out, row, col, need_ctx):
    B = h.shape[0]
    d = GQA_HEAD_DIM
    G = GQA_HEADS // GQA_KV_HEADS
    scale = d ** -0.5

    def project(z, rotate):
        L = z.shape[1]
        q, k, v = jnp.split(z @ w_in, [GQA_HEADS * d, (GQA_HEADS + GQA_KV_HEADS) * d], axis=-1)
        q = rms_norm(q.reshape(B, L, GQA_HEADS, d), q_gain)
        k = rms_norm(k.reshape(B, L, GQA_KV_HEADS, d), k_gain)
        v = v.reshape(B, L, GQA_KV_HEADS, d)
        if rotate:
            q = rope_2d(q, row, col)
            k = rope_2d(k, row, col)
        return q.reshape(B, L, GQA_KV_HEADS, G, d), k, v

    qc, kc, vc = project(hc, False)
    q, k, v = project(h, True)
    k_all = jnp.concatenate([kc, k], axis=1)
    v_all = jnp.concatenate([vc, v], axis=1)
    o = blocked_attention(q, k_all, v_all, scale)
    y = o.reshape(B, o.shape[1], GQA_HEADS * d) @ w_out
    yc = None
    if need_ctx:
        oc = attention(qc, kc, vc, scale)
        yc = oc.reshape(B, oc.shape[1], GQA_HEADS * d) @ w_out
    return y, yc


def mla_mixer(h, hc, w_in, q_norm, w_q_up, kv_norm, w_kv_up, w_out, row, col, need_ctx):
    B = h.shape[0]
    H = MLA_HEADS
    scale = (MLA_NOPE + MLA_ROPE) ** -0.5

    def project(z, rotate):
        L = z.shape[1]
        cq, ckv, k_rope = jnp.split(z @ w_in, [MLA_Q_RANK, MLA_Q_RANK + MLA_KV_RANK], axis=-1)
        q = (rms_norm(cq, q_norm) @ w_q_up).reshape(B, L, H, MLA_NOPE + MLA_ROPE)
        kv = (rms_norm(ckv, kv_norm) @ w_kv_up).reshape(B, L, H, MLA_NOPE + MLA_V)
        q_nope, q_rope = jnp.split(q, [MLA_NOPE], axis=-1)
        k_nope, v = jnp.split(kv, [MLA_NOPE], axis=-1)
        k_rope = k_rope[:, :, None, :]
        if rotate:
            q_rope = rope_2d(q_rope, row, col)
            k_rope = rope_2d(k_rope, row, col)
        q = jnp.concatenate([q_nope, q_rope], -1)[:, :, :, None, :]
        k = jnp.concatenate([k_nope, jnp.broadcast_to(k_rope, (B, L, H, MLA_ROPE))], -1)
        return q, k, v

    qc, kc, vc = project(hc, False)
    q, k, v = project(h, True)
    k_all = jnp.concatenate([kc, k], axis=1)
    v_all = jnp.concatenate([vc, v], axis=1)
    o = blocked_attention(q, k_all, v_all, scale)
    y = o.reshape(B, o.shape[1], H * MLA_V) @ w_out
    yc = None
    if need_ctx:
        oc = attention(qc, kc, vc, scale)
        yc = oc.reshape(B, oc.shape[1], H * MLA_V) @ w_out
    return y, yc


def hgrn2_mixer(h, hc, w_in, lower_bound, out_gain, w_out, need_ctx):
    B = h.shape[0]
    H, d = HGRN_HEADS, HGRN_DIM
    width = H * d
    lb = lower_bound.astype(F32).reshape(H, 1, d)

    def heads(t):
        return jnp.swapaxes(t.reshape(B, t.shape[1], H, d), 1, 2).astype(F32)

    def forget(fp):
        f = lb + (1.0 - lb) * jax.nn.sigmoid(heads(fp))
        return 1.0 - f, jnp.log(f)

    def project(z):
        q, f_f, f_b, i, g = jnp.split(z @ w_in, 5, axis=-1)
        k_f, lf_f = forget(f_f)
        k_b, lf_b = forget(f_b)
        return jax.nn.silu(heads(q)), heads(i), k_f, lf_f, k_b, lf_b, g

    def bidir(q, i, k_f, lf_f, k_b, lf_b, s_f, s_b):
        o_f, s_f = gla_scan(q, k_f, i, lf_f, s_f)
        o_b, s_b = gla_scan(flip_t(q), flip_t(k_b), flip_t(i), flip_t(lf_b), s_b)
        return o_f + flip_t(o_b), s_f, s_b

    def readout(o, g):
        o = rms_norm(jnp.swapaxes(o, 1, 2), out_gain).reshape(B, o.shape[2], width)
        return (o.astype(g.dtype) * jax.nn.silu(g)) @ w_out

    qc, ic, kfc, lfc, kbc, lbc, gc = project(hc)
    q, i, k_f, lf_f, k_b, lf_b, g = project(h)
    zero = jnp.zeros((B, H, d, d), F32)
    oc, s_f, s_b = bidir(qc, ic, kfc, lfc, kbc, lbc, zero, zero)
    o, _, _ = bidir(q, i, k_f, lf_f, k_b, lf_b, s_f, s_b)
    y = readout(o, g)
    yc = readout(oc, gc) if need_ctx else None
    return y, yc


def setup_inputs(seed: int = 0) -> dict:
    key = jax.random.key(seed)
    ks = jax.random.split(key, 32)
    counter = iter(range(32))
    D = D_MODEL

    def normal(shape, scale):
        return jax.random.normal(ks[next(counter)], shape, F32) * scale

    def n_of(m):
        return len(range(m, DEPTH, N_MIXERS))

    nR, nG, nM, nH = n_of(0), n_of(1), n_of(2), n_of(3)
    ret_base = jnp.log(1.0 - 2.0 ** (-5.0 - jnp.arange(RET_HEADS, dtype=F32)))
    ret_in = 2 * RET_HEADS * RET_DK + 2 * RET_HEADS * RET_DV
    gqa_in = (GQA_HEADS + 2 * GQA_KV_HEADS) * GQA_HEAD_DIM
    mla_in = MLA_Q_RANK + MLA_KV_RANK + MLA_ROPE
    hgrn_w = HGRN_HEADS * HGRN_DIM
    return {
        "x": normal((BATCH, SEQ, D), 1.0),
        "c": normal((BATCH, D), 1.0),
        "ctx": normal((BATCH, CTX_LEN, D), 1.0),
        "c_ctx": normal((D,), 1.0),
        "ada_w": normal((DEPTH, D, 6 * D), 0.5 * D ** -0.5),
        "ada_b": normal((DEPTH, 6 * D), 0.01),
        "ln_g": 1.0 + normal((DEPTH, 2, D), 0.02),
        "ln_b": normal((DEPTH, 2, D), 0.01),
        "ffn_w_in": normal((DEPTH, D, 2 * FFN_HIDDEN), D ** -0.5),
        "ffn_w_out": normal((DEPTH, FFN_HIDDEN, D), DEEPNORM_BETA * FFN_HIDDEN ** -0.5),
        "ret_w_in": normal((nR, D, ret_in), D ** -0.5),
        "ret_decay_fwd": ret_base[None] * (1.0 + normal((nR, RET_HEADS), 0.05)),
        "ret_decay_bwd": ret_base[None] * (1.0 + normal((nR, RET_HEADS), 0.05)),
        "ret_w_out": normal((nR, RET_HEADS * RET_DV, D), DEEPNORM_BETA * (RET_HEADS * RET_DV) ** -0.5),
        "gqa_w_in": normal((nG, D, gqa_in), D ** -0.5),
        "gqa_q_norm": 1.0 + normal((nG, GQA_HEAD_DIM), 0.02),
        "gqa_k_norm": 1.0 + normal((nG, GQA_HEAD_DIM), 0.02),
        "gqa_w_out": normal((nG, GQA_HEADS * GQA_HEAD_DIM, D), DEEPNORM_BETA * (GQA_HEADS * GQA_HEAD_DIM) ** -0.5),
        "mla_w_in": normal((nM, D, mla_in), D ** -0.5),
        "mla_q_norm": 1.0 + normal((nM, MLA_Q_RANK), 0.02),
        "mla_w_q_up": normal((nM, MLA_Q_RANK, MLA_HEADS * (MLA_NOPE + MLA_ROPE)), MLA_Q_RANK ** -0.5),
        "mla_kv_norm": 1.0 + normal((nM, MLA_KV_RANK), 0.02),
        "mla_w_kv_up": normal((nM, MLA_KV_RANK, MLA_HEADS * (MLA_NOPE + MLA_V)), MLA_KV_RANK ** -0.5),
        "mla_w_out": normal((nM, MLA_HEADS * MLA_V, D), DEEPNORM_BETA * (MLA_HEADS * MLA_V) ** -0.5),
        "hgrn_w_in": normal((nH, D, 5 * hgrn_w), D ** -0.5),
        "hgrn_lb_raw": normal((DEPTH, hgrn_w), 0.1),
        "hgrn_out_norm": 1.0 + normal((nH, HGRN_DIM), 0.02),
        "hgrn_w_out": normal((nH, hgrn_w, D), DEEPNORM_BETA * hgrn_w ** -0.5),
    }


def reference(x, c, ctx, c_ctx, ada_w, ada_b, ln_g, ln_b, ffn_w_in, ffn_w_out,
              ret_w_in, ret_decay_fwd, ret_decay_bwd, ret_w_out,
              gqa_w_in, gqa_q_norm, gqa_k_norm, gqa_w_out,
              mla_w_in, mla_q_norm, mla_w_q_up, mla_kv_norm, mla_w_kv_up, mla_w_out,
              hgrn_w_in, hgrn_lb_raw, hgrn_out_norm, hgrn_w_out):
    rows = x.shape[1] // GRID_W
    row = jnp.repeat(jnp.arange(rows), GRID_W)
    col = jnp.tile(jnp.arange(GRID_W), rows)
    p = jax.nn.softmax(hgrn_lb_raw.astype(F32), axis=0)
    lower_bounds = jnp.cumsum(p, axis=0) - p[0]

    for i in range(DEPTH):
        m, j = i % N_MIXERS, i // N_MIXERS
        need_ctx = i < DEPTH - 1
        sh1, sc1, g1, sh2, sc2, g2 = jnp.split(jax.nn.silu(c) @ ada_w[i] + ada_b[i], 6, axis=-1)
        csh1, csc1, cg1, csh2, csc2, cg2 = jnp.split(jax.nn.silu(c_ctx) @ ada_w[i] + ada_b[i], 6, axis=-1)
        h = modulate(x, sh1[:, None], sc1[:, None])
        hc = modulate(ctx, csh1, csc1)
        if m == 0:
            y, yc = retention_mixer(h, hc, ret_w_in[j], ret_decay_fwd[j], ret_decay_bwd[j], ret_w_out[j],
                                    row, col, need_ctx)
        elif m == 1:
            y, yc = gqa_mixer(h, hc, gqa_w_in[j], gqa_q_norm[j], gqa_k_norm[j], gqa_w_out[j],
                              row, col, need_ctx)
        elif m == 2:
            y, yc = mla_mixer(h, hc, mla_w_in[j], mla_q_norm[j], mla_w_q_up[j], mla_kv_norm[j],
                              mla_w_kv_up[j], mla_w_out[j], row, col, need_ctx)
        else:
            y, yc = hgrn2_mixer(h, hc, hgrn_w_in[j], lower_bounds[i], hgrn_out_norm[j], hgrn_w_out[j], need_ctx)
        x = layer_norm(DEEPNORM_ALPHA * x + g1[:, None] * y, ln_g[i, 0], ln_b[i, 0])
        h = modulate(x, sh2[:, None], sc2[:, None])
        x = layer_norm(DEEPNORM_ALPHA * x + g2[:, None] * swiglu(h, ffn_w_in[i], ffn_w_out[i]), ln_g[i, 1], ln_b[i, 1])
        if need_ctx:
            ctx = layer_norm(DEEPNORM_ALPHA * ctx + cg1 * yc, ln_g[i, 0], ln_b[i, 0])
            hc = modulate(ctx, csh2, csc2)
            ctx = layer_norm(DEEPNORM_ALPHA * ctx + cg2 * swiglu(hc, ffn_w_in[i], ffn_w_out[i]), ln_g[i, 1], ln_b[i, 1])
    return x
```

```cpp
#include <hip/hip_runtime.h>
#include <hip/hip_bf16.h>
#include <cstdio>
#include <cstdint>
namespace pg8 {
#define PG8_LAS __attribute__((address_space(3)))
typedef unsigned short bf16_t;
typedef short bf16x8 __attribute__((ext_vector_type(8)));
typedef float f32x4 __attribute__((ext_vector_type(4)));
typedef unsigned u32x4 __attribute__((ext_vector_type(4)));
constexpr int BM = 256, BK = 64, HALF = 128, HTB = HALF * BK * 2  , STAGE_BYTES = 8 * HTB, NXCD = 8, WGM = 8;

__host__ __device__ __forceinline__ int lds_byte(int r, int c) { const int st = (r >> 4) * 2 + (c >> 5), rr = r & 15, cc = c & 31, ob = rr * 64 + cc * 2; return st * 1024 + (ob ^ (((ob >> 9) & 1) << 5)); }
__host__ __device__ __forceinline__ void stage_rc(int b, int& R, int& C) { const int st = b / 1024, sb = b % 1024, swz = sb ^ (((sb >> 9) & 1) << 5); R = (st >> 1) * 16 + swz / 64; C = (st & 1) * 32 + (swz % 64) / 2; }
__host__ __device__ __forceinline__ int perm32(int rho) { const int n = rho >> 4, i = rho & 15; return 8 * (i >> 2) + 4 * n + (i & 3); }

struct Unit { int pm, pn; };
struct Gemm { const bf16_t* A; const bf16_t* Bt; int M, N, K; };

struct StaticOrder {
    int nM, nN, nwg, G, c;
    __host__ __device__ void init(int M, int N, int G_, int c_) { nM = M / BM; nN = N / BM; nwg = nM * nN; G = G_; c = c_; }
    __host__ __device__ bool next(int i, Unit& u) const {
        const long L = (long)i * G + c; if (L >= nwg) return false;
        int wgid = (int)L; { const int q = nwg / NXCD, r = nwg % NXCD, xcd = wgid % NXCD, off = wgid / NXCD; wgid = (xcd < r ? xcd * (q + 1) : r * (q + 1) + (xcd - r) * q) + off; }
        const int nig = WGM * nN, gid = wgid / nig, fm = gid * WGM, gsz = (nM - fm) < WGM ? (nM - fm) : WGM;
        u.pm = fm + ((wgid % nig) % gsz); u.pn = (wgid % nig) / gsz; return true;
    }
    __device__ __forceinline__ void a_ready(const Unit&) const {}
    __device__ __forceinline__ void done(const Unit&) const {}
};

__device__ __forceinline__ unsigned cvt_pk_bf16(float lo, float hi) { unsigned r; asm volatile("v_cvt_pk_bf16_f32 %0, %1, %2" : "=v"(r) : "v"(lo), "v"(hi)); return r; }
struct EpiBf16P {
    static constexpr bool PERM = true, AFTER_DRAIN = false;
    bf16_t* O; int ldc;
    __device__ __forceinline__ void operator()(const f32x4 (&acc)[2][2][4][2], const Unit& u, int wr, int wc, int fr, int fq) const {
        const int row0 = u.pm * BM + wr * 64 + fr, col0 = u.pn * BM + wc * 32 + 8 * fq;
#pragma unroll
        for (int ai = 0; ai < 2; ++ai)
#pragma unroll
            for (int m = 0; m < 4; ++m) { bf16_t* rowp = O + (size_t)(row0 + ai * HALF + m * 16) * ldc + col0;
#pragma unroll
                for (int bj = 0; bj < 2; ++bj) { const f32x4 v0 = acc[ai][bj][m][0], v1 = acc[ai][bj][m][1];
                    u32x4 w; w.x = cvt_pk_bf16(v0[0], v0[1]); w.y = cvt_pk_bf16(v0[2], v0[3]); w.z = cvt_pk_bf16(v1[0], v1[1]); w.w = cvt_pk_bf16(v1[2], v1[3]);
                    *(u32x4*)(rowp + bj * HALF) = w; } }
    }
};
struct EpiF32P {
    static constexpr bool PERM = false, AFTER_DRAIN = false;
    float* C; int ldc;
    __device__ __forceinline__ void operator()(const f32x4 (&acc)[2][2][4][2], const Unit& u, int wr, int wc, int fr, int fq) const {
        const int row0 = u.pm * BM + wr * 64 + fr, col0 = u.pn * BM + wc * 32 + 4 * fq;
#pragma unroll
        for (int ai = 0; ai < 2; ++ai)
#pragma unroll
            for (int m = 0; m < 4; ++m) { float* rowp = C + (size_t)(row0 + ai * HALF + m * 16) * ldc + col0;
#pragma unroll
                for (int bj = 0; bj < 2; ++bj)
#pragma unroll
                    for (int n = 0; n < 2; ++n) *(f32x4*)(rowp + bj * HALF + n * 16) = acc[ai][bj][m][n]; }
    }
};
__device__ __forceinline__ float silu_mul(float a, float b) { return a * b * __builtin_amdgcn_rcpf(1.0f + __builtin_amdgcn_exp2f(a * -1.4426950408889634f)); }
struct EpiSwiglu {
    static constexpr bool PERM = true, AFTER_DRAIN = false;
    bf16_t* O; int ldc;
    __device__ __forceinline__ void operator()(const f32x4 (&acc)[2][2][4][2], const Unit& u, int wr, int wc, int fr, int fq) const {
        const int row0 = u.pm * BM + wr * 64 + fr, col0 = u.pn * HALF + wc * 32 + 8 * fq;
#pragma unroll
        for (int ai = 0; ai < 2; ++ai)
#pragma unroll
            for (int m = 0; m < 4; ++m) { bf16_t* rowp = O + (size_t)(row0 + ai * HALF + m * 16) * ldc + col0;
                const f32x4 a0 = acc[ai][0][m][0], a1 = acc[ai][0][m][1], b0 = acc[ai][1][m][0], b1 = acc[ai][1][m][1];
                u32x4 w; w.x = cvt_pk_bf16(silu_mul(a0[0], b0[0]), silu_mul(a0[1], b0[1])); w.y = cvt_pk_bf16(silu_mul(a0[2], b0[2]), silu_mul(a0[3], b0[3]));
                w.z = cvt_pk_bf16(silu_mul(a1[0], b1[0]), silu_mul(a1[1], b1[1])); w.w = cvt_pk_bf16(silu_mul(a1[2], b1[2]), silu_mul(a1[3], b1[3]));
                *(u32x4*)rowp = w; }
    }
};

template <class Epi, class Sched, bool ALIGN_EPI = false, bool SP2 = false>
__device__ __forceinline__ void gemm_phase(PG8_LAS unsigned char* lds, const Gemm g, const Sched& S, const Epi& E) {
    const int tid = threadIdx.x, wid = __builtin_amdgcn_readfirstlane(tid >> 6), lane = tid & 63, wr = wid >> 2, wc = wid & 3, fr = lane & 15, fq = lane >> 4;
    const int K = g.K, nt = K / BK;
    unsigned voffA[2], voffB[2];
#pragma unroll
    for (int i = 0; i < 2; ++i) { int R, C; stage_rc(tid * 16 + i * 8192, R, C); const int Rb = Epi::PERM ? ((R & ~31) + perm32(R & 31)) : R;
        voffA[i] = (unsigned)(R * K + C) * 2u; voffB[i] = (unsigned)(Rb * K + C) * 2u; }
    const size_t kstep = (size_t)(BK * 2);
    const size_t hstep = (size_t)HALF * K * 2;
    const size_t tstep = 2 * hstep;
    const unsigned ldsw = (unsigned)wid * 1024u;
    const int aoff = lds_byte(wr * 64 + fr, fq * 8), boff = lds_byte(wc * 32 + fr, fq * 8);
#define PG8_SA(b, h) (((b) * 2 + (h)) * HTB)
#define PG8_SB(b, h) ((4 + (b) * 2 + (h)) * HTB)
#define PG8_STAGE(bufoff, gbase, voff) do { _Pragma("unroll") for (int _i = 0; _i < 2; ++_i) \
        __builtin_amdgcn_global_load_lds((const unsigned*)((const char*)(gbase) + (voff)[_i]), (PG8_LAS unsigned*)(lds + (bufoff) + ldsw + _i * 8192), 16, 0, 0); } while (0)
#define PG8_LDA(dst, b, h) do { _Pragma("unroll") for (int m = 0; m < 4; ++m) _Pragma("unroll") for (int k = 0; k < 2; ++k) dst[m][k] = *(const PG8_LAS bf16x8*)(lds + PG8_SA(b, h) + aoff + m * 2048 + k * 1024); } while (0)
#define PG8_LDB(dst, b, h) do { _Pragma("unroll") for (int n = 0; n < 2; ++n) _Pragma("unroll") for (int k = 0; k < 2; ++k) dst[n][k] = *(const PG8_LAS bf16x8*)(lds + PG8_SB(b, h) + boff + n * 2048 + k * 1024); } while (0)
#define PG8_MMA(ai, bj, At, Bt) do { __builtin_amdgcn_s_setprio(1); _Pragma("unroll") for (int m = 0; m < 4; ++m) _Pragma("unroll") for (int n = 0; n < 2; ++n) _Pragma("unroll") for (int k = 0; k < 2; ++k) \
        acc[ai][bj][m][n] = __builtin_amdgcn_mfma_f32_16x16x32_bf16(Bt[n][k], At[m][k], acc[ai][bj][m][n], 0, 0, 0); __builtin_amdgcn_s_setprio(0); } while (0)
#define PG8_WAIT_V(n) asm volatile("s_waitcnt vmcnt(" #n ")" ::: "memory")
#define PG8_WAIT_L(n) asm volatile("s_waitcnt lgkmcnt(" #n ")" ::: "memory")
#define PG8_BAR __builtin_amdgcn_s_barrier()
#define PG8_SCHED __builtin_amdgcn_sched_barrier(0)
    Unit cur, nxt; int ui = 0;
    if (!S.next(0, cur)) return;
    f32x4 acc[2][2][4][2];
#pragma unroll
    for (int a = 0; a < 2; ++a)
#pragma unroll
        for (int b = 0; b < 2; ++b)
#pragma unroll
            for (int m = 0; m < 4; ++m)
#pragma unroll
                for (int n = 0; n < 2; ++n) acc[a][b][m][n] = (f32x4){0.f, 0.f, 0.f, 0.f};
    bf16x8 At[4][2], B0[2][2], B1[2][2];
    const char* cA = (const char*)g.A + (size_t)cur.pm * tstep; const char* cB = (const char*)g.Bt + (size_t)cur.pn * tstep;
    S.a_ready(cur);
    if constexpr (SP2) {
        PG8_STAGE(PG8_SB(0, 0), cB, voffB); PG8_STAGE(PG8_SB(0, 1), cB + hstep, voffB); PG8_STAGE(PG8_SA(0, 0), cA, voffA); PG8_STAGE(PG8_SA(0, 1), cA + hstep, voffA);
        if (wr == 1) PG8_BAR;
        PG8_WAIT_V(2); PG8_BAR;
        PG8_STAGE(PG8_SB(1, 0), cB + kstep, voffB); PG8_STAGE(PG8_SA(1, 0), cA + kstep, voffA); PG8_STAGE(PG8_SB(1, 1), cB + hstep + kstep, voffB);
        PG8_WAIT_V(6); PG8_BAR;
    } else {
        PG8_STAGE(PG8_SB(0, 0), cB, voffB); PG8_STAGE(PG8_SA(0, 0), cA, voffA); PG8_STAGE(PG8_SB(0, 1), cB + hstep, voffB); PG8_STAGE(PG8_SA(0, 1), cA + hstep, voffA);
        if (wr == 1) PG8_BAR;
        PG8_WAIT_V(4); PG8_BAR;
        PG8_STAGE(PG8_SB(1, 0), cB + kstep, voffB); PG8_STAGE(PG8_SA(1, 0), cA + kstep, voffA); PG8_STAGE(PG8_SB(1, 1), cB + hstep + kstep, voffB);
        PG8_WAIT_V(6); PG8_BAR;
    }
    for (;;) {
        const bool has_next = S.next(ui + 1, nxt);
        const char* nA = has_next ? (const char*)g.A + (size_t)nxt.pm * tstep : cA; const char* nB = has_next ? (const char*)g.Bt + (size_t)nxt.pn * tstep : cB;
        for (int t = 0; t < nt; t += 2) {
            const bool last = (t == nt - 2);
            const char* a1 = cA + (size_t)(t + 1) * kstep;
            const char* a2 = last ? nA : cA + (size_t)(t + 2) * kstep; const char* b2 = last ? nB : cB + (size_t)(t + 2) * kstep;
            const char* a3 = a2 + kstep; const char* b3 = b2 + kstep;
            if (last && has_next) S.a_ready(nxt);
            if constexpr (SP2) {
            PG8_LDB(B0, 0, 0); PG8_LDB(B1, 0, 1); PG8_SCHED; PG8_LDA(At, 0, 0); PG8_STAGE(PG8_SA(1, 1), a1 + hstep, voffA);
            PG8_WAIT_V(8); PG8_WAIT_L(0); PG8_BAR; PG8_MMA(0, 0, At, B0); PG8_MMA(0, 1, At, B1); PG8_BAR; PG8_SCHED;
            PG8_LDA(At, 0, 1); PG8_STAGE(PG8_SB(0, 0), b2, voffB); PG8_STAGE(PG8_SB(0, 1), b2 + hstep, voffB); PG8_STAGE(PG8_SA(0, 0), a2, voffA);
            PG8_WAIT_V(8); PG8_WAIT_L(0); PG8_BAR; PG8_MMA(1, 0, At, B0); PG8_MMA(1, 1, At, B1); PG8_BAR; PG8_SCHED;
            PG8_LDB(B0, 1, 0); PG8_LDB(B1, 1, 1); PG8_SCHED; PG8_LDA(At, 1, 0); PG8_STAGE(PG8_SA(0, 1), a2 + hstep, voffA);
            PG8_WAIT_V(8); PG8_WAIT_L(0); PG8_BAR; PG8_MMA(0, 0, At, B0); PG8_MMA(0, 1, At, B1); PG8_BAR; PG8_SCHED;
            PG8_LDA(At, 1, 1); PG8_STAGE(PG8_SB(1, 0), b3, voffB); PG8_STAGE(PG8_SB(1, 1), b3 + hstep, voffB); PG8_STAGE(PG8_SA(1, 0), a3, voffA);
            PG8_WAIT_V(8); PG8_WAIT_L(0); PG8_BAR; PG8_MMA(1, 0, At, B0); PG8_MMA(1, 1, At, B1); PG8_BAR; PG8_SCHED;
            } else {
            PG8_LDB(B0, 0, 0); PG8_SCHED; PG8_LDA(At, 0, 0); PG8_STAGE(PG8_SA(1, 1), a1 + hstep, voffA);
            PG8_WAIT_L(8); PG8_BAR; PG8_WAIT_L(0); PG8_MMA(0, 0, At, B0); PG8_BAR; PG8_SCHED;
            PG8_LDB(B1, 0, 1); PG8_STAGE(PG8_SB(0, 0), b2, voffB);
            PG8_BAR; PG8_WAIT_L(0); PG8_MMA(0, 1, At, B1); PG8_BAR;
            PG8_LDA(At, 0, 1); PG8_STAGE(PG8_SA(0, 0), a2, voffA);
            PG8_BAR; PG8_WAIT_L(0); PG8_MMA(1, 0, At, B0); PG8_BAR; PG8_SCHED;
            PG8_STAGE(PG8_SB(0, 1), b2 + hstep, voffB);
            PG8_WAIT_V(6); PG8_BAR; PG8_MMA(1, 1, At, B1); PG8_BAR;
            PG8_LDB(B0, 1, 0); PG8_SCHED; PG8_LDA(At, 1, 0); PG8_STAGE(PG8_SA(0, 1), a2 + hstep, voffA);
            PG8_WAIT_L(8); PG8_BAR; PG8_WAIT_L(0); PG8_MMA(0, 0, At, B0); PG8_BAR; PG8_SCHED;
            PG8_LDB(B1, 1, 1); PG8_STAGE(PG8_SB(1, 0), b3, voffB);
            PG8_BAR; PG8_WAIT_L(0); PG8_MMA(0, 1, At, B1); PG8_BAR;
            PG8_LDA(At, 1, 1); PG8_STAGE(PG8_SA(1, 0), a3, voffA);
            PG8_BAR; PG8_WAIT_L(0); PG8_MMA(1, 0, At, B0); PG8_BAR; PG8_SCHED;
            PG8_STAGE(PG8_SB(1, 1), b3 + hstep, voffB);
            PG8_WAIT_V(6); PG8_BAR; PG8_MMA(1, 1, At, B1); PG8_BAR;
            }
        }
        if constexpr (ALIGN_EPI) { if (wr == 0) PG8_BAR; }
        if constexpr (!Epi::AFTER_DRAIN) { E(acc, cur, wr, wc, fr, fq); S.done(cur); }
        if (!has_next) break;
#pragma unroll
        for (int a = 0; a < 2; ++a)
#pragma unroll
            for (int b = 0; b < 2; ++b)
#pragma unroll
                for (int m = 0; m < 4; ++m)
#pragma unroll
                    for (int n = 0; n < 2; ++n) acc[a][b][m][n] = (f32x4){0.f, 0.f, 0.f, 0.f};
        cur = nxt; cA = nA; cB = nB; ++ui;
        if constexpr (ALIGN_EPI) { if (wr == 1) PG8_BAR; }
    }
    PG8_WAIT_V(0);
    if constexpr (!ALIGN_EPI) { if (wr == 0) PG8_BAR; }
    PG8_BAR;
    if constexpr (Epi::AFTER_DRAIN) { E.fused(acc, cur, wr, wc, fr, fq, lds, wid, lane); S.done(cur); }
#undef PG8_SA
#undef PG8_SB
#undef PG8_STAGE
#undef PG8_LDA
#undef PG8_LDB
#undef PG8_MMA
#undef PG8_WAIT_V
#undef PG8_WAIT_L
#undef PG8_BAR
#undef PG8_SCHED
}
}
namespace att {
using bf16x8 = __attribute__((ext_vector_type(8))) short;
using s16x4  = __attribute__((ext_vector_type(4))) short;
using f32x16 = __attribute__((ext_vector_type(16))) float;
using u32x4  = __attribute__((ext_vector_type(4))) unsigned;
typedef unsigned short bf16;
#define ATT_LAS __attribute__((address_space(3)))
constexpr int NW = 8, QBLK = 32, KVBLK = 64;
constexpr int SHM_V = KVBLK * 128 * 2;
#define ATT_SBAR() __builtin_amdgcn_sched_barrier(0)
__device__ __forceinline__ int crow(int r, int hi) { return (r & 3) + 8 * (r >> 2) + 4 * hi; }
__device__ __forceinline__ unsigned cvtpk(float lo, float hi) { unsigned r; asm volatile("v_cvt_pk_bf16_f32 %0, %1, %2" : "=v"(r) : "v"(lo), "v"(hi)); return r; }
__device__ __forceinline__ void partialSM(f32x16& p0, f32x16& p1, float& m_reg, float& mn, float& alpha, float C, float thr_raw) {
  float pmax = p0[0];
#pragma unroll
  for (int r = 1; r < 16; ++r) pmax = fmaxf(pmax, p0[r]);
#pragma unroll
  for (int r = 0; r < 16; ++r) pmax = fmaxf(pmax, p1[r]);
  { auto rr = __builtin_amdgcn_permlane32_swap(__float_as_uint(pmax), __float_as_uint(pmax), false, false);
    pmax = fmaxf(__uint_as_float(rr[0]), __uint_as_float(rr[1])); }
  if (__builtin_expect(__all(pmax - m_reg <= thr_raw), 1)) { mn = m_reg; alpha = 1.f; }
  else { mn = fmaxf(m_reg, pmax); alpha = __builtin_amdgcn_exp2f((m_reg - mn) * C); m_reg = mn; }
  float mnC = -mn * C;
#pragma unroll
  for (int r = 0; r < 16; ++r) p0[r] = fmaf(p0[r], C, mnC);
#pragma unroll
  for (int r = 0; r < 16; ++r) p1[r] = fmaf(p1[r], C, mnC);
#pragma unroll
  for (int r = 0; r < 16; ++r) p0[r] = __builtin_amdgcn_exp2f(p0[r]);
}
__device__ __forceinline__ void finishSM(f32x16& p0, f32x16& p1, float alpha, float& l_reg, bf16x8& pa0, bf16x8& pa1, bf16x8& pa2, bf16x8& pa3) {
#pragma unroll
  for (int r = 0; r < 16; ++r) p1[r] = __builtin_amdgcn_exp2f(p1[r]);
  float ps = 0;
#pragma unroll
  for (int r = 0; r < 16; ++r) ps += p0[r];
#pragma unroll
  for (int r = 0; r < 16; ++r) ps += p1[r];
  { auto rr = __builtin_amdgcn_permlane32_swap(__float_as_uint(ps), __float_as_uint(ps), false, false);
    ps = __uint_as_float(rr[0]) + __uint_as_float(rr[1]); }
  l_reg = l_reg * alpha + ps;
#define ATT_PK4(P, BASE, OUT) do { unsigned a0 = cvtpk(P[BASE + 0], P[BASE + 1]), a1 = cvtpk(P[BASE + 2], P[BASE + 3]);   \
    unsigned b0 = cvtpk(P[BASE + 4], P[BASE + 5]), b1 = cvtpk(P[BASE + 6], P[BASE + 7]);                              \
    auto r0 = __builtin_amdgcn_permlane32_swap(a0, b0, false, false); auto r1 = __builtin_amdgcn_permlane32_swap(a1, b1, false, false); \
    u32x4 w = {r0[0], r1[0], r0[1], r1[1]}; OUT = __builtin_bit_cast(bf16x8, w); } while (0)
  ATT_PK4(p0, 0, pa0); ATT_PK4(p0, 8, pa1); ATT_PK4(p1, 0, pa2); ATT_PK4(p1, 8, pa3);
}
template <int NQK> __device__ __forceinline__ int kswz(int row, int colB) { return row * (32 * NQK) + (colB ^ ((row & 7) << 4)); }
template <int NQK, int NQR> __device__ __forceinline__ void qkt(f32x16& p0, f32x16& p1, ATT_LAS const char* Ks, const bf16x8* qr, ATT_LAS const char* qx, int r32, int hi) {
  p0 = f32x16{}; p1 = f32x16{};
#pragma unroll
  for (int d0 = 0; d0 < NQK; ++d0) { int cb = (d0 * 16 + hi * 8) * 2;
    bf16x8 b0 = *(ATT_LAS const bf16x8*)(Ks + kswz<NQK>(r32, cb));
    bf16x8 b1 = *(ATT_LAS const bf16x8*)(Ks + kswz<NQK>(32 + r32, cb));
    bf16x8 qv; if (d0 < NQR) qv = qr[d0 < NQR ? d0 : 0]; else qv = *(ATT_LAS const bf16x8*)(qx + (d0 - NQR) * 1024);
    p0 = __builtin_amdgcn_mfma_f32_32x32x16_bf16(b0, qv, p0, 0, 0, 0);
    p1 = __builtin_amdgcn_mfma_f32_32x32x16_bf16(b1, qv, p1, 0, 0, 0); }
}
__device__ __forceinline__ int v_st(int k, int c) { const int kk = (k & ~0xC) | ((k & 4) << 1) | ((k & 8) >> 1); return ((kk >> 3) * 4 + (c >> 5)) * 512 + ((kk & 7) * 32 + (c & 31)) * 2; }
__device__ __forceinline__ int v_rd_base(int lane) { return ((lane & 3) << 3) | (((lane >> 2) & 3) << 6) | (((lane >> 4) & 1) << 5) | (((lane >> 5) & 1) << 8); }
constexpr int v_rd_off(int d0, int ks, int half) { return d0 * 512 + ks * 4096 + half * 2048; }
template <int OFF> __device__ __forceinline__ s16x4 tr_read(int vb) {
  s16x4 r; asm volatile("ds_read_b64_tr_b16 %0, %1 offset:%2" : "=&v"(r) : "v"(vb), "i"(OFF) : "memory"); return r;
}
template <int D0> __device__ __forceinline__ void pv_one(f32x16& od, int vb, bf16x8 pa0, bf16x8 pa1, bf16x8 pa2, bf16x8 pa3) {
  const s16x4 l0 = tr_read<v_rd_off(D0, 0, 0)>(vb), h0 = tr_read<v_rd_off(D0, 0, 1)>(vb), l1 = tr_read<v_rd_off(D0, 1, 0)>(vb), h1 = tr_read<v_rd_off(D0, 1, 1)>(vb);
  const s16x4 l2 = tr_read<v_rd_off(D0, 2, 0)>(vb), h2 = tr_read<v_rd_off(D0, 2, 1)>(vb), l3 = tr_read<v_rd_off(D0, 3, 0)>(vb), h3 = tr_read<v_rd_off(D0, 3, 1)>(vb);
  asm volatile("s_waitcnt lgkmcnt(0)" ::: "memory"); ATT_SBAR();
#define ATT_PK(L, H) (bf16x8){L[0], L[1], L[2], L[3], H[0], H[1], H[2], H[3]}
  od = __builtin_amdgcn_mfma_f32_32x32x16_bf16(pa0, ATT_PK(l0, h0), od, 0, 0, 0);
  od = __builtin_amdgcn_mfma_f32_32x32x16_bf16(pa1, ATT_PK(l1, h1), od, 0, 0, 0);
  od = __builtin_amdgcn_mfma_f32_32x32x16_bf16(pa2, ATT_PK(l2, h2), od, 0, 0, 0);
  od = __builtin_amdgcn_mfma_f32_32x32x16_bf16(pa3, ATT_PK(l3, h3), od, 0, 0, 0);
}
__device__ __forceinline__ void pv_d0(f32x16* o, int vb, bf16x8 pa0, bf16x8 pa1, bf16x8 pa2, bf16x8 pa3) {
  pv_one<0>(o[0], vb, pa0, pa1, pa2, pa3); pv_one<1>(o[1], vb, pa0, pa1, pa2, pa3); pv_one<2>(o[2], vb, pa0, pa1, pa2, pa3); pv_one<3>(o[3], vb, pa0, pa1, pa2, pa3);
}
template <int NQK> constexpr int shm_k() { return KVBLK * 32 * NQK; }
template <int NQK, int NQR> constexpr int shm_attn() { return 2 * SHM_V + 2 * shm_k<NQK>() + NW * 64 * 4 + NW * (NQK - NQR) * 1024; }

template <int NQK, int NQR, int SD, int ldq, int ldka, int ldkb, int ldv, int ldo>
__device__ __forceinline__ void attn_unit(const bf16* __restrict__ Qb, const bf16* __restrict__ KA, const bf16* __restrict__ KB,
                                          const bf16* __restrict__ Vh, bf16* __restrict__ Ob, int seq, float C, float thr_raw, ATT_LAS char* lds) {
  constexpr int SHM_K = shm_k<NQK>(), KCH = (2 * NQK * 64) / 512, NLD = KCH + 2;
  const int tid = threadIdx.x, wid = tid >> 6, lane = tid & 63, r32 = lane & 31, hi = lane >> 5;
  ATT_LAS char* V_lds = lds; ATT_LAS char* K_lds = lds + 2 * SHM_V;
  ATT_LAS float* ws = (ATT_LAS float*)(lds + 2 * SHM_V + 2 * SHM_K) + wid * 64; ATT_LAS float* li_l = ws; ATT_LAS float* al_l = ws + 32;
  float m_reg = -1e30f, l_reg = 0; f32x16 o[4] = {}; bf16x8 qr[NQR];
  const bf16* Qw = Qb + (long)(wid * QBLK + r32) * ldq + hi * 8;
  ATT_LAS char* qx = lds + 2 * SHM_V + 2 * SHM_K + NW * 64 * 4 + wid * ((NQK - NQR) * 1024) + lane * 16;
#pragma unroll
  for (int d0 = 0; d0 < NQR; ++d0) qr[d0] = *(const bf16x8*)(Qw + d0 * 16);
#pragma unroll
  for (int d0 = NQR; d0 < NQK; ++d0) *(ATT_LAS bf16x8*)(qx + (d0 - NQR) * 1024) = *(const bf16x8*)(Qw + d0 * 16);
  const int sr = tid >> 4, sc = (tid & 15) * 8, vst0 = v_st(sr, sc), vst1 = v_st(32 + sr, sc);
  const int sr2 = tid >> 3, sc2 = (tid & 7) * 8;
  const int vb0 = (int)(unsigned)(size_t)V_lds + v_rd_base(lane);
  struct { bf16x8 vs0, vs1, ks[KCH]; } sr_[SD];
#define ATT_SLOAD(i, k0) do { sr_[i].vs0 = *(const bf16x8*)(&Vh[(long)((k0) + sr) * ldv + sc]); sr_[i].vs1 = *(const bf16x8*)(&Vh[(long)((k0) + 32 + sr) * ldv + sc]); \
    sr_[i].ks[0] = *(const bf16x8*)(&KA[(long)((k0) + sr) * ldka + sc]); sr_[i].ks[1] = *(const bf16x8*)(&KA[(long)((k0) + 32 + sr) * ldka + sc]); \
    if constexpr (KCH == 3) sr_[i].ks[2] = *(const bf16x8*)(&KB[(long)((k0) + sr2) * ldkb + sc2]); } while (0)
#define ATT_SWRITE(b, i) do { *(ATT_LAS bf16x8*)(V_lds + (b) * SHM_V + vst0) = sr_[i].vs0; *(ATT_LAS bf16x8*)(V_lds + (b) * SHM_V + vst1) = sr_[i].vs1; \
    *(ATT_LAS bf16x8*)(K_lds + (b) * SHM_K + kswz<NQK>(sr, sc * 2)) = sr_[i].ks[0]; *(ATT_LAS bf16x8*)(K_lds + (b) * SHM_K + kswz<NQK>(32 + sr, sc * 2)) = sr_[i].ks[1]; \
    if constexpr (KCH == 3) *(ATT_LAS bf16x8*)(K_lds + (b) * SHM_K + kswz<NQK>(sr2, 256 + sc2 * 2)) = sr_[i].ks[2]; } while (0)
#define ATT_SWAIT() do { if constexpr (SD == 2) { if constexpr (NLD == 4) asm volatile("s_waitcnt vmcnt(4)" ::: "memory"); else asm volatile("s_waitcnt vmcnt(5)" ::: "memory"); } else asm volatile("s_waitcnt vmcnt(0)" ::: "memory"); } while (0)
#define ATT_RESC(a) do { if (__any((a) < 1.f)) { if (hi == 0) al_l[r32] = (a); asm volatile("s_waitcnt lgkmcnt(0)" ::: "memory"); \
    _Pragma("unroll") for (int d = 0; d < 4; ++d) _Pragma("unroll") for (int r = 0; r < 16; ++r) o[d][r] *= al_l[crow(r, hi)]; } } while (0)
  f32x16 pA0, pA1, pB0, pB1; float mnA, mnB, alA, alB; bf16x8 pa0, pa1, pa2, pa3; const int NT = seq / KVBLK;
  constexpr int SE = 0, SO = SD - 1;
  ATT_SLOAD(SE, 0); asm volatile("s_waitcnt vmcnt(0)" ::: "memory"); ATT_SWRITE(0, SE); __syncthreads();
  qkt<NQK, NQR>(pA0, pA1, K_lds, qr, qx, r32, hi); partialSM(pA0, pA1, m_reg, mnA, alA, C, thr_raw);
  ATT_SLOAD(SO, KVBLK); if constexpr (SD == 2) { if (2 < NT) ATT_SLOAD(SE, 2 * KVBLK); }
  ATT_SWAIT(); ATT_SWRITE(1, SO); __syncthreads();
  for (int j = 1; j + 1 < NT; j += 2) {
    ATT_SBAR(); qkt<NQK, NQR>(pB0, pB1, K_lds + SHM_K, qr, qx, r32, hi);
    finishSM(pA0, pA1, alA, l_reg, pa0, pa1, pa2, pa3); ATT_SBAR();
    ATT_SLOAD(SO, (j + SD) * KVBLK); ATT_SBAR();
    pv_d0(o, vb0, pa0, pa1, pa2, pa3); partialSM(pB0, pB1, m_reg, mnB, alB, C, thr_raw);
    __syncthreads(); ATT_SWAIT(); ATT_SWRITE(0, SE);
    ATT_RESC(alB); __syncthreads();
    ATT_SBAR(); qkt<NQK, NQR>(pA0, pA1, K_lds, qr, qx, r32, hi);
    finishSM(pB0, pB1, alB, l_reg, pa0, pa1, pa2, pa3); ATT_SBAR();
    if (SD == 1 || j + 3 < NT) ATT_SLOAD(SE, (j + 1 + SD) * KVBLK); ATT_SBAR();
    pv_d0(o, vb0 + SHM_V, pa0, pa1, pa2, pa3); partialSM(pA0, pA1, m_reg, mnA, alA, C, thr_raw);
    __syncthreads(); ATT_SWAIT(); ATT_SWRITE(1, SO);
    ATT_RESC(alA); __syncthreads();
  }
  ATT_SBAR(); qkt<NQK, NQR>(pB0, pB1, K_lds + SHM_K, qr, qx, r32, hi);
  finishSM(pA0, pA1, alA, l_reg, pa0, pa1, pa2, pa3); ATT_SBAR();
  pv_d0(o, vb0, pa0, pa1, pa2, pa3); partialSM(pB0, pB1, m_reg, mnB, alB, C, thr_raw);
  __syncthreads(); ATT_RESC(alB);
  finishSM(pB0, pB1, alB, l_reg, pa0, pa1, pa2, pa3); ATT_SBAR();
  pv_d0(o, vb0 + SHM_V, pa0, pa1, pa2, pa3);
  if (hi == 0) li_l[r32] = l_reg; asm volatile("s_waitcnt lgkmcnt(0)" ::: "memory");
  float rli[16];
#pragma unroll
  for (int r = 0; r < 16; ++r) rli[r] = __builtin_amdgcn_rcpf(li_l[crow(r, hi)]);
  bf16* Ow = Ob + (long)(wid * QBLK) * ldo;
#pragma unroll
  for (int r = 0; r < 16; ++r) { const int orow = crow(r, hi);
#pragma unroll
    for (int d0 = 0; d0 < 4; ++d0) { const float v = o[d0][r] * rli[r]; const unsigned u = __float_as_uint(v); Ow[(long)orow * ldo + d0 * 32 + r32] = (bf16)((u + 0x7fffu + ((u >> 16) & 1u)) >> 16); } }
  __syncthreads();
#undef ATT_SLOAD
#undef ATT_SWRITE
#undef ATT_SWAIT
#undef ATT_RESC
}
}

#define GAS __attribute__((address_space(1)))
#define LAS __attribute__((address_space(3)))
typedef unsigned short bf16;
typedef unsigned v4u __attribute__((ext_vector_type(4)));
typedef float f32x4 __attribute__((ext_vector_type(4)));
typedef short bf16x8 __attribute__((ext_vector_type(8)));
typedef GAS unsigned gu32;
typedef GAS unsigned long long gu64;
#define RLX_AGENT __ATOMIC_RELAXED, __HIP_MEMORY_SCOPE_AGENT
#define LDS_WAIT() asm volatile("s_waitcnt lgkmcnt(0)" ::: "memory")
#define VM_WAIT() asm volatile("s_waitcnt vmcnt(0)" ::: "memory")
__device__ __forceinline__ unsigned long long rt() { return __builtin_amdgcn_s_memrealtime(); }
__device__ __forceinline__ unsigned f2bf(float f) { unsigned u = __builtin_bit_cast(unsigned, f); return (u + 0x7fffu + ((u >> 16) & 1u)) >> 16; }
__device__ __forceinline__ unsigned pk2(float lo, float hi) { return f2bf(lo) | (f2bf(hi) << 16); }

#define XB_TMO      128
#define XB_XCNT(j)  (256  + 64 * (j))
#define XB_XSUB(j)  (1280 + 64 * (j))
#define XB_XGEN(j)  (2304 + 64 * (j))
#define XB_TOP      3328
#define XB_TOPGEN   3392
#define XCD_BAR_WORDS 3456
#define XB_SPIN_CAP (1u << 18)

__device__ __forceinline__ unsigned xb_ld(unsigned* p)              { return __hip_atomic_load(p, __ATOMIC_RELAXED, __HIP_MEMORY_SCOPE_AGENT); }
__device__ __forceinline__ unsigned xb_add(unsigned* p, unsigned v) { return __hip_atomic_fetch_add(p, v, __ATOMIC_RELAXED, __HIP_MEMORY_SCOPE_AGENT); }
__device__ __forceinline__ unsigned xb_xcc_id() { return (unsigned)__builtin_amdgcn_s_getreg((3 << 11) | 20) & 0xFu; }
#define XB_SPIN(cond, bar) do { unsigned _sp = 0; while (cond) { __builtin_amdgcn_s_sleep(1); \
    if ((++_sp & 255u) == 0u) { if (xb_ld(&(bar)[XB_TMO])) break; if (_sp > XB_SPIN_CAP) { atomicAdd(&(bar)[XB_TMO], 1u); break; } } } } while (0)

struct XcdBarrier {
    unsigned* bar; unsigned x;
    volatile LAS unsigned* st;
};

__device__ __forceinline__ XcdBarrier xcd_barrier_post(unsigned* bar, volatile LAS unsigned* st) {
    XcdBarrier b; b.bar = bar; b.x = xb_xcc_id(); b.st = st;
    if (threadIdx.x == 0) (void)xb_add(&bar[XB_XCNT(b.x)], 1u);
    return b;
}
__device__ __forceinline__ void xcd_barrier_complete(unsigned* bar, unsigned x, unsigned& nloc, unsigned& nx) {
    const unsigned G = gridDim.x * gridDim.y * gridDim.z;
    unsigned sum, cnt, mine, sp = 0u;
    for (;;) {
        sum = 0u; cnt = 0u; mine = 0u;
#pragma unroll
        for (unsigned j = 0; j < 16; ++j) { const unsigned c = xb_ld(&bar[XB_XCNT(j)]); sum += c; cnt += (c > 0u) ? 1u : 0u; mine = (j == x) ? c : mine; }
        if (sum == G) break;
        __builtin_amdgcn_s_sleep(1);
        if ((++sp & 255u) == 0u) { if (xb_ld(&bar[XB_TMO])) break; if (sp > XB_SPIN_CAP) { atomicAdd(&bar[XB_TMO], 1u); break; } }
    }
    nloc = mine > 0u ? mine : 1u; nx = cnt > 0u ? cnt : 1u;
}

__device__ __forceinline__ void xcd_barrier(const XcdBarrier& b) {
    asm volatile("s_waitcnt vmcnt(0)" ::: "memory");
    __syncthreads();
    if (threadIdx.x == 0) {
        unsigned* bar = b.bar;
        __builtin_amdgcn_s_waitcnt(0);
        unsigned nloc = b.st[0], nx = b.st[1];
        if (nloc == 0u) { xcd_barrier_complete(bar, b.x, nloc, nx); b.st[0] = nloc; b.st[1] = nx; }
        const unsigned old = xb_add(&bar[XB_XSUB(b.x)], 1u);
        const unsigned gen = old / nloc;
        if (old + 1u == (gen + 1u) * nloc) {
            __builtin_amdgcn_fence(__ATOMIC_RELEASE, "agent");
            asm volatile("s_waitcnt vmcnt(0)" ::: "memory");
            const unsigned og = xb_add(&bar[XB_TOP], 1u);
            const unsigned tg = og / nx;
            if (og + 1u == (tg + 1u) * nx) xb_add(&bar[XB_TOPGEN], 1u);
            else XB_SPIN(xb_ld(&bar[XB_TOPGEN]) == tg, bar);
            __builtin_amdgcn_fence(__ATOMIC_ACQUIRE, "agent");
            xb_add(&bar[XB_XGEN(b.x)], 1u);
            asm volatile("s_waitcnt vmcnt(0)" ::: "memory");
        } else {
            XB_SPIN(xb_ld(&bar[XB_XGEN(b.x)]) == gen, bar);
            __builtin_amdgcn_fence(__ATOMIC_ACQUIRE, "agent");
            asm volatile("s_waitcnt vmcnt(0)" ::: "memory");
        }
    }
    __syncthreads();
}
constexpr int DM = 2048, NBATCH = 4, SEQ = 4096, CTXL = 256, SROWS = SEQ + CTXL, MROWS = NBATCH * SROWS;
constexpr int FFH = 5632;
constexpr int RET_N = 12288, GQA_N = 3072, MLA_NP = 1280, MLA_NACT = 1088, MLA_QN = 3072, MLA_KVN = 4096, HG_N = 10240;
constexpr float LN_EPS = 1e-6f, DN_ALPHA = 1.681792830507429f;
constexpr int NWAVES = 8;
constexpr size_t MiB = 1u << 20;
constexpr size_t WS_CTL = 0, CTL_ZERO_BYTES = 1 * MiB;
constexpr size_t WS_MODS = 1 * MiB, WS_TAB = 2 * MiB;
constexpr size_t WS_W_RET_IN = 4 * MiB, WS_W_RET_OUT = 52 * MiB, WS_W_GQA_IN = 68 * MiB, WS_W_GQA_OUT = 80 * MiB, WS_W_MLA_IN = 88 * MiB, WS_W_MLA_QUP = 93 * MiB, WS_W_MLA_KVUP = 96 * MiB,
                 WS_W_MLA_OUT = 100 * MiB, WS_W_HG_IN = 108 * MiB, WS_W_HG_OUT = 148 * MiB, WS_W_FFN_IN = 156 * MiB, WS_W_FFN_OUT = 332 * MiB;
constexpr size_t FFN_IN_BYTES = 44 * MiB, FFN_OUT_BYTES = 22 * MiB;
constexpr size_t WS_X = 420 * MiB, WS_R1 = 556 * MiB, WS_PROJ = 692 * MiB, WS_SCY = 1100 * MiB, WS_END = 1372 * MiB;
constexpr size_t PJ_MLA_Q = 0, PJ_MLA_KV = 102 * MiB, PJ_MLA_C = 238 * MiB, PJ_MLA_CQN = 281 * MiB, PJ_MLA_CKVN = 298 * MiB, PJ_MLA_KR = 315 * MiB;
constexpr int CW_BAR = 4096;
constexpr int TAB_R = 0, TAB_G = 64 * 64 * 2, TAB_M = TAB_G + 64 * 32 * 2;
constexpr int LDS_BYTES = 150528, MISC_OFF = LDS_BYTES - 512;

typedef __attribute__((ext_vector_type(4))) unsigned short bf16x4v;
typedef __attribute__((ext_vector_type(2))) unsigned u32x2v;
typedef __attribute__((ext_vector_type(2))) float f32x2v;

__device__ __forceinline__ float bf2f(unsigned short b) { return __uint_as_float(((unsigned)b) << 16); }
__device__ __forceinline__ float bflo(unsigned w) { return __uint_as_float(w << 16); }
__device__ __forceinline__ float bfhi(unsigned w) { return __uint_as_float(w & 0xffff0000u); }
__device__ __forceinline__ float wave_sum(float v) {
#pragma unroll
    for (int o = 1; o < 64; o <<= 1) v += __shfl_xor(v, o);
    return v;
}
__device__ __forceinline__ float silu_f(float x) { return x / (1.0f + __expf(-x)); }
__device__ __forceinline__ float sigmoid_f(float x) { return 1.0f / (1.0f + __expf(-x)); }
__device__ __forceinline__ void unpack8(const v4u w, float* f) { f[0] = bflo(w.x); f[1] = bfhi(w.x); f[2] = bflo(w.y); f[3] = bfhi(w.y); f[4] = bflo(w.z); f[5] = bfhi(w.z); f[6] = bflo(w.w); f[7] = bfhi(w.w); }
__device__ __forceinline__ v4u pack8(const float* f) { v4u w; w.x = pk2(f[0], f[1]); w.y = pk2(f[2], f[3]); w.z = pk2(f[4], f[5]); w.w = pk2(f[6], f[7]); return w; }

struct Args {
    const float *x, *c, *ctx, *c_ctx, *ada_w, *ada_b, *ln_g, *ln_b, *ffn_w_in, *ffn_w_out;
    const float *ret_w_in, *ret_df, *ret_db, *ret_w_out;
    const float *gqa_w_in, *gqa_qn, *gqa_kn, *gqa_w_out;
    const float *mla_w_in, *mla_qn, *mla_w_qup, *mla_kvn, *mla_w_kvup, *mla_w_out;
    const float *hg_w_in, *hg_lb_raw, *hg_on, *hg_w_out;
    float* out; unsigned char* ws; int ph_lo, ph_hi, use_bar, pad;
};

__device__ __forceinline__ void transpose_item(const float* W, int K, int Nact, bf16* WT, int k0, int n0, int act_n0, LAS float* scr, int lane) {
    if (act_n0 >= 0) {
#pragma unroll 8
        for (int i = 0; i < 32; ++i) { const int kk = 2 * i + (lane >> 5); scr[kk * 33 + (lane & 31)] = W[(size_t)(k0 + kk) * Nact + act_n0 + (lane & 31)]; }
    } else {
#pragma unroll 8
        for (int i = 0; i < 32; ++i) { const int kk = 2 * i + (lane >> 5); scr[kk * 33 + (lane & 31)] = 0.f; }
    }
    LDS_WAIT(); asm volatile("" ::: "memory");
    const int c = lane & 7;
#pragma unroll
    for (int j = 0; j < 4; ++j) { const int n = (lane >> 3) + 8 * j; const LAS float* s = scr + (8 * c) * 33 + n;
        v4u o; o.x = pk2(s[0 * 33], s[1 * 33]); o.y = pk2(s[2 * 33], s[3 * 33]); o.z = pk2(s[4 * 33], s[5 * 33]); o.w = pk2(s[6 * 33], s[7 * 33]);
        *(GAS v4u*)(WT + (size_t)(n0 + n) * K + k0 + 8 * c) = o; }
    LDS_WAIT(); asm volatile("" ::: "memory");
}
template <int PERMK> __device__ __forceinline__ void transpose_w(const float* W, int K, int Nact, int Nv, bf16* WT, int item, LAS float* scr, int lane) {
    const int nblk = Nv / 32, kb = item / nblk, nb = item % nblk, n0 = 32 * nb;
    int act = n0;
    if (PERMK == 1) { const int pn = n0 >> 8, rem = n0 & 255; act = (rem >> 7) * FFH + 128 * pn + (rem & 127); }
    if (PERMK == 2) { if (n0 >= Nact) act = -1; }
    transpose_item(W, K, Nact, WT, 64 * kb, n0, act, scr, lane);
}

struct RowInfo { int b, s, ctx, mi, gr, gc; };
__device__ __forceinline__ RowInfo row_info(int r) { RowInfo q; q.b = r / SROWS; q.s = r - q.b * SROWS; q.ctx = q.s < CTXL; q.mi = q.ctx ? 4 : q.b; const int t = q.s - CTXL; q.gr = t >> 6; q.gc = t & 63; return q; }

__device__ __forceinline__ void mods_unit(const Args& a, int l, int cg, LAS float* red, int tid, int lane, int wave) {
    float sreg[5][4];
#pragma unroll
    for (int j = 0; j < 5; ++j)
#pragma unroll
        for (int i = 0; i < 4; ++i) { const int k = 256 * wave + 64 * i + lane; const float cv = (j < 4) ? a.c[j * DM + k] : a.c_ctx[k]; sreg[j][i] = silu_f(cv); }
    f32x4 acc[5];
#pragma unroll
    for (int j = 0; j < 5; ++j) acc[j] = (f32x4){0.f, 0.f, 0.f, 0.f};
    const float* wp = a.ada_w + ((size_t)l * DM + 256 * wave) * 12288 + cg * 256 + 4 * lane;
#pragma unroll
    for (int i = 0; i < 4; ++i) {
#pragma unroll 8
        for (int kk = 0; kk < 64; ++kk) {
            const f32x4 w4 = *(const GAS f32x4*)(wp + (size_t)(64 * i + kk) * 12288);
#pragma unroll
            for (int j = 0; j < 5; ++j) { const float sj = __uint_as_float(__builtin_amdgcn_readlane(__float_as_uint(sreg[j][i]), kk)); acc[j] += sj * w4; }
        }
    }
#pragma unroll
    for (int j = 0; j < 5; ++j) *(LAS f32x4*)(red + (wave * 5 + j) * 256 + 4 * lane) = acc[j];
    __syncthreads();
    for (int o = tid; o < 1280; o += 512) { const int j = o >> 8, col = o & 255; float s = a.ada_b[l * 12288 + cg * 256 + col];
#pragma unroll
        for (int w = 0; w < 8; ++w) s += red[(w * 5 + j) * 256 + col];
        ((float*)(a.ws + WS_MODS))[(size_t)(l * 5 + j) * 12288 + cg * 256 + col] = s; }
    __syncthreads();
}
__device__ __forceinline__ void rope_tables(const Args& a, int gtid, int gthreads) {
    float* tab = (float*)(a.ws + WS_TAB);
    for (int i = gtid; i < 64 * 64 + 64 * 32 + 64 * 16; i += gthreads) {
        int nf, base, idx = i;
        if (idx < 64 * 64) { nf = 64; base = TAB_R; } else if (idx < 64 * 64 + 64 * 32) { idx -= 64 * 64; nf = 32; base = TAB_G; } else { idx -= 64 * 64 + 64 * 32; nf = 16; base = TAB_M; }
        const int pos = idx / nf, j = idx % nf;
        const float freq = powf(10000.0f, -(float)j / (float)nf);
        const float ang = (float)pos * freq;
        tab[base + 2 * idx] = cosf(ang); tab[base + 2 * idx + 1] = sinf(ang);
    }
}
__device__ __forceinline__ void init_rows(const Args& a, int gw, int NGW, int lane) {
    float* X = (float*)(a.ws + WS_X); bf16* H = (bf16*)(a.ws + WS_R1); const float* mods = (const float*)(a.ws + WS_MODS);
    for (int r = gw; r < MROWS; r += NGW) {
        const RowInfo q = row_info(r);
        const float* src = q.ctx ? a.ctx + ((size_t)q.b * CTXL + q.s) * DM : a.x + ((size_t)q.b * SEQ + (q.s - CTXL)) * DM;
        const float* mp = mods + (size_t)(0 * 5 + q.mi) * 12288;
#pragma unroll
        for (int j = 0; j < 8; ++j) { const int c = 4 * lane + 256 * j; const f32x4 v = *(const GAS f32x4*)(src + c);
            *(GAS f32x4*)(X + (size_t)r * DM + c) = v;
            const f32x4 sh = *(const GAS f32x4*)(mp + c), sc = *(const GAS f32x4*)(mp + 2048 + c);
            const f32x4 h = v * (1.0f + sc) + sh; u32x2v w; w.x = pk2(h[0], h[1]); w.y = pk2(h[2], h[3]);
            *(GAS u32x2v*)(H + (size_t)r * DM + c) = w; }
    }
}
__device__ __forceinline__ void ln_rows(const Args& a, int l, int which, int gw, int NGW, int lane) {
    float* X = (float*)(a.ws + WS_X); const float* Y = (const float*)(a.ws + WS_SCY); bf16* H = (bf16*)(a.ws + WS_R1); const float* mods = (const float*)(a.ws + WS_MODS);
    const float* lng = a.ln_g + (size_t)(l * 2 + which) * DM; const float* lnb = a.ln_b + (size_t)(l * 2 + which) * DM;
    const bool last = (l == 3 && which == 1);
    const int gate_i = which ? 5 : 2, nl = which ? l + 1 : l, nsh = which ? 0 : 3, nsc = which ? 1 : 4;
    for (int r = gw; r < MROWS; r += NGW) {
        const RowInfo q = row_info(r);
        const float* gp = mods + (size_t)(l * 5 + q.mi) * 12288 + gate_i * 2048;
        f32x4 z[8]; float s = 0.f;
#pragma unroll
        for (int j = 0; j < 8; ++j) { const int c = 4 * lane + 256 * j; const f32x4 xv = *(const GAS f32x4*)(X + (size_t)r * DM + c), yv = *(const GAS f32x4*)(Y + (size_t)r * DM + c), gv = *(const GAS f32x4*)(gp + c);
            z[j] = DN_ALPHA * xv + gv * yv; s += (z[j][0] + z[j][1]) + (z[j][2] + z[j][3]); }
        const float mean = wave_sum(s) * (1.0f / DM); float s2 = 0.f;
#pragma unroll
        for (int j = 0; j < 8; ++j) { z[j] = z[j] - mean; s2 += (z[j][0] * z[j][0] + z[j][1] * z[j][1]) + (z[j][2] * z[j][2] + z[j][3] * z[j][3]); }
        const float rstd = 1.0f / sqrtf(wave_sum(s2) * (1.0f / DM) + LN_EPS);
        const float* mp = mods + (size_t)((last ? 0 : nl) * 5 + q.mi) * 12288;
#pragma unroll
        for (int j = 0; j < 8; ++j) { const int c = 4 * lane + 256 * j; const f32x4 g4 = *(const GAS f32x4*)(lng + c), b4 = *(const GAS f32x4*)(lnb + c);
            const f32x4 xn = z[j] * rstd * g4 + b4;
            if (last) { if (!q.ctx) *(GAS f32x4*)(a.out + ((size_t)q.b * SEQ + (q.s - CTXL)) * DM + c) = xn; }
            else { *(GAS f32x4*)(X + (size_t)r * DM + c) = xn;
                const f32x4 sh = *(const GAS f32x4*)(mp + nsh * 2048 + c), sc = *(const GAS f32x4*)(mp + nsc * 2048 + c);
                const f32x4 h = xn * (1.0f + sc) + sh; u32x2v w; w.x = pk2(h[0], h[1]); w.y = pk2(h[2], h[3]);
                *(GAS u32x2v*)(H + (size_t)r * DM + c) = w; } }
    }
}
__device__ __forceinline__ void ret_rope_rows(const Args& a, int gw, int NGW, int lane) {
    bf16* P = (bf16*)(a.ws + WS_PROJ); const float* tab = (const float*)(a.ws + WS_TAB) + TAB_R;
    for (int r = gw; r < MROWS; r += NGW) {
        const RowInfo q = row_info(r);
#pragma unroll
        for (int i = 0; i < 4; ++i) { const int it = lane + 64 * i, tensor = it >> 7, head = (it >> 4) & 7, half = (it >> 3) & 1, grp = it & 7;
            bf16* p1 = P + (size_t)r * RET_N + tensor * 2048 + head * 256 + half * 128 + grp * 8; bf16* p2 = p1 + 64;
            if (q.ctx && tensor == 0) continue;
            float x1[8], x2[8]; unpack8(*(const GAS v4u*)p1, x1); unpack8(*(const GAS v4u*)p2, x2);
            const float ksc = tensor ? 0.0625f : 1.0f;
            float o1[8], o2[8];
            if (!q.ctx) { const int pos = half ? q.gc : q.gr; const float* tp = tab + (pos * 64 + grp * 8) * 2;
#pragma unroll
                for (int e = 0; e < 8; ++e) { const float cs = tp[2 * e], sn = tp[2 * e + 1]; o1[e] = (x1[e] * cs - x2[e] * sn) * ksc; o2[e] = (x1[e] * sn + x2[e] * cs) * ksc; } }
            else {
#pragma unroll
                for (int e = 0; e < 8; ++e) { o1[e] = x1[e] * ksc; o2[e] = x2[e] * ksc; } }
            *(GAS v4u*)p1 = pack8(o1); *(GAS v4u*)p2 = pack8(o2); }
    }
}
__device__ __forceinline__ void gqa_normrope_rows(const Args& a, int gw, int NGW, int lane) {
    bf16* P = (bf16*)(a.ws + WS_PROJ); const float* tab = (const float*)(a.ws + WS_TAB) + TAB_G;
    const int li = lane & 15, hsub = lane >> 4;
    const int half = li >> 3, second = (li >> 2) & 1, fj0 = (li & 3) * 8;
    for (int r = gw; r < MROWS; r += NGW) {
        const RowInfo q = row_info(r);
#pragma unroll
        for (int pass = 0; pass < 5; ++pass) { const int head = pass * 4 + hsub;
            bf16* p = P + (size_t)r * GQA_N + head * 128 + li * 8;
            const float* gain = (head < 16 ? a.gqa_qn : a.gqa_kn) + li * 8;
            float x[8]; unpack8(*(const GAS v4u*)p, x);
            float ss = 0.f;
#pragma unroll
            for (int e = 0; e < 8; ++e) ss += x[e] * x[e];
            ss += __shfl_xor(ss, 1); ss += __shfl_xor(ss, 2); ss += __shfl_xor(ss, 4); ss += __shfl_xor(ss, 8);
            const float rs = 1.0f / sqrtf(ss * (1.0f / 128.0f) + LN_EPS);
#pragma unroll
            for (int e = 0; e < 8; ++e) x[e] = x[e] * rs * gain[e];
            float o[8];
            if (!q.ctx) { const int pos = half ? q.gc : q.gr; const float* tp = tab + (pos * 32 + fj0) * 2;
#pragma unroll
                for (int e = 0; e < 8; ++e) { const float other = __shfl_xor(x[e], 4); const float cs = tp[2 * e], sn = tp[2 * e + 1];
                    o[e] = second ? (other * sn + x[e] * cs) : (x[e] * cs - other * sn); } }
            else {
#pragma unroll
                for (int e = 0; e < 8; ++e) o[e] = x[e]; }
            *(GAS v4u*)p = pack8(o); }
    }
}
__device__ __forceinline__ void mla_norm_rows(const Args& a, int gw, int NGW, int lane) {
    const bf16* C = (const bf16*)(a.ws + WS_PROJ + PJ_MLA_C); bf16* CQN = (bf16*)(a.ws + WS_PROJ + PJ_MLA_CQN); bf16* CKVN = (bf16*)(a.ws + WS_PROJ + PJ_MLA_CKVN); bf16* KR = (bf16*)(a.ws + WS_PROJ + PJ_MLA_KR);
    const float* tab = (const float*)(a.ws + WS_TAB) + TAB_M;
    for (int r = gw; r < MROWS; r += NGW) {
        const RowInfo q = row_info(r);
#pragma unroll
        for (int t = 0; t < 2; ++t) { float x[8]; unpack8(*(const GAS v4u*)(C + (size_t)r * MLA_NP + t * 512 + lane * 8), x);
            float ss = 0.f;
#pragma unroll
            for (int e = 0; e < 8; ++e) ss += x[e] * x[e];
            const float rs = 1.0f / sqrtf(wave_sum(ss) * (1.0f / 512.0f) + LN_EPS);
            const float* gain = (t ? a.mla_kvn : a.mla_qn) + lane * 8; float o[8];
#pragma unroll
            for (int e = 0; e < 8; ++e) o[e] = x[e] * rs * gain[e];
            *(GAS v4u*)((t ? CKVN : CQN) + (size_t)r * 512 + lane * 8) = pack8(o); }
        { const float xv = bf2f(C[(size_t)r * MLA_NP + 1024 + lane]); const float other = __shfl_xor(xv, 16);
          float ov = xv;
          if (!q.ctx) { const int half = lane >> 5, second = (lane >> 4) & 1, fj = lane & 15; const int pos = half ? q.gc : q.gr; const float cs = tab[(pos * 16 + fj) * 2], sn = tab[(pos * 16 + fj) * 2 + 1];
              ov = second ? (other * sn + xv * cs) : (xv * cs - other * sn); }
          KR[(size_t)r * 64 + lane] = (bf16)f2bf(ov); }
    }
}
__device__ __forceinline__ void mla_qrope_rows(const Args& a, int gw, int NGW, int lane) {
    bf16* Q = (bf16*)(a.ws + WS_PROJ + PJ_MLA_Q); const float* tab = (const float*)(a.ws + WS_TAB) + TAB_M;
    const int li = lane & 7, hsub = lane >> 3;
    const int half = li >> 2, second = (li >> 1) & 1, fj0 = (li & 1) * 8;
    for (int r = gw; r < MROWS; r += NGW) {
        const RowInfo q = row_info(r);
        if (q.ctx) continue;
#pragma unroll
        for (int pass = 0; pass < 2; ++pass) { const int head = pass * 8 + hsub;
            bf16* p = Q + (size_t)r * MLA_QN + head * 192 + 128 + li * 8;
            float x[8]; unpack8(*(const GAS v4u*)p, x);
            const int pos = half ? q.gc : q.gr; const float* tp = tab + (pos * 16 + fj0) * 2; float o[8];
#pragma unroll
            for (int e = 0; e < 8; ++e) { const float other = __shfl_xor(x[e], 2); const float cs = tp[2 * e], sn = tp[2 * e + 1];
                o[e] = second ? (other * sn + x[e] * cs) : (x[e] * cs - other * sn); }
            *(GAS v4u*)p = pack8(o); }
    }
}
__device__ __forceinline__ void ret_readout_rows(const Args& a, int gw, int NGW, int lane) {
    const bf16* SO = (const bf16*)(a.ws + WS_SCY); const bf16* P = (const bf16*)(a.ws + WS_PROJ); bf16* A2 = (bf16*)(a.ws + WS_R1);
    for (int r = gw; r < MROWS; r += NGW) {
#pragma unroll
        for (int h = 0; h < 8; ++h) { const int c = h * 512 + lane * 8;
            float f[8], b[8], g[8]; unpack8(*(const GAS v4u*)(SO + (size_t)r * 4096 + c), f); unpack8(*(const GAS v4u*)(SO + ((size_t)MROWS + r) * 4096 + c), b);
            unpack8(*(const GAS v4u*)(P + (size_t)r * RET_N + 8192 + c), g);
            float ss = 0.f;
#pragma unroll
            for (int e = 0; e < 8; ++e) { f[e] += b[e]; ss += f[e] * f[e]; }
            const float rs = 1.0f / sqrtf(wave_sum(ss) * (1.0f / 512.0f) + LN_EPS); float o[8];
#pragma unroll
            for (int e = 0; e < 8; ++e) o[e] = f[e] * rs * silu_f(g[e]);
            *(GAS v4u*)(A2 + (size_t)r * 4096 + c) = pack8(o); }
    }
}
__device__ __forceinline__ void hg_readout_rows(const Args& a, int gw, int NGW, int lane) {
    const bf16* SO = (const bf16*)(a.ws + WS_SCY); const bf16* P = (const bf16*)(a.ws + WS_PROJ); bf16* A2 = (bf16*)(a.ws + WS_R1);
    const int li = lane & 15;
    for (int r = gw; r < MROWS; r += NGW) {
#pragma unroll
        for (int pass = 0; pass < 4; ++pass) { const int c = pass * 512 + lane * 8;
            float f[8], b[8], g[8]; unpack8(*(const GAS v4u*)(SO + (size_t)r * 2048 + c), f); unpack8(*(const GAS v4u*)(SO + ((size_t)MROWS + r) * 2048 + c), b);
            unpack8(*(const GAS v4u*)(P + (size_t)r * HG_N + 8192 + c), g);
            float ss = 0.f;
#pragma unroll
            for (int e = 0; e < 8; ++e) { f[e] += b[e]; ss += f[e] * f[e]; }
            ss += __shfl_xor(ss, 1); ss += __shfl_xor(ss, 2); ss += __shfl_xor(ss, 4); ss += __shfl_xor(ss, 8);
            const float rs = 1.0f / sqrtf(ss * (1.0f / 128.0f) + LN_EPS); const float* gain = a.hg_on + li * 8; float o[8];
#pragma unroll
            for (int e = 0; e < 8; ++e) o[e] = f[e] * rs * gain[e] * silu_f(g[e]);
            *(GAS v4u*)(A2 + (size_t)r * 2048 + c) = pack8(o); }
    }
}
__device__ __forceinline__ int scan_row(int p, int dir) { return dir ? (p < CTXL ? CTXL - 1 - p : SROWS + CTXL - 1 - p) : p; }
__device__ __forceinline__ void ret_scan_simple(const Args& a, LAS unsigned char* lds, int tid) {
    const bf16* P = (const bf16*)(a.ws + WS_PROJ); bf16* SO = (bf16*)(a.ws + WS_SCY);
    LAS float* qs = (LAS float*)lds; LAS float* ks = qs + 16 * 256; LAS float* vsm = ks + 16 * 256; LAS float* op = vsm + 16 * 128;
    const int dv = tid & 127, g = tid >> 7;
    for (int u = blockIdx.x; u < 256; u += gridDim.x) {
        const int b = u >> 6, h = (u >> 3) & 7, dir = (u >> 2) & 1, vs = u & 3;
        const float gamma = expf((dir ? a.ret_db : a.ret_df)[h]);
        float S[64];
#pragma unroll
        for (int j = 0; j < 64; ++j) S[j] = 0.f;
        for (int p0 = 0; p0 < SROWS; p0 += 16) {
            { const int pp = tid >> 5, ch = tid & 31; const size_t row = (size_t)b * SROWS + scan_row(p0 + pp, dir);
              float f[8]; unpack8(*(const GAS v4u*)(P + row * RET_N + h * 256 + ch * 8), f);
              *(LAS f32x4*)(qs + pp * 256 + ch * 8) = (f32x4){f[0], f[1], f[2], f[3]}; *(LAS f32x4*)(qs + pp * 256 + ch * 8 + 4) = (f32x4){f[4], f[5], f[6], f[7]};
              unpack8(*(const GAS v4u*)(P + row * RET_N + 2048 + h * 256 + ch * 8), f);
              *(LAS f32x4*)(ks + pp * 256 + ch * 8) = (f32x4){f[0], f[1], f[2], f[3]}; *(LAS f32x4*)(ks + pp * 256 + ch * 8 + 4) = (f32x4){f[4], f[5], f[6], f[7]};
              const u32x2v w = *(const GAS u32x2v*)(P + row * RET_N + 4096 + h * 512 + vs * 128 + ch * 4);
              *(LAS f32x4*)(vsm + pp * 128 + ch * 4) = (f32x4){bflo(w.x), bfhi(w.x), bflo(w.y), bfhi(w.y)}; }
            __syncthreads();
            for (int pp = 0; pp < 16; ++pp) {
                const float vv = vsm[pp * 128 + dv]; float acc = 0.f;
#pragma unroll
                for (int j4 = 0; j4 < 16; ++j4) { const f32x4 k4 = *(const LAS f32x4*)(ks + pp * 256 + 64 * g + 4 * j4), q4 = *(const LAS f32x4*)(qs + pp * 256 + 64 * g + 4 * j4);
#pragma unroll
                    for (int e = 0; e < 4; ++e) { S[4 * j4 + e] = fmaf(gamma, S[4 * j4 + e], k4[e] * vv); acc = fmaf(q4[e], S[4 * j4 + e], acc); } }
                op[(pp * 4 + g) * 128 + dv] = acc;
            }
            __syncthreads();
#pragma unroll
            for (int i = 0; i < 4; ++i) { const int idx = tid + 512 * i, pp = idx >> 7, d = idx & 127;
                const float o = (op[(pp * 4 + 0) * 128 + d] + op[(pp * 4 + 1) * 128 + d]) + (op[(pp * 4 + 2) * 128 + d] + op[(pp * 4 + 3) * 128 + d]);
                const size_t row = (size_t)b * SROWS + scan_row(p0 + pp, dir);
                SO[((size_t)dir * MROWS + row) * 4096 + h * 512 + vs * 128 + d] = (bf16)f2bf(o); }
        }
        __syncthreads();
    }
}
__device__ __forceinline__ void hg_scan_simple(const Args& a, LAS unsigned char* lds, int tid) {
    const bf16* P = (const bf16*)(a.ws + WS_PROJ); bf16* SO = (bf16*)(a.ws + WS_SCY);
    LAS float* qs = (LAS float*)lds; LAS float* fs = qs + 16 * 128; LAS float* kk = fs + 16 * 128; LAS float* is = kk + 16 * 128; LAS float* op = is + 16 * 64; LAS float* lbs = op + 16 * 8 * 64;
    const int dv = tid & 63, g8 = tid >> 6;
    for (int u = blockIdx.x; u < 256; u += gridDim.x) {
        const int b = u >> 6, h = (u >> 2) & 15, dir = (u >> 1) & 1, vs = u & 1;
        if (tid < 128) { const int col = h * 128 + tid; const float r0 = a.hg_lb_raw[col], r1 = a.hg_lb_raw[2048 + col], r2 = a.hg_lb_raw[4096 + col], r3 = a.hg_lb_raw[6144 + col];
            const float mx = fmaxf(fmaxf(r0, r1), fmaxf(r2, r3)); const float e0 = expf(r0 - mx), e1 = expf(r1 - mx), e2 = expf(r2 - mx), e3 = expf(r3 - mx); const float sum = (e0 + e1) + (e2 + e3);
            const float p0 = e0 / sum, p1 = e1 / sum, p2 = e2 / sum, p3 = e3 / sum; lbs[tid] = (((p0 + p1) + p2) + p3) - p0; }
        __syncthreads();
        float S[16];
#pragma unroll
        for (int j = 0; j < 16; ++j) S[j] = 0.f;
        for (int p0 = 0; p0 < SROWS; p0 += 16) {
            { const int pp = tid >> 5, ch = tid & 31; const size_t row = (size_t)b * SROWS + scan_row(p0 + pp, dir);
              const u32x2v wq = *(const GAS u32x2v*)(P + row * HG_N + h * 128 + ch * 4), wf = *(const GAS u32x2v*)(P + row * HG_N + (dir ? 4096 : 2048) + h * 128 + ch * 4);
              const float qv[4] = {bflo(wq.x), bfhi(wq.x), bflo(wq.y), bfhi(wq.y)}, fv[4] = {bflo(wf.x), bfhi(wf.x), bflo(wf.y), bfhi(wf.y)};
              f32x4 qo, fo, ko;
#pragma unroll
              for (int e = 0; e < 4; ++e) { const float lb = lbs[ch * 4 + e]; const float f = lb + (1.0f - lb) * sigmoid_f(fv[e]); qo[e] = silu_f(qv[e]); fo[e] = f; ko[e] = 1.0f - f; }
              *(LAS f32x4*)(qs + pp * 128 + ch * 4) = qo; *(LAS f32x4*)(fs + pp * 128 + ch * 4) = fo; *(LAS f32x4*)(kk + pp * 128 + ch * 4) = ko;
              const unsigned wi = *(const GAS unsigned*)(P + row * HG_N + 6144 + h * 128 + vs * 64 + ch * 2);
              *(LAS f32x2v*)(is + pp * 64 + ch * 2) = (f32x2v){bflo(wi), bfhi(wi)}; }
            __syncthreads();
            for (int pp = 0; pp < 16; ++pp) {
                const float iv = is[pp * 64 + dv]; float acc = 0.f;
#pragma unroll
                for (int j4 = 0; j4 < 4; ++j4) { const f32x4 f4 = *(const LAS f32x4*)(fs + pp * 128 + 16 * g8 + 4 * j4), k4 = *(const LAS f32x4*)(kk + pp * 128 + 16 * g8 + 4 * j4), q4 = *(const LAS f32x4*)(qs + pp * 128 + 16 * g8 + 4 * j4);
#pragma unroll
                    for (int e = 0; e < 4; ++e) { S[4 * j4 + e] = fmaf(f4[e], S[4 * j4 + e], k4[e] * iv); acc = fmaf(q4[e], S[4 * j4 + e], acc); } }
                op[(pp * 8 + g8) * 64 + dv] = acc;
            }
            __syncthreads();
#pragma unroll
            for (int i = 0; i < 2; ++i) { const int idx = tid + 512 * i, pp = idx >> 6, d = idx & 63; float o = 0.f;
#pragma unroll
                for (int w = 0; w < 8; ++w) o += op[(pp * 8 + w) * 64 + d];
                const size_t row = (size_t)b * SROWS + scan_row(p0 + pp, dir);
                SO[((size_t)dir * MROWS + row) * 2048 + h * 128 + vs * 64 + d] = (bf16)f2bf(o); }
        }
        __syncthreads();
    }
}
constexpr int NPH = 2 + 11 * 4;
#define IN(k) (lo <= (k) && (k) < hi)
#define SEAM(k) do { if (a.use_bar && hi > (k) + 1) xcd_barrier(bar); } while (0)
template <int l> __device__ __forceinline__ void run_layer(const Args& a, LAS unsigned char* lds, const XcdBarrier& bar, int tid, int lane, int wave, int G, int gw, int NGW) {
    const int lo = a.ph_lo, hi = a.ph_hi; unsigned char* ws = a.ws;
    bf16* const H = (bf16*)(ws + WS_R1); bf16* const PROJ = (bf16*)(ws + WS_PROJ); float* const Y = (float*)(ws + WS_SCY);
        const int pb = 2 + 11 * l;
        if (IN(pb)) {
            const bf16* Bt; int N; bf16* O;
            if (l == 0) { Bt = (const bf16*)(ws + WS_W_RET_IN); N = RET_N; O = PROJ; }
            else if (l == 1) { Bt = (const bf16*)(ws + WS_W_GQA_IN); N = GQA_N; O = PROJ; }
            else if (l == 2) { Bt = (const bf16*)(ws + WS_W_MLA_IN); N = MLA_NP; O = (bf16*)(ws + WS_PROJ + PJ_MLA_C); }
            else { Bt = (const bf16*)(ws + WS_W_HG_IN); N = HG_N; O = PROJ; }
            pg8::Gemm g{H, Bt, MROWS, N, DM}; pg8::StaticOrder S; S.init(MROWS, N, G, (int)blockIdx.x); pg8::EpiBf16P E{O, N};
            pg8::gemm_phase<pg8::EpiBf16P, pg8::StaticOrder, true, true>(lds, g, S, E);
            SEAM(pb);
        }
        if (IN(pb + 1) && l != 3) {
            if (l == 0) ret_rope_rows(a, gw, NGW, lane); else if (l == 1) gqa_normrope_rows(a, gw, NGW, lane); else mla_norm_rows(a, gw, NGW, lane);
            SEAM(pb + 1);
        }
        if (IN(pb + 2) && l == 2) {
            { pg8::Gemm g{(const bf16*)(ws + WS_PROJ + PJ_MLA_CQN), (const bf16*)(ws + WS_W_MLA_QUP), MROWS, MLA_QN, 512}; pg8::StaticOrder S; S.init(MROWS, MLA_QN, G, (int)blockIdx.x);
              pg8::EpiBf16P E{(bf16*)(ws + WS_PROJ + PJ_MLA_Q), MLA_QN}; pg8::gemm_phase<pg8::EpiBf16P, pg8::StaticOrder, true, true>(lds, g, S, E); }
            { pg8::Gemm g{(const bf16*)(ws + WS_PROJ + PJ_MLA_CKVN), (const bf16*)(ws + WS_W_MLA_KVUP), MROWS, MLA_KVN, 512}; pg8::StaticOrder S; S.init(MROWS, MLA_KVN, G, (int)blockIdx.x);
              pg8::EpiBf16P E{(bf16*)(ws + WS_PROJ + PJ_MLA_KV), MLA_KVN}; pg8::gemm_phase<pg8::EpiBf16P, pg8::StaticOrder, true, true>(lds, g, S, E); }
            SEAM(pb + 2);
        }
        if (IN(pb + 3) && l == 2) { mla_qrope_rows(a, gw, NGW, lane); SEAM(pb + 3); }
        if (IN(pb + 4)) {
            if (l == 0) ret_scan_simple(a, lds, tid);
            else if (l == 3) hg_scan_simple(a, lds, tid);
            else {
                bf16* const A2 = (bf16*)(ws + WS_R1);
                for (int uidx = blockIdx.x; uidx < 1088; uidx += G) {
                    int b, h, qb, ctxu = 0;
                    if (uidx < 1024) { const int x = uidx & 7, y = (uidx >> 3) & 31, rnd = uidx >> 8;
                        if (l == 1) { const int combo = 2 * x + (y >> 4), w = (y & 15) + 16 * rnd; b = combo >> 2; h = (combo & 3) * 4 + (w >> 4); qb = w & 15; }
                        else { const int combo = 2 * x + (y >> 4) + 16 * rnd; b = combo >> 4; h = combo & 15; qb = y & 15; } }
                    else { const int c = uidx - 1024; b = c >> 4; h = c & 15; qb = 0; ctxu = 1; }
                    const size_t rb = (size_t)b * SROWS, r0 = rb + (ctxu ? 0 : CTXL + qb * 256); const int seq = ctxu ? CTXL : SROWS;
                    if (l == 1) { const bf16* QKV = PROJ; const int kvh = h >> 2;
                        att::attn_unit<8, 8, 2, GQA_N, GQA_N, GQA_N, GQA_N, DM>(QKV + r0 * GQA_N + h * 128, QKV + rb * GQA_N + 2048 + kvh * 128, QKV + rb * GQA_N + 2048 + kvh * 128,
                                             QKV + rb * GQA_N + 2560 + kvh * 128, A2 + r0 * DM + h * 128, seq, 0.08838834764831845f * 1.4426950408889634f, 8.0f / 0.08838834764831845f, (ATT_LAS char*)lds); }
                    else { const bf16* Q = (const bf16*)(ws + WS_PROJ + PJ_MLA_Q); const bf16* KV = (const bf16*)(ws + WS_PROJ + PJ_MLA_KV); const bf16* KR = (const bf16*)(ws + WS_PROJ + PJ_MLA_KR);
                        att::attn_unit<12, 4, 1, MLA_QN, MLA_KVN, 64, MLA_KVN, DM>(Q + r0 * MLA_QN + h * 192, KV + rb * MLA_KVN + h * 256, KR + rb * 64,
                                              KV + rb * MLA_KVN + h * 256 + 128, A2 + r0 * DM + h * 128, seq, 0.07216878364870323f * 1.4426950408889634f, 8.0f / 0.07216878364870323f, (ATT_LAS char*)lds); }
                }
            }
            SEAM(pb + 4);
        }
        if (IN(pb + 5) && (l == 0 || l == 3)) { if (l == 0) ret_readout_rows(a, gw, NGW, lane); else hg_readout_rows(a, gw, NGW, lane); SEAM(pb + 5); }
        if (IN(pb + 6)) {
            const bf16* Bt = (const bf16*)(ws + (l == 0 ? WS_W_RET_OUT : l == 1 ? WS_W_GQA_OUT : l == 2 ? WS_W_MLA_OUT : WS_W_HG_OUT)); const int K = (l == 0) ? 4096 : DM;
            pg8::Gemm g{(const bf16*)(ws + WS_R1), Bt, MROWS, DM, K}; pg8::StaticOrder S; S.init(MROWS, DM, G, (int)blockIdx.x); pg8::EpiF32P E{Y, DM};
            pg8::gemm_phase<pg8::EpiF32P, pg8::StaticOrder, true, true>(lds, g, S, E);
            SEAM(pb + 6);
        }
        if (IN(pb + 7)) { ln_rows(a, l, 0, gw, NGW, lane); SEAM(pb + 7); }
        if (IN(pb + 8)) {
            pg8::Gemm g{H, (const bf16*)(ws + WS_W_FFN_IN + l * FFN_IN_BYTES), MROWS, 2 * FFH, DM}; pg8::StaticOrder S; S.init(MROWS, 2 * FFH, G, (int)blockIdx.x); pg8::EpiSwiglu E{PROJ, FFH};
            pg8::gemm_phase<pg8::EpiSwiglu, pg8::StaticOrder, true, true>(lds, g, S, E);
            SEAM(pb + 8);
        }
        if (IN(pb + 9)) {
            pg8::Gemm g{PROJ, (const bf16*)(ws + WS_W_FFN_OUT + l * FFN_OUT_BYTES), MROWS, DM, FFH}; pg8::StaticOrder S; S.init(MROWS, DM, G, (int)blockIdx.x); pg8::EpiF32P E{Y, DM};
            pg8::gemm_phase<pg8::EpiF32P, pg8::StaticOrder, true, true>(lds, g, S, E);
            SEAM(pb + 9);
        }
        if (IN(pb + 10)) { ln_rows(a, l, 1, gw, NGW, lane); SEAM(pb + 10); }
    }
__global__ void __launch_bounds__(NWAVES * 64, 2) mk_fwd(Args a) {
    extern __shared__ __attribute__((aligned(16))) unsigned char lds_raw[];
    LAS unsigned char* lds = (LAS unsigned char*)lds_raw;
    const int tid = threadIdx.x, lane = tid & 63, wave = __builtin_amdgcn_readfirstlane(tid >> 6);
    const int G = gridDim.x, gw = blockIdx.x * NWAVES + wave, NGW = G * NWAVES;
    volatile LAS unsigned* MISC = (volatile LAS unsigned*)(lds + MISC_OFF);
    if (tid < 128) ((LAS unsigned*)(lds + MISC_OFF))[tid] = 0u;
    __syncthreads();
    gu32* ctl = (gu32*)(a.ws + WS_CTL);
    XcdBarrier bar; bar.bar = (unsigned*)ctl + CW_BAR; bar.x = 0; bar.st = nullptr;
    if (a.use_bar) bar = xcd_barrier_post((unsigned*)ctl + CW_BAR, MISC + 8);
    const int lo = a.ph_lo, hi = a.ph_hi;
    unsigned char* ws = a.ws;
    bf16* const H = (bf16*)(ws + WS_R1); bf16* const PROJ = (bf16*)(ws + WS_PROJ); float* const Y = (float*)(ws + WS_SCY);

    if (IN(0)) {
        LAS float* scr = (LAS float*)(lds + wave * 16384);
        constexpr int I_RI = 32 * (RET_N / 32), I_RO = 64 * 64, I_GI = 32 * (GQA_N / 32), I_GO = 32 * 64, I_MI = 32 * (MLA_NP / 32), I_MQ = 8 * (MLA_QN / 32), I_MK = 8 * (MLA_KVN / 32), I_MO = 32 * 64,
                      I_HI = 32 * (HG_N / 32), I_HO = 32 * 64, I_FI = 32 * (2 * FFH / 32), I_FO = (FFH / 64) * 64;
        constexpr int NITEMS = I_RI + I_RO + I_GI + I_GO + I_MI + I_MQ + I_MK + I_MO + I_HI + I_HO + 4 * I_FI + 4 * I_FO;
        for (int it = gw; it < NITEMS; it += NGW) {
            int r = it;
            if (r < I_RI) { transpose_w<0>(a.ret_w_in, DM, RET_N, RET_N, (bf16*)(ws + WS_W_RET_IN), r, scr, lane); continue; } r -= I_RI;
            if (r < I_RO) { transpose_w<0>(a.ret_w_out, 4096, DM, DM, (bf16*)(ws + WS_W_RET_OUT), r, scr, lane); continue; } r -= I_RO;
            if (r < I_GI) { transpose_w<0>(a.gqa_w_in, DM, GQA_N, GQA_N, (bf16*)(ws + WS_W_GQA_IN), r, scr, lane); continue; } r -= I_GI;
            if (r < I_GO) { transpose_w<0>(a.gqa_w_out, DM, DM, DM, (bf16*)(ws + WS_W_GQA_OUT), r, scr, lane); continue; } r -= I_GO;
            if (r < I_MI) { transpose_w<2>(a.mla_w_in, DM, MLA_NACT, MLA_NP, (bf16*)(ws + WS_W_MLA_IN), r, scr, lane); continue; } r -= I_MI;
            if (r < I_MQ) { transpose_w<0>(a.mla_w_qup, 512, MLA_QN, MLA_QN, (bf16*)(ws + WS_W_MLA_QUP), r, scr, lane); continue; } r -= I_MQ;
            if (r < I_MK) { transpose_w<0>(a.mla_w_kvup, 512, MLA_KVN, MLA_KVN, (bf16*)(ws + WS_W_MLA_KVUP), r, scr, lane); continue; } r -= I_MK;
            if (r < I_MO) { transpose_w<0>(a.mla_w_out, DM, DM, DM, (bf16*)(ws + WS_W_MLA_OUT), r, scr, lane); continue; } r -= I_MO;
            if (r < I_HI) { transpose_w<0>(a.hg_w_in, DM, HG_N, HG_N, (bf16*)(ws + WS_W_HG_IN), r, scr, lane); continue; } r -= I_HI;
            if (r < I_HO) { transpose_w<0>(a.hg_w_out, DM, DM, DM, (bf16*)(ws + WS_W_HG_OUT), r, scr, lane); continue; } r -= I_HO;
            if (r < 4 * I_FI) { const int l = r / I_FI; transpose_w<1>(a.ffn_w_in + (size_t)l * DM * 2 * FFH, DM, 2 * FFH, 2 * FFH, (bf16*)(ws + WS_W_FFN_IN + l * FFN_IN_BYTES), r % I_FI, scr, lane); continue; } r -= 4 * I_FI;
            { const int l = r / I_FO; transpose_w<0>(a.ffn_w_out + (size_t)l * FFH * DM, FFH, DM, DM, (bf16*)(ws + WS_W_FFN_OUT + l * FFN_OUT_BYTES), r % I_FO, scr, lane); }
        }
        __syncthreads();
        for (int u = blockIdx.x; u < 192; u += G) mods_unit(a, u / 48, u % 48, (LAS float*)lds, tid, lane, wave);
        rope_tables(a, blockIdx.x * (NWAVES * 64) + tid, G * NWAVES * 64);
        SEAM(0);
    }
    if (IN(1)) { init_rows(a, gw, NGW, lane); SEAM(1); }

    run_layer<0>(a, lds, bar, tid, lane, wave, G, gw, NGW);
    run_layer<1>(a, lds, bar, tid, lane, wave, G, gw, NGW);
    run_layer<2>(a, lds, bar, tid, lane, wave, G, gw, NGW);
    run_layer<3>(a, lds, bar, tid, lane, wave, G, gw, NGW);
}

#ifndef MK_PER_PHASE
#define MK_PER_PHASE 0
#endif
extern "C" void kernel_launch(void* const* d_in, const int* in_sizes, int n_in, void* d_out, int out_size, void* d_ws, size_t ws_size, hipStream_t stream) {
    static int grid = 0;
    if (grid == 0) {
        if (n_in != 28 || out_size != NBATCH * SEQ * DM || ws_size < WS_END) { fprintf(stderr, "kernel_launch: unexpected shapes (n_in %d out %d ws %zu)\n", n_in, out_size, ws_size); grid = -1; return; }
        int dev = 0, cus = 0, per_cu = 0;
        if (hipGetDevice(&dev) != hipSuccess || hipDeviceGetAttribute(&cus, hipDeviceAttributeMultiprocessorCount, dev) != hipSuccess) { grid = -1; return; }
        if (hipFuncSetAttribute((const void*)mk_fwd, hipFuncAttributeMaxDynamicSharedMemorySize, LDS_BYTES) != hipSuccess) { fprintf(stderr, "kernel_launch: hipFuncSetAttribute failed\n"); grid = -1; return; }
        if (hipOccupancyMaxActiveBlocksPerMultiprocessor(&per_cu, (const void*)mk_fwd, NWAVES * 64, LDS_BYTES) != hipSuccess || per_cu < 1) { fprintf(stderr, "kernel_launch: occupancy query says %d\n", per_cu); }
        (void)hipGetLastError();
        grid = cus;
    }
    if (grid < 0) return;
    if (hipMemsetAsync((char*)d_ws + WS_CTL, 0, CTL_ZERO_BYTES, stream) != hipSuccess) return;
    Args a{};
    const float** ap = (const float**)&a;
    for (int i = 0; i < 28; ++i) ap[i] = (const float*)d_in[i];
    a.out = (float*)d_out; a.ws = (unsigned char*)d_ws; a.pad = 0;
#if MK_PER_PHASE
    for (int p = 0; p < NPH; ++p) { a.ph_lo = p; a.ph_hi = p + 1; a.use_bar = 0; hipLaunchKernelGGL(mk_fwd, dim3(grid), dim3(NWAVES * 64), LDS_BYTES, stream, a); }
#else
    a.ph_lo = 0; a.ph_hi = NPH; a.use_bar = 1;
    hipLaunchKernelGGL(mk_fwd, dim3(grid), dim3(NWAVES * 64), LDS_BYTES, stream, a);
#endif
    const hipError_t le = hipPeekAtLastError();
    if (le != hipSuccess) fprintf(stderr, "kernel_launch: launch failed: %s\n", hipGetErrorName(le));
}
```

```cpp
#include <hip/hip_runtime.h>
#include <hip/hip_bf16.h>
#include <cstdio>
#include <cstdint>
namespace pg8 {
#define PG8_LAS __attribute__((address_space(3)))
typedef unsigned short bf16_t;
typedef short bf16x8 __attribute__((ext_vector_type(8)));
typedef float f32x4 __attribute__((ext_vector_type(4)));
typedef unsigned u32x4 __attribute__((ext_vector_type(4)));
constexpr int BM = 256, BK = 64, HALF = 128, HTB = HALF * BK * 2  , STAGE_BYTES = 8 * HTB, NXCD = 8, WGM = 8;

__host__ __device__ __forceinline__ int lds_byte(int r, int c) { const int st = (r >> 4) * 2 + (c >> 5), rr = r & 15, cc = c & 31, ob = rr * 64 + cc * 2; return st * 1024 + (ob ^ (((ob >> 9) & 1) << 5)); }
__host__ __device__ __forceinline__ void stage_rc(int b, int& R, int& C) { const int st = b / 1024, sb = b % 1024, swz = sb ^ (((sb >> 9) & 1) << 5); R = (st >> 1) * 16 + swz / 64; C = (st & 1) * 32 + (swz % 64) / 2; }
__host__ __device__ __forceinline__ int perm32(int rho) { const int n = rho >> 4, i = rho & 15; return 8 * (i >> 2) + 4 * n + (i & 3); }

struct Unit { int pm, pn; };
struct Gemm { const bf16_t* A; const bf16_t* Bt; int M, N, K; };

struct StaticOrder {
    int nM, nN, nwg, G, c;
    __host__ __device__ void init(int M, int N, int G_, int c_) { nM = M / BM; nN = N / BM; nwg = nM * nN; G = G_; c = c_; }
    __host__ __device__ bool next(int i, Unit& u) const {
        const long L = (long)i * G + c; if (L >= nwg) return false;
        int wgid = (int)L; { const int q = nwg / NXCD, r = nwg % NXCD, xcd = wgid % NXCD, off = wgid / NXCD; wgid = (xcd < r ? xcd * (q + 1) : r * (q + 1) + (xcd - r) * q) + off; }
        const int nig = WGM * nN, gid = wgid / nig, fm = gid * WGM, gsz = (nM - fm) < WGM ? (nM - fm) : WGM;
        u.pm = fm + ((wgid % nig) % gsz); u.pn = (wgid % nig) / gsz; return true;
    }
    __device__ __forceinline__ void a_ready(const Unit&) const {}
    __device__ __forceinline__ void done(const Unit&) const {}
};

__device__ __forceinline__ unsigned cvt_pk_bf16(float lo, float hi) { unsigned r; asm volatile("v_cvt_pk_bf16_f32 %0, %1, %2" : "=v"(r) : "v"(lo), "v"(hi)); return r; }
struct EpiBf16P {
    static constexpr bool PERM = true, AFTER_DRAIN = false;
    bf16_t* O; int ldc;
    __device__ __forceinline__ void operator()(const f32x4 (&acc)[2][2][4][2], const Unit& u, int wr, int wc, int fr, int fq) const {
        const int row0 = u.pm * BM + wr * 64 + fr, col0 = u.pn * BM + wc * 32 + 8 * fq;
#pragma unroll
        for (int ai = 0; ai < 2; ++ai)
#pragma unroll
            for (int m = 0; m < 4; ++m) { bf16_t* rowp = O + (size_t)(row0 + ai * HALF + m * 16) * ldc + col0;
#pragma unroll
                for (int bj = 0; bj < 2; ++bj) { const f32x4 v0 = acc[ai][bj][m][0], v1 = acc[ai][bj][m][1];
                    u32x4 w; w.x = cvt_pk_bf16(v0[0], v0[1]); w.y = cvt_pk_bf16(v0[2], v0[3]); w.z = cvt_pk_bf16(v1[0], v1[1]); w.w = cvt_pk_bf16(v1[2], v1[3]);
                    *(u32x4*)(rowp + bj * HALF) = w; } }
    }
};
struct EpiF32P {
    static constexpr bool PERM = false, AFTER_DRAIN = false;
    float* C; int ldc;
    __device__ __forceinline__ void operator()(const f32x4 (&acc)[2][2][4][2], const Unit& u, int wr, int wc, int fr, int fq) const {
        const int row0 = u.pm * BM + wr * 64 + fr, col0 = u.pn * BM + wc * 32 + 4 * fq;
#pragma unroll
        for (int ai = 0; ai < 2; ++ai)
#pragma unroll
            for (int m = 0; m < 4; ++m) { float* rowp = C + (size_t)(row0 + ai * HALF + m * 16) * ldc + col0;
#pragma unroll
                for (int bj = 0; bj < 2; ++bj)
#pragma unroll
                    for (int n = 0; n < 2; ++n) *(f32x4*)(rowp + bj * HALF + n * 16) = acc[ai][bj][m][n]; }
    }
};
__device__ __forceinline__ float silu_mul(float a, float b) { return a * b * __builtin_amdgcn_rcpf(1.0f + __builtin_amdgcn_exp2f(a * -1.4426950408889634f)); }
struct EpiSwiglu {
    static constexpr bool PERM = true, AFTER_DRAIN = false;
    bf16_t* O; int ldc;
    __device__ __forceinline__ void operator()(const f32x4 (&acc)[2][2][4][2], const Unit& u, int wr, int wc, int fr, int fq) const {
        const int row0 = u.pm * BM + wr * 64 + fr, col0 = u.pn * HALF + wc * 32 + 8 * fq;
#pragma unroll
        for (int ai = 0; ai < 2; ++ai)
#pragma unroll
            for (int m = 0; m < 4; ++m) { bf16_t* rowp = O + (size_t)(row0 + ai * HALF + m * 16) * ldc + col0;
                const f32x4 a0 = acc[ai][0][m][0], a1 = acc[ai][0][m][1], b0 = acc[ai][1][m][0], b1 = acc[ai][1][m][1];
                u32x4 w; w.x = cvt_pk_bf16(silu_mul(a0[0], b0[0]), silu_mul(a0[1], b0[1])); w.y = cvt_pk_bf16(silu_mul(a0[2], b0[2]), silu_mul(a0[3], b0[3]));
                w.z = cvt_pk_bf16(silu_mul(a1[0], b1[0]), silu_mul(a1[1], b1[1])); w.w = cvt_pk_bf16(silu_mul(a1[2], b1[2]), silu_mul(a1[3], b1[3]));
                *(u32x4*)rowp = w; }
    }
};

template <class Epi, class Sched, bool ALIGN_EPI = false, bool SP2 = false>
__device__ __forceinline__ void gemm_phase(PG8_LAS unsigned char* lds, const Gemm g, const Sched& S, const Epi& E) {
    const int tid = threadIdx.x, wid = __builtin_amdgcn_readfirstlane(tid >> 6), lane = tid & 63, wr = wid >> 2, wc = wid & 3, fr = lane & 15, fq = lane >> 4;
    const int K = g.K, nt = K / BK;
    unsigned voffA[2], voffB[2];
#pragma unroll
    for (int i = 0; i < 2; ++i) { int R, C; stage_rc(tid * 16 + i * 8192, R, C); const int Rb = Epi::PERM ? ((R & ~31) + perm32(R & 31)) : R;
        voffA[i] = (unsigned)(R * K + C) * 2u; voffB[i] = (unsigned)(Rb * K + C) * 2u; }
    const size_t kstep = (size_t)(BK * 2);
    const size_t hstep = (size_t)HALF * K * 2;
    const size_t tstep = 2 * hstep;
    const unsigned ldsw = (unsigned)wid * 1024u;
    const int aoff = lds_byte(wr * 64 + fr, fq * 8), boff = lds_byte(wc * 32 + fr, fq * 8);
#define PG8_SA(b, h) (((b) * 2 + (h)) * HTB)
#define PG8_SB(b, h) ((4 + (b) * 2 + (h)) * HTB)
#define PG8_STAGE(bufoff, gbase, voff) do { _Pragma("unroll") for (int _i = 0; _i < 2; ++_i) \
        __builtin_amdgcn_global_load_lds((const unsigned*)((const char*)(gbase) + (voff)[_i]), (PG8_LAS unsigned*)(lds + (bufoff) + ldsw + _i * 8192), 16, 0, 0); } while (0)
#define PG8_LDA(dst, b, h) do { _Pragma("unroll") for (int m = 0; m < 4; ++m) _Pragma("unroll") for (int k = 0; k < 2; ++k) dst[m][k] = *(const PG8_LAS bf16x8*)(lds + PG8_SA(b, h) + aoff + m * 2048 + k * 1024); } while (0)
#define PG8_LDB(dst, b, h) do { _Pragma("unroll") for (int n = 0; n < 2; ++n) _Pragma("unroll") for (int k = 0; k < 2; ++k) dst[n][k] = *(const PG8_LAS bf16x8*)(lds + PG8_SB(b, h) + boff + n * 2048 + k * 1024); } while (0)
#define PG8_MMA(ai, bj, At, Bt) do { __builtin_amdgcn_s_setprio(1); _Pragma("unroll") for (int m = 0; m < 4; ++m) _Pragma("unroll") for (int n = 0; n < 2; ++n) _Pragma("unroll") for (int k = 0; k < 2; ++k) \
        acc[ai][bj][m][n] = __builtin_amdgcn_mfma_f32_16x16x32_bf16(Bt[n][k], At[m][k], acc[ai][bj][m][n], 0, 0, 0); __builtin_amdgcn_s_setprio(0); } while (0)
#define PG8_WAIT_V(n) asm volatile("s_waitcnt vmcnt(" #n ")" ::: "memory")
#define PG8_WAIT_L(n) asm volatile("s_waitcnt lgkmcnt(" #n ")" ::: "memory")
#define PG8_BAR __builtin_amdgcn_s_barrier()
#define PG8_SCHED __builtin_amdgcn_sched_barrier(0)
    Unit cur, nxt; int ui = 0;
    if (!S.next(0, cur)) return;
    f32x4 acc[2][2][4][2];
#pragma unroll
    for (int a = 0; a < 2; ++a)
#pragma unroll
        for (int b = 0; b < 2; ++b)
#pragma unroll
            for (int m = 0; m < 4; ++m)
#pragma unroll
                for (int n = 0; n < 2; ++n) acc[a][b][m][n] = (f32x4){0.f, 0.f, 0.f, 0.f};
    bf16x8 At[4][2], B0[2][2], B1[2][2];
    const char* cA = (const char*)g.A + (size_t)cur.pm * tstep; const char* cB = (const char*)g.Bt + (size_t)cur.pn * tstep;
    S.a_ready(cur);
    if constexpr (SP2) {
        PG8_STAGE(PG8_SB(0, 0), cB, voffB); PG8_STAGE(PG8_SB(0, 1), cB + hstep, voffB); PG8_STAGE(PG8_SA(0, 0), cA, voffA); PG8_STAGE(PG8_SA(0, 1), cA + hstep, voffA);
        if (wr == 1) PG8_BAR;
        PG8_WAIT_V(2); PG8_BAR;
        PG8_STAGE(PG8_SB(1, 0), cB + kstep, voffB); PG8_STAGE(PG8_SA(1, 0), cA + kstep, voffA); PG8_STAGE(PG8_SB(1, 1), cB + hstep + kstep, voffB);
        PG8_WAIT_V(6); PG8_BAR;
    } else {
        PG8_STAGE(PG8_SB(0, 0), cB, voffB); PG8_STAGE(PG8_SA(0, 0), cA, voffA); PG8_STAGE(PG8_SB(0, 1), cB + hstep, voffB); PG8_STAGE(PG8_SA(0, 1), cA + hstep, voffA);
        if (wr == 1) PG8_BAR;
        PG8_WAIT_V(4); PG8_BAR;
        PG8_STAGE(PG8_SB(1, 0), cB + kstep, voffB); PG8_STAGE(PG8_SA(1, 0), cA + kstep, voffA); PG8_STAGE(PG8_SB(1, 1), cB + hstep + kstep, voffB);
        PG8_WAIT_V(6); PG8_BAR;
    }
    for (;;) {
        const bool has_next = S.next(ui + 1, nxt);
        const char* nA = has_next ? (const char*)g.A + (size_t)nxt.pm * tstep : cA; const char* nB = has_next ? (const char*)g.Bt + (size_t)nxt.pn * tstep : cB;
        for (int t = 0; t < nt; t += 2) {
            const bool last = (t == nt - 2);
            const char* a1 = cA + (size_t)(t + 1) * kstep;
            const char* a2 = last ? nA : cA + (size_t)(t + 2) * kstep; const char* b2 = last ? nB : cB + (size_t)(t + 2) * kstep;
            const char* a3 = a2 + kstep; const char* b3 = b2 + kstep;
            if (last && has_next) S.a_ready(nxt);
            if constexpr (SP2) {
            PG8_LDB(B0, 0, 0); PG8_LDB(B1, 0, 1); PG8_SCHED; PG8_LDA(At, 0, 0); PG8_STAGE(PG8_SA(1, 1), a1 + hstep, voffA);
            PG8_WAIT_V(8); PG8_WAIT_L(0); PG8_BAR; PG8_MMA(0, 0, At, B0); PG8_MMA(0, 1, At, B1); PG8_BAR; PG8_SCHED;
            PG8_LDA(At, 0, 1); PG8_STAGE(PG8_SB(0, 0), b2, voffB); PG8_STAGE(PG8_SB(0, 1), b2 + hstep, voffB); PG8_STAGE(PG8_SA(0, 0), a2, voffA);
            PG8_WAIT_V(8); PG8_WAIT_L(0); PG8_BAR; PG8_MMA(1, 0, At, B0); PG8_MMA(1, 1, At, B1); PG8_BAR; PG8_SCHED;
            PG8_LDB(B0, 1, 0); PG8_LDB(B1, 1, 1); PG8_SCHED; PG8_LDA(At, 1, 0); PG8_STAGE(PG8_SA(0, 1), a2 + hstep, voffA);
            PG8_WAIT_V(8); PG8_WAIT_L(0); PG8_BAR; PG8_MMA(0, 0, At, B0); PG8_MMA(0, 1, At, B1); PG8_BAR; PG8_SCHED;
            PG8_LDA(At, 1, 1); PG8_STAGE(PG8_SB(1, 0), b3, voffB); PG8_STAGE(PG8_SB(1, 1), b3 + hstep, voffB); PG8_STAGE(PG8_SA(1, 0), a3, voffA);
            PG8_WAIT_V(8); PG8_WAIT_L(0); PG8_BAR; PG8_MMA(1, 0, At, B0); PG8_MMA(1, 1, At, B1); PG8_BAR; PG8_SCHED;
            } else {
            PG8_LDB(B0, 0, 0); PG8_SCHED; PG8_LDA(At, 0, 0); PG8_STAGE(PG8_SA(1, 1), a1 + hstep, voffA);
            PG8_WAIT_L(8); PG8_BAR; PG8_WAIT_L(0); PG8_MMA(0, 0, At, B0); PG8_BAR; PG8_SCHED;
            PG8_LDB(B1, 0, 1); PG8_STAGE(PG8_SB(0, 0), b2, voffB);
            PG8_BAR; PG8_WAIT_L(0); PG8_MMA(0, 1, At, B1); PG8_BAR;
            PG8_LDA(At, 0, 1); PG8_STAGE(PG8_SA(0, 0), a2, voffA);
            PG8_BAR; PG8_WAIT_L(0); PG8_MMA(1, 0, At, B0); PG8_BAR; PG8_SCHED;
            PG8_STAGE(PG8_SB(0, 1), b2 + hstep, voffB);
            PG8_WAIT_V(6); PG8_BAR; PG8_MMA(1, 1, At, B1); PG8_BAR;
            PG8_LDB(B0, 1, 0); PG8_SCHED; PG8_LDA(At, 1, 0); PG8_STAGE(PG8_SA(0, 1), a2 + hstep, voffA);
            PG8_WAIT_L(8); PG8_BAR; PG8_WAIT_L(0); PG8_MMA(0, 0, At, B0); PG8_BAR; PG8_SCHED;
            PG8_LDB(B1, 1, 1); PG8_STAGE(PG8_SB(1, 0), b3, voffB);
            PG8_BAR; PG8_WAIT_L(0); PG8_MMA(0, 1, At, B1); PG8_BAR;
            PG8_LDA(At, 1, 1); PG8_STAGE(PG8_SA(1, 0), a3, voffA);
            PG8_BAR; PG8_WAIT_L(0); PG8_MMA(1, 0, At, B0); PG8_BAR; PG8_SCHED;
            PG8_STAGE(PG8_SB(1, 1), b3 + hstep, voffB);
            PG8_WAIT_V(6); PG8_BAR; PG8_MMA(1, 1, At, B1); PG8_BAR;
            }
        }
        if constexpr (ALIGN_EPI) { if (wr == 0) PG8_BAR; }
        if constexpr (!Epi::AFTER_DRAIN) { E(acc, cur, wr, wc, fr, fq); S.done(cur); }
        if (!has_next) break;
#pragma unroll
        for (int a = 0; a < 2; ++a)
#pragma unroll
            for (int b = 0; b < 2; ++b)
#pragma unroll
                for (int m = 0; m < 4; ++m)
#pragma unroll
                    for (int n = 0; n < 2; ++n) acc[a][b][m][n] = (f32x4){0.f, 0.f, 0.f, 0.f};
        cur = nxt; cA = nA; cB = nB; ++ui;
        if constexpr (ALIGN_EPI) { if (wr == 1) PG8_BAR; }
    }
    PG8_WAIT_V(0);
    if constexpr (!ALIGN_EPI) { if (wr == 0) PG8_BAR; }
    PG8_BAR;
    if constexpr (Epi::AFTER_DRAIN) { E.fused(acc, cur, wr, wc, fr, fq, lds, wid, lane); S.done(cur); }
#undef PG8_SA
#undef PG8_SB
#undef PG8_STAGE
#undef PG8_LDA
#undef PG8_LDB
#undef PG8_MMA
#undef PG8_WAIT_V
#undef PG8_WAIT_L
#undef PG8_BAR
#undef PG8_SCHED
}
}
namespace att {
using bf16x8 = __attribute__((ext_vector_type(8))) short;
using s16x4  = __attribute__((ext_vector_type(4))) short;
using f32x16 = __attribute__((ext_vector_type(16))) float;
using u32x4  = __attribute__((ext_vector_type(4))) unsigned;
typedef unsigned short bf16;
#define ATT_LAS __attribute__((address_space(3)))
constexpr int NW = 8, QBLK = 32, KVBLK = 64;
constexpr int SHM_V = KVBLK * 128 * 2;
#define ATT_SBAR() __builtin_amdgcn_sched_barrier(0)
__device__ __forceinline__ int crow(int r, int hi) { return (r & 3) + 8 * (r >> 2) + 4 * hi; }
__device__ __forceinline__ unsigned cvtpk(float lo, float hi) { unsigned r; asm volatile("v_cvt_pk_bf16_f32 %0, %1, %2" : "=v"(r) : "v"(lo), "v"(hi)); return r; }
__device__ __forceinline__ void partialSM(f32x16& p0, f32x16& p1, float& m_reg, float& mn, float& alpha, float C, float thr_raw) {
  float pmax = p0[0];
#pragma unroll
  for (int r = 1; r < 16; ++r) pmax = fmaxf(pmax, p0[r]);
#pragma unroll
  for (int r = 0; r < 16; ++r) pmax = fmaxf(pmax, p1[r]);
  { auto rr = __builtin_amdgcn_permlane32_swap(__float_as_uint(pmax), __float_as_uint(pmax), false, false);
    pmax = fmaxf(__uint_as_float(rr[0]), __uint_as_float(rr[1])); }
  if (__builtin_expect(__all(pmax - m_reg <= thr_raw), 1)) { mn = m_reg; alpha = 1.f; }
  else { mn = fmaxf(m_reg, pmax); alpha = __builtin_amdgcn_exp2f((m_reg - mn) * C); m_reg = mn; }
  float mnC = -mn * C;
#pragma unroll
  for (int r = 0; r < 16; ++r) p0[r] = fmaf(p0[r], C, mnC);
#pragma unroll
  for (int r = 0; r < 16; ++r) p1[r] = fmaf(p1[r], C, mnC);
#pragma unroll
  for (int r = 0; r < 16; ++r) p0[r] = __builtin_amdgcn_exp2f(p0[r]);
}
__device__ __forceinline__ void finishSM(f32x16& p0, f32x16& p1, float alpha, float& l_reg, bf16x8& pa0, bf16x8& pa1, bf16x8& pa2, bf16x8& pa3) {
#pragma unroll
  for (int r = 0; r < 16; ++r) p1[r] = __builtin_amdgcn_exp2f(p1[r]);
  float ps = 0;
#pragma unroll
  for (int r = 0; r < 16; ++r) ps += p0[r];
#pragma unroll
  for (int r = 0; r < 16; ++r) ps += p1[r];
  { auto rr = __builtin_amdgcn_permlane32_swap(__float_as_uint(ps), __float_as_uint(ps), false, false);
    ps = __uint_as_float(rr[0]) + __uint_as_float(rr[1]); }
  l_reg = l_reg * alpha + ps;
#define ATT_PK4(P, BASE, OUT) do { unsigned a0 = cvtpk(P[BASE + 0], P[BASE + 1]), a1 = cvtpk(P[BASE + 2], P[BASE + 3]);   \
    unsigned b0 = cvtpk(P[BASE + 4], P[BASE + 5]), b1 = cvtpk(P[BASE + 6], P[BASE + 7]);                              \
    auto r0 = __builtin_amdgcn_permlane32_swap(a0, b0, false, false); auto r1 = __builtin_amdgcn_permlane32_swap(a1, b1, false, false); \
    u32x4 w = {r0[0], r1[0], r0[1], r1[1]}; OUT = __builtin_bit_cast(bf16x8, w); } while (0)
  ATT_PK4(p0, 0, pa0); ATT_PK4(p0, 8, pa1); ATT_PK4(p1, 0, pa2); ATT_PK4(p1, 8, pa3);
}
template <int NQK> __device__ __forceinline__ int kswz(int row, int colB) { return row * (32 * NQK) + (colB ^ ((row & 7) << 4)); }
template <int NQK, int NQR> __device__ __forceinline__ void qkt(f32x16& p0, f32x16& p1, ATT_LAS const char* Ks, const bf16x8* qr, ATT_LAS const char* qx, int r32, int hi) {
  p0 = f32x16{}; p1 = f32x16{};
#pragma unroll
  for (int d0 = 0; d0 < NQK; ++d0) { int cb = (d0 * 16 + hi * 8) * 2;
    bf16x8 b0 = *(ATT_LAS const bf16x8*)(Ks + kswz<NQK>(r32, cb));
    bf16x8 b1 = *(ATT_LAS const bf16x8*)(Ks + kswz<NQK>(32 + r32, cb));
    bf16x8 qv; if (d0 < NQR) qv = qr[d0 < NQR ? d0 : 0]; else qv = *(ATT_LAS const bf16x8*)(qx + (d0 - NQR) * 1024);
    p0 = __builtin_amdgcn_mfma_f32_32x32x16_bf16(b0, qv, p0, 0, 0, 0);
    p1 = __builtin_amdgcn_mfma_f32_32x32x16_bf16(b1, qv, p1, 0, 0, 0); }
}
__device__ __forceinline__ int v_st(int k, int c) { const int kk = (k & ~0xC) | ((k & 4) << 1) | ((k & 8) >> 1); return ((kk >> 3) * 4 + (c >> 5)) * 512 + ((kk & 7) * 32 + (c & 31)) * 2; }
__device__ __forceinline__ int v_rd_base(int lane) { return ((lane & 3) << 3) | (((lane >> 2) & 3) << 6) | (((lane >> 4) & 1) << 5) | (((lane >> 5) & 1) << 8); }
constexpr int v_rd_off(int d0, int ks, int half) { return d0 * 512 + ks * 4096 + half * 2048; }
template <int OFF> __device__ __forceinline__ s16x4 tr_read(int vb) {
  s16x4 r; asm volatile("ds_read_b64_tr_b16 %0, %1 offset:%2" : "=&v"(r) : "v"(vb), "i"(OFF) : "memory"); return r;
}
template <int D0> __device__ __forceinline__ void pv_one(f32x16& od, int vb, bf16x8 pa0, bf16x8 pa1, bf16x8 pa2, bf16x8 pa3) {
  const s16x4 l0 = tr_read<v_rd_off(D0, 0, 0)>(vb), h0 = tr_read<v_rd_off(D0, 0, 1)>(vb), l1 = tr_read<v_rd_off(D0, 1, 0)>(vb), h1 = tr_read<v_rd_off(D0, 1, 1)>(vb);
  const s16x4 l2 = tr_read<v_rd_off(D0, 2, 0)>(vb), h2 = tr_read<v_rd_off(D0, 2, 1)>(vb), l3 = tr_read<v_rd_off(D0, 3, 0)>(vb), h3 = tr_read<v_rd_off(D0, 3, 1)>(vb);
  asm volatile("s_waitcnt lgkmcnt(0)" ::: "memory"); ATT_SBAR();
#define ATT_PK(L, H) (bf16x8){L[0], L[1], L[2], L[3], H[0], H[1], H[2], H[3]}
  od = __builtin_amdgcn_mfma_f32_32x32x16_bf16(pa0, ATT_PK(l0, h0), od, 0, 0, 0);
  od = __builtin_amdgcn_mfma_f32_32x32x16_bf16(pa1, ATT_PK(l1, h1), od, 0, 0, 0);
  od = __builtin_amdgcn_mfma_f32_32x32x16_bf16(pa2, ATT_PK(l2, h2), od, 0, 0, 0);
  od = __builtin_amdgcn_mfma_f32_32x32x16_bf16(pa3, ATT_PK(l3, h3), od, 0, 0, 0);
}
__device__ __forceinline__ void pv_d0(f32x16* o, int vb, bf16x8 pa0, bf16x8 pa1, bf16x8 pa2, bf16x8 pa3) {
  pv_one<0>(o[0], vb, pa0, pa1, pa2, pa3); pv_one<1>(o[1], vb, pa0, pa1, pa2, pa3); pv_one<2>(o[2], vb, pa0, pa1, pa2, pa3); pv_one<3>(o[3], vb, pa0, pa1, pa2, pa3);
}
template <int NQK> constexpr int shm_k() { return KVBLK * 32 * NQK; }
template <int NQK, int NQR> constexpr int shm_attn() { return 2 * SHM_V + 2 * shm_k<NQK>() + NW * 64 * 4 + NW * (NQK - NQR) * 1024; }

template <int NQK, int NQR, int SD, int ldq, int ldka, int ldkb, int ldv, int ldo>
__device__ __forceinline__ void attn_unit(const bf16* __restrict__ Qb, const bf16* __restrict__ KA, const bf16* __restrict__ KB,
                                          const bf16* __restrict__ Vh, bf16* __restrict__ Ob, int seq, float C, float thr_raw, ATT_LAS char* lds) {
  constexpr int SHM_K = shm_k<NQK>(), KCH = (2 * NQK * 64) / 512, NLD = KCH + 2;
  const int tid = threadIdx.x, wid = tid >> 6, lane = tid & 63, r32 = lane & 31, hi = lane >> 5;
  ATT_LAS char* V_lds = lds; ATT_LAS char* K_lds = lds + 2 * SHM_V;
  ATT_LAS float* ws = (ATT_LAS float*)(lds + 2 * SHM_V + 2 * SHM_K) + wid * 64; ATT_LAS float* li_l = ws; ATT_LAS float* al_l = ws + 32;
  float m_reg = -1e30f, l_reg = 0; f32x16 o[4] = {}; bf16x8 qr[NQR];
  const bf16* Qw = Qb + (long)(wid * QBLK + r32) * ldq + hi * 8;
  ATT_LAS char* qx = lds + 2 * SHM_V + 2 * SHM_K + NW * 64 * 4 + wid * ((NQK - NQR) * 1024) + lane * 16;
#pragma unroll
  for (int d0 = 0; d0 < NQR; ++d0) qr[d0] = *(const bf16x8*)(Qw + d0 * 16);
#pragma unroll
  for (int d0 = NQR; d0 < NQK; ++d0) *(ATT_LAS bf16x8*)(qx + (d0 - NQR) * 1024) = *(const bf16x8*)(Qw + d0 * 16);
  const int sr = tid >> 4, sc = (tid & 15) * 8, vst0 = v_st(sr, sc), vst1 = v_st(32 + sr, sc);
  const int sr2 = tid >> 3, sc2 = (tid & 7) * 8;
  const int vb0 = (int)(unsigned)(size_t)V_lds + v_rd_base(lane);
  struct { bf16x8 vs0, vs1, ks[KCH]; } sr_[SD];
#define ATT_SLOAD(i, k0) do { sr_[i].vs0 = *(const bf16x8*)(&Vh[(long)((k0) + sr) * ldv + sc]); sr_[i].vs1 = *(const bf16x8*)(&Vh[(long)((k0) + 32 + sr) * ldv + sc]); \
    sr_[i].ks[0] = *(const bf16x8*)(&KA[(long)((k0) + sr) * ldka + sc]); sr_[i].ks[1] = *(const bf16x8*)(&KA[(long)((k0) + 32 + sr) * ldka + sc]); \
    if constexpr (KCH == 3) sr_[i].ks[2] = *(const bf16x8*)(&KB[(long)((k0) + sr2) * ldkb + sc2]); } while (0)
#define ATT_SWRITE(b, i) do { *(ATT_LAS bf16x8*)(V_lds + (b) * SHM_V + vst0) = sr_[i].vs0; *(ATT_LAS bf16x8*)(V_lds + (b) * SHM_V + vst1) = sr_[i].vs1; \
    *(ATT_LAS bf16x8*)(K_lds + (b) * SHM_K + kswz<NQK>(sr, sc * 2)) = sr_[i].ks[0]; *(ATT_LAS bf16x8*)(K_lds + (b) * SHM_K + kswz<NQK>(32 + sr, sc * 2)) = sr_[i].ks[1]; \
    if constexpr (KCH == 3) *(ATT_LAS bf16x8*)(K_lds + (b) * SHM_K + kswz<NQK>(sr2, 256 + sc2 * 2)) = sr_[i].ks[2]; } while (0)
#define ATT_SWAIT() do { if constexpr (SD == 2) { if constexpr (NLD == 4) asm volatile("s_waitcnt vmcnt(4)" ::: "memory"); else asm volatile("s_waitcnt vmcnt(5)" ::: "memory"); } else asm volatile("s_waitcnt vmcnt(0)" ::: "memory"); } while (0)
#define ATT_RESC(a) do { if (__any((a) < 1.f)) { if (hi == 0) al_l[r32] = (a); asm volatile("s_waitcnt lgkmcnt(0)" ::: "memory"); \
    _Pragma("unroll") for (int d = 0; d < 4; ++d) _Pragma("unroll") for (int r = 0; r < 16; ++r) o[d][r] *= al_l[crow(r, hi)]; } } while (0)
  f32x16 pA0, pA1, pB0, pB1; float mnA, mnB, alA, alB; bf16x8 pa0, pa1, pa2, pa3; const int NT = seq / KVBLK;
  constexpr int SE = 0, SO = SD - 1;
  ATT_SLOAD(SE, 0); asm volatile("s_waitcnt vmcnt(0)" ::: "memory"); ATT_SWRITE(0, SE); __syncthreads();
  qkt<NQK, NQR>(pA0, pA1, K_lds, qr, qx, r32, hi); partialSM(pA0, pA1, m_reg, mnA, alA, C, thr_raw);
  ATT_SLOAD(SO, KVBLK); if constexpr (SD == 2) { if (2 < NT) ATT_SLOAD(SE, 2 * KVBLK); }
  ATT_SWAIT(); ATT_SWRITE(1, SO); __syncthreads();
  for (int j = 1; j + 1 < NT; j += 2) {
    ATT_SBAR(); qkt<NQK, NQR>(pB0, pB1, K_lds + SHM_K, qr, qx, r32, hi);
    finishSM(pA0, pA1, alA, l_reg, pa0, pa1, pa2, pa3); ATT_SBAR();
    ATT_SLOAD(SO, (j + SD) * KVBLK); ATT_SBAR();
    pv_d0(o, vb0, pa0, pa1, pa2, pa3); partialSM(pB0, pB1, m_reg, mnB, alB, C, thr_raw);
    __syncthreads(); ATT_SWAIT(); ATT_SWRITE(0, SE);
    ATT_RESC(alB); __syncthreads();
    ATT_SBAR(); qkt<NQK, NQR>(pA0, pA1, K_lds, qr, qx, r32, hi);
    finishSM(pB0, pB1, alB, l_reg, pa0, pa1, pa2, pa3); ATT_SBAR();
    if (SD == 1 || j + 3 < NT) ATT_SLOAD(SE, (j + 1 + SD) * KVBLK); ATT_SBAR();
    pv_d0(o, vb0 + SHM_V, pa0, pa1, pa2, pa3); partialSM(pA0, pA1, m_reg, mnA, alA, C, thr_raw);
    __syncthreads(); ATT_SWAIT(); ATT_SWRITE(1, SO);
    ATT_RESC(alA); __syncthreads();
  }
  ATT_SBAR(); qkt<NQK, NQR>(pB0, pB1, K_lds + SHM_K, qr, qx, r32, hi);
  finishSM(pA0, pA1, alA, l_reg, pa0, pa1, pa2, pa3); ATT_SBAR();
  pv_d0(o, vb0, pa0, pa1, pa2, pa3); partialSM(pB0, pB1, m_reg, mnB, alB, C, thr_raw);
  __syncthreads(); ATT_RESC(alB);
  finishSM(pB0, pB1, alB, l_reg, pa0, pa1, pa2, pa3); ATT_SBAR();
  pv_d0(o, vb0 + SHM_V, pa0, pa1, pa2, pa3);
  if (hi == 0) li_l[r32] = l_reg; asm volatile("s_waitcnt lgkmcnt(0)" ::: "memory");
  float rli[16];
#pragma unroll
  for (int r = 0; r < 16; ++r) rli[r] = __builtin_amdgcn_rcpf(li_l[crow(r, hi)]);
  bf16* Ow = Ob + (long)(wid * QBLK) * ldo;
#pragma unroll
  for (int r = 0; r < 16; ++r) { const int orow = crow(r, hi);
#pragma unroll
    for (int d0 = 0; d0 < 4; ++d0) { const float v = o[d0][r] * rli[r]; const unsigned u = __float_as_uint(v); Ow[(long)orow * ldo + d0 * 32 + r32] = (bf16)((u + 0x7fffu + ((u >> 16) & 1u)) >> 16); } }
  __syncthreads();
#undef ATT_SLOAD
#undef ATT_SWRITE
#undef ATT_SWAIT
#undef ATT_RESC
}
}

namespace scan {
using bf16x8 = __attribute__((ext_vector_type(8))) short;
using s16x4  = __attribute__((ext_vector_type(4))) short;
using f32x16 = __attribute__((ext_vector_type(16))) float;
using u32x4  = __attribute__((ext_vector_type(4))) unsigned;
using u32x2  = __attribute__((ext_vector_type(2))) unsigned;
typedef unsigned short bf16;
#define SC_LAS __attribute__((address_space(3)))
#define SC_GAS __attribute__((address_space(1)))
__device__ __forceinline__ unsigned off_b(unsigned row, unsigned ch) { return 256u * row + 16u * (ch ^ (((row & 3u) << 2) | ((row >> 2) & 3u))); }
__device__ __forceinline__ unsigned row_rd(unsigned lane, unsigned s) { return off_b(lane & 31u, 2u * s + (lane >> 5)); }
__device__ __forceinline__ unsigned tr_rd(unsigned lane, unsigned c, unsigned ks, unsigned t) {
    const unsigned h = lane >> 5, blk = (lane >> 4) & 1u, q = (lane & 15u) >> 2, p = lane & 3u;
    return off_b(16u * ks + 8u * h + 4u * t + q, 4u * c + 2u * blk + (p >> 1)) + 8u * (p & 1u);
}
__device__ __forceinline__ int crow(int r, int hi) { return (r & 3) + 8 * (r >> 2) + 4 * hi; }
__device__ __forceinline__ unsigned cvtpk(float lo, float hi) { unsigned r; asm volatile("v_cvt_pk_bf16_f32 %0, %1, %2" : "=v"(r) : "v"(lo), "v"(hi)); return r; }
__device__ __forceinline__ s16x4 trr(unsigned addr) { s16x4 r; asm volatile("ds_read_b64_tr_b16 %0, %1" : "=v"(r) : "v"(addr) : "memory"); return r; }
#define SC_PK(L, H) (bf16x8){L[0], L[1], L[2], L[3], H[0], H[1], H[2], H[3]}
#define SC_PK4(P, BASE, OUT) do { unsigned a0 = cvtpk(P[BASE + 0], P[BASE + 1]), a1 = cvtpk(P[BASE + 2], P[BASE + 3]);   \
    unsigned b0 = cvtpk(P[BASE + 4], P[BASE + 5]), b1 = cvtpk(P[BASE + 6], P[BASE + 7]);                              \
    auto r0 = __builtin_amdgcn_permlane32_swap(a0, b0, false, false); auto r1 = __builtin_amdgcn_permlane32_swap(a1, b1, false, false); \
    u32x4 w = {r0[0], r1[0], r0[1], r1[1]}; OUT = __builtin_bit_cast(bf16x8, w); } while (0)
#define SC_MFMA(a, b, c) __builtin_amdgcn_mfma_f32_32x32x16_bf16((a), (b), (c), 0, 0, 0)

constexpr int KOFF = 0, VOFF = 32768, QOFF = 49152, TOFF = 81920, LDS_NEED = 147456;

__device__ __forceinline__ void ret_scan_mfma(const bf16* __restrict__ P, bf16* __restrict__ SO, const float* lgf, const float* lgb, SC_LAS unsigned char* lds, int tid) {
    constexpr int LDP = 12288, SR = 4352, MR = 17408;
    const unsigned lane = tid & 63; const int wave = __builtin_amdgcn_readfirstlane(tid >> 6), cb = wave >> 2, dvb = wave & 3, hi = lane >> 5, r32 = lane & 31;
    const unsigned ldsb = (unsigned)(size_t)lds;
    const unsigned rb_i = 256u * r32, m4_i = ((((unsigned)r32 & 3u) << 2) | (((unsigned)r32 >> 2) & 3u)) << 4, xk_i = m4_i ^ ((unsigned)hi << 4);
    const unsigned vtr0_i = ldsb + VOFF + tr_rd(lane, dvb, 0, 0), vtr1_i = ldsb + VOFF + tr_rd(lane, dvb, 0, 1);
    const unsigned ktb0_i = ldsb + KOFF + cb * 8192 + tr_rd(lane, 0, 0, 0), ktb1_i = ldsb + KOFF + cb * 8192 + tr_rd(lane, 0, 0, 1), q6_i = ((lane & 15u) >> 2) << 6;
    const int kr0 = tid >> 5, kc = tid & 31, vr0 = tid >> 4, vc = tid & 15;
    const unsigned kst0 = (kc >> 4) * 8192 + off_b(kr0, kc & 15), vst0 = off_b(vr0, vc);
    const unsigned kgo = (unsigned)(kr0 * LDP + kc * 8) * 2u, vgo = (unsigned)(vr0 * LDP + vc * 8) * 2u;
    for (int u = blockIdx.x; u < 256; u += gridDim.x) {
        const int b = u >> 6, h = (u >> 3) & 7, dir = (u >> 2) & 1, vs = u & 3;
        const float lg2 = (dir ? lgb : lgf)[h] * 1.4426950408889634f;
        const float g64 = __builtin_amdgcn_exp2f(64.0f * lg2);
        const float vsc0 = __builtin_amdgcn_exp2f((float)(dir ? vr0 : 63 - vr0) * lg2), vsc1 = __builtin_amdgcn_exp2f((float)(dir ? vr0 + 32 : 31 - vr0) * lg2);
        const int crow_i = cb * 32 + r32;
        const float osc = __builtin_amdgcn_exp2f((float)(dir ? -crow_i : crow_i - 63) * lg2);
        const SC_GAS char* Pq = (const SC_GAS char*)(P + (size_t)b * SR * LDP + h * 256);
        const SC_GAS char* Pv = (const SC_GAS char*)(P + (size_t)b * SR * LDP + 4096 + h * 512 + vs * 128);
        bf16* Ob = SO + ((size_t)dir * MR + (size_t)b * SR) * 4096 + h * 512 + vs * 128;
        f32x16 S[4];
#pragma unroll
        for (int j = 0; j < 4; ++j) S[j] = f32x16{};
        u32x4 kq[4], qq[4], vq[2];
#define chunk_base(n) (dir ? ((n) < 4 ? 256 - 64 * ((n) + 1) : SR - 64 * ((n) - 3)) : 64 * (n))
#define SC_GLOAD(n) do { const size_t cbo = (size_t)chunk_base(n) * (LDP * 2); \
        _Pragma("unroll") for (int j = 0; j < 4; ++j) { const SC_GAS char* pj = Pq + cbo + (size_t)j * (16 * LDP * 2); qq[j] = *(const SC_GAS u32x4*)(pj + kgo); kq[j] = *(const SC_GAS u32x4*)(pj + 4096 + kgo); } \
        _Pragma("unroll") for (int j = 0; j < 2; ++j) { const SC_GAS char* pj = Pv + cbo + (size_t)j * (32 * LDP * 2); vq[j] = *(const SC_GAS u32x4*)(pj + vgo); } } while (0)
        SC_GLOAD(0);
        for (int n = 0; n < 68; ++n) {
            unsigned rb = rb_i, m4 = m4_i, xk = xk_i, q6 = q6_i;
            asm volatile("" : "+v"(rb), "+v"(m4), "+v"(xk), "+v"(q6));
            __syncthreads();
#pragma unroll
            for (int j = 0; j < 4; ++j) {
#pragma unroll
                for (int r = 0; r < 16; ++r) S[j][r] *= g64;
#pragma unroll
                for (int g = 0; g < 4; ++g) { u32x2 w; w.x = cvtpk(S[j][4 * g], S[j][4 * g + 1]); w.y = cvtpk(S[j][4 * g + 2], S[j][4 * g + 3]);
                    *(SC_LAS u32x2*)(lds + TOFF + (dvb * 2 + cb) * 8192 + rb + (((unsigned)(4 * j + g) << 4) ^ m4) + 8 * hi) = w; }
            }
#pragma unroll
            for (int j = 0; j < 4; ++j) { *(SC_LAS u32x4*)(lds + KOFF + kst0 + (j & 1) * 4096 + (j >> 1) * 16384) = kq[j]; *(SC_LAS u32x4*)(lds + QOFF + kst0 + (j & 1) * 4096 + (j >> 1) * 16384) = qq[j]; }
#pragma unroll
            for (int j = 0; j < 2; ++j) { const u32x4 w = vq[j]; const float sc = j ? vsc1 : vsc0; u32x4 o;
                o.x = cvtpk(__uint_as_float(w.x << 16) * sc, __uint_as_float(w.x & 0xffff0000u) * sc); o.y = cvtpk(__uint_as_float(w.y << 16) * sc, __uint_as_float(w.y & 0xffff0000u) * sc);
                o.z = cvtpk(__uint_as_float(w.z << 16) * sc, __uint_as_float(w.z & 0xffff0000u) * sc); o.w = cvtpk(__uint_as_float(w.w << 16) * sc, __uint_as_float(w.w & 0xffff0000u) * sc);
                *(SC_LAS u32x4*)(lds + VOFF + vst0 + j * 8192) = o; }
            __syncthreads();
            if (n + 1 < 68) SC_GLOAD(n + 1);
            const bool need1 = dir ? true : (cb == 1);
            const bool use0 = dir ? (cb == 0) : true;
            f32x16 p0 = f32x16{}, p1 = f32x16{}, oT = f32x16{};
#pragma unroll 1
            for (int cq = 0; cq < 2; ++cq) {
                const unsigned sub = cq * 8192;
#pragma unroll
                for (int s8 = 0; s8 < 8; ++s8) {
                    const unsigned ra = rb + ((32u * s8) ^ xk) + sub;
                    const bf16x8 qf = *(const SC_LAS bf16x8*)(lds + ra + QOFF + cb * 16384);
                    const bf16x8 tf = *(const SC_LAS bf16x8*)(lds + ra + TOFF + dvb * 16384);
                    oT = SC_MFMA(tf, qf, oT);
                    if (use0) { const bf16x8 k0 = *(const SC_LAS bf16x8*)(lds + ra + KOFF + 0 * 16384); p0 = SC_MFMA(k0, qf, p0); }
                    if (need1) { const bf16x8 k1 = *(const SC_LAS bf16x8*)(lds + ra + KOFF + 1 * 16384); p1 = SC_MFMA(k1, qf, p1); }
                }
            }
#pragma unroll
            for (int r = 0; r < 16; ++r) { const int sr = crow(r, hi); const bool keep = dir ? (sr >= r32) : (sr <= r32);
                if (cb == 0) p0[r] = keep ? p0[r] : 0.f; else p1[r] = keep ? p1[r] : 0.f; }
            bf16x8 pa0, pa1, pa2, pa3; SC_PK4(p0, 0, pa0); SC_PK4(p0, 8, pa1); SC_PK4(p1, 0, pa2); SC_PK4(p1, 8, pa3);
            bf16x8 vf[4];
            { s16x4 l[4], hh[4];
#pragma unroll
              for (int kp = 0; kp < 4; ++kp) { l[kp] = trr(vtr0_i + (kp >> 1) * 8192 + (kp & 1) * 4096); hh[kp] = trr(vtr1_i + (kp >> 1) * 8192 + (kp & 1) * 4096); }
              asm volatile("s_waitcnt lgkmcnt(0)" : "+v"(l[0]), "+v"(l[1]), "+v"(l[2]), "+v"(l[3]), "+v"(hh[0]), "+v"(hh[1]), "+v"(hh[2]), "+v"(hh[3]) :: "memory");
#pragma unroll
              for (int kp = 0; kp < 4; ++kp) vf[kp] = SC_PK(l[kp], hh[kp]); }
            if (use0) { oT = SC_MFMA(vf[0], pa0, oT); oT = SC_MFMA(vf[1], pa1, oT); }
            if (need1) { oT = SC_MFMA(vf[2], pa2, oT); oT = SC_MFMA(vf[3], pa3, oT); }
            { bf16* op = Ob + (size_t)(chunk_base(n) + crow_i) * 4096 + dvb * 32 + 4 * hi;
#pragma unroll
              for (int g = 0; g < 4; ++g) { u32x2 w; w.x = cvtpk(oT[4 * g] * osc, oT[4 * g + 1] * osc); w.y = cvtpk(oT[4 * g + 2] * osc, oT[4 * g + 3] * osc); *(SC_GAS u32x2*)(op + 8 * g) = w; } }
#pragma unroll
            for (int c = 0; c < 4; ++c) {
                const unsigned cx = (((unsigned)c << 6) ^ q6) - q6;
                s16x4 l[4], hh[4];
#pragma unroll
                for (int kp = 0; kp < 4; ++kp) { l[kp] = trr(ktb0_i + cx + (kp >> 1) * 16384 + (kp & 1) * 4096); hh[kp] = trr(ktb1_i + cx + (kp >> 1) * 16384 + (kp & 1) * 4096); }
                asm volatile("s_waitcnt lgkmcnt(0)" : "+v"(l[0]), "+v"(l[1]), "+v"(l[2]), "+v"(l[3]), "+v"(hh[0]), "+v"(hh[1]), "+v"(hh[2]), "+v"(hh[3]) :: "memory");
#pragma unroll
                for (int kp = 0; kp < 4; ++kp) S[c] = SC_MFMA(SC_PK(l[kp], hh[kp]), vf[kp], S[c]);
            }
        }
#undef SC_GLOAD
#undef chunk_base
        __syncthreads();
    }
}
}

#define GAS __attribute__((address_space(1)))
#define LAS __attribute__((address_space(3)))
typedef unsigned short bf16;
typedef unsigned v4u __attribute__((ext_vector_type(4)));
typedef float f32x4 __attribute__((ext_vector_type(4)));
typedef short bf16x8 __attribute__((ext_vector_type(8)));
typedef GAS unsigned gu32;
typedef GAS unsigned long long gu64;
#define RLX_AGENT __ATOMIC_RELAXED, __HIP_MEMORY_SCOPE_AGENT
#define LDS_WAIT() asm volatile("s_waitcnt lgkmcnt(0)" ::: "memory")
#define VM_WAIT() asm volatile("s_waitcnt vmcnt(0)" ::: "memory")
__device__ __forceinline__ unsigned long long rt() { return __builtin_amdgcn_s_memrealtime(); }
__device__ __forceinline__ unsigned f2bf(float f) { unsigned u = __builtin_bit_cast(unsigned, f); return (u + 0x7fffu + ((u >> 16) & 1u)) >> 16; }
__device__ __forceinline__ unsigned pk2(float lo, float hi) { return f2bf(lo) | (f2bf(hi) << 16); }

#define XB_TMO      128
#define XB_XCNT(j)  (256  + 64 * (j))
#define XB_XSUB(j)  (1280 + 64 * (j))
#define XB_XGEN(j)  (2304 + 64 * (j))
#define XB_TOP      3328
#define XB_TOPGEN   3392
#define XCD_BAR_WORDS 3456
#define XB_SPIN_CAP (1u << 18)

__device__ __forceinline__ unsigned xb_ld(unsigned* p)              { return __hip_atomic_load(p, __ATOMIC_RELAXED, __HIP_MEMORY_SCOPE_AGENT); }
__device__ __forceinline__ unsigned xb_add(unsigned* p, unsigned v) { return __hip_atomic_fetch_add(p, v, __ATOMIC_RELAXED, __HIP_MEMORY_SCOPE_AGENT); }
__device__ __forceinline__ unsigned xb_xcc_id() { return (unsigned)__builtin_amdgcn_s_getreg((3 << 11) | 20) & 0xFu; }
#define XB_SPIN(cond, bar) do { unsigned _sp = 0; while (cond) { __builtin_amdgcn_s_sleep(1); \
    if ((++_sp & 255u) == 0u) { if (xb_ld(&(bar)[XB_TMO])) break; if (_sp > XB_SPIN_CAP) { atomicAdd(&(bar)[XB_TMO], 1u); break; } } } } while (0)

struct XcdBarrier {
    unsigned* bar; unsigned x;
    volatile LAS unsigned* st;
};

__device__ __forceinline__ XcdBarrier xcd_barrier_post(unsigned* bar, volatile LAS unsigned* st) {
    XcdBarrier b; b.bar = bar; b.x = xb_xcc_id(); b.st = st;
    if (threadIdx.x == 0) (void)xb_add(&bar[XB_XCNT(b.x)], 1u);
    return b;
}
__device__ __forceinline__ void xcd_barrier_complete(unsigned* bar, unsigned x, unsigned& nloc, unsigned& nx) {
    const unsigned G = gridDim.x * gridDim.y * gridDim.z;
    unsigned sum, cnt, mine, sp = 0u;
    for (;;) {
        sum = 0u; cnt = 0u; mine = 0u;
#pragma unroll
        for (unsigned j = 0; j < 16; ++j) { const unsigned c = xb_ld(&bar[XB_XCNT(j)]); sum += c; cnt += (c > 0u) ? 1u : 0u; mine = (j == x) ? c : mine; }
        if (sum == G) break;
        __builtin_amdgcn_s_sleep(1);
        if ((++sp & 255u) == 0u) { if (xb_ld(&bar[XB_TMO])) break; if (sp > XB_SPIN_CAP) { atomicAdd(&bar[XB_TMO], 1u); break; } }
    }
    nloc = mine > 0u ? mine : 1u; nx = cnt > 0u ? cnt : 1u;
}

__device__ __forceinline__ void xcd_barrier(const XcdBarrier& b) {
    asm volatile("s_waitcnt vmcnt(0)" ::: "memory");
    __syncthreads();
    if (threadIdx.x == 0) {
        unsigned* bar = b.bar;
        __builtin_amdgcn_s_waitcnt(0);
        unsigned nloc = b.st[0], nx = b.st[1];
        if (nloc == 0u) { xcd_barrier_complete(bar, b.x, nloc, nx); b.st[0] = nloc; b.st[1] = nx; }
        const unsigned old = xb_add(&bar[XB_XSUB(b.x)], 1u);
        const unsigned gen = old / nloc;
        if (old + 1u == (gen + 1u) * nloc) {
            __builtin_amdgcn_fence(__ATOMIC_RELEASE, "agent");
            asm volatile("s_waitcnt vmcnt(0)" ::: "memory");
            const unsigned og = xb_add(&bar[XB_TOP], 1u);
            const unsigned tg = og / nx;
            if (og + 1u == (tg + 1u) * nx) xb_add(&bar[XB_TOPGEN], 1u);
            else XB_SPIN(xb_ld(&bar[XB_TOPGEN]) == tg, bar);
            __builtin_amdgcn_fence(__ATOMIC_ACQUIRE, "agent");
            xb_add(&bar[XB_XGEN(b.x)], 1u);
            asm volatile("s_waitcnt vmcnt(0)" ::: "memory");
        } else {
            XB_SPIN(xb_ld(&bar[XB_XGEN(b.x)]) == gen, bar);
            __builtin_amdgcn_fence(__ATOMIC_ACQUIRE, "agent");
            asm volatile("s_waitcnt vmcnt(0)" ::: "memory");
        }
    }
    __syncthreads();
}
constexpr int DM = 2048, NBATCH = 4, SEQ = 4096, CTXL = 256, SROWS = SEQ + CTXL, MROWS = NBATCH * SROWS;
constexpr int FFH = 5632;
constexpr int RET_N = 12288, GQA_N = 3072, MLA_NP = 1280, MLA_NACT = 1088, MLA_QN = 3072, MLA_KVN = 4096, HG_N = 10240;
constexpr float LN_EPS = 1e-6f, DN_ALPHA = 1.681792830507429f;
constexpr int NWAVES = 8;
constexpr size_t MiB = 1u << 20;
constexpr size_t WS_CTL = 0, CTL_ZERO_BYTES = 1 * MiB;
constexpr size_t WS_MODS = 1 * MiB, WS_TAB = 2 * MiB;
constexpr size_t WS_W_RET_IN = 4 * MiB, WS_W_RET_OUT = 52 * MiB, WS_W_GQA_IN = 68 * MiB, WS_W_GQA_OUT = 80 * MiB, WS_W_MLA_IN = 88 * MiB, WS_W_MLA_QUP = 93 * MiB, WS_W_MLA_KVUP = 96 * MiB,
                 WS_W_MLA_OUT = 100 * MiB, WS_W_HG_IN = 108 * MiB, WS_W_HG_OUT = 148 * MiB, WS_W_FFN_IN = 156 * MiB, WS_W_FFN_OUT = 332 * MiB;
constexpr size_t FFN_IN_BYTES = 44 * MiB, FFN_OUT_BYTES = 22 * MiB;
constexpr size_t WS_X = 420 * MiB, WS_R1 = 556 * MiB, WS_PROJ = 692 * MiB, WS_SCY = 1100 * MiB, WS_END = 1372 * MiB;
constexpr size_t PJ_MLA_Q = 0, PJ_MLA_KV = 102 * MiB, PJ_MLA_C = 238 * MiB, PJ_MLA_CQN = 281 * MiB, PJ_MLA_CKVN = 298 * MiB, PJ_MLA_KR = 315 * MiB;
constexpr int CW_BAR = 4096;
constexpr int TAB_R = 0, TAB_G = 64 * 64 * 2, TAB_M = TAB_G + 64 * 32 * 2;
constexpr int LDS_BYTES = 150528, MISC_OFF = LDS_BYTES - 512;

typedef __attribute__((ext_vector_type(4))) unsigned short bf16x4v;
typedef __attribute__((ext_vector_type(2))) unsigned u32x2v;
typedef __attribute__((ext_vector_type(2))) float f32x2v;

__device__ __forceinline__ float bf2f(unsigned short b) { return __uint_as_float(((unsigned)b) << 16); }
__device__ __forceinline__ float bflo(unsigned w) { return __uint_as_float(w << 16); }
__device__ __forceinline__ float bfhi(unsigned w) { return __uint_as_float(w & 0xffff0000u); }
__device__ __forceinline__ float wave_sum(float v) {
#pragma unroll
    for (int o = 1; o < 64; o <<= 1) v += __shfl_xor(v, o);
    return v;
}
__device__ __forceinline__ float silu_f(float x) { return x / (1.0f + __expf(-x)); }
__device__ __forceinline__ float sigmoid_f(float x) { return 1.0f / (1.0f + __expf(-x)); }
__device__ __forceinline__ void unpack8(const v4u w, float* f) { f[0] = bflo(w.x); f[1] = bfhi(w.x); f[2] = bflo(w.y); f[3] = bfhi(w.y); f[4] = bflo(w.z); f[5] = bfhi(w.z); f[6] = bflo(w.w); f[7] = bfhi(w.w); }
__device__ __forceinline__ v4u pack8(const float* f) { v4u w; w.x = pk2(f[0], f[1]); w.y = pk2(f[2], f[3]); w.z = pk2(f[4], f[5]); w.w = pk2(f[6], f[7]); return w; }

struct Args {
    const float *x, *c, *ctx, *c_ctx, *ada_w, *ada_b, *ln_g, *ln_b, *ffn_w_in, *ffn_w_out;
    const float *ret_w_in, *ret_df, *ret_db, *ret_w_out;
    const float *gqa_w_in, *gqa_qn, *gqa_kn, *gqa_w_out;
    const float *mla_w_in, *mla_qn, *mla_w_qup, *mla_kvn, *mla_w_kvup, *mla_w_out;
    const float *hg_w_in, *hg_lb_raw, *hg_on, *hg_w_out;
    float* out; unsigned char* ws; int ph_lo, ph_hi, use_bar, pad;
};

__device__ __forceinline__ void transpose_item(const float* W, int K, int Nact, bf16* WT, int k0, int n0, int act_n0, LAS float* scr, int lane) {
    if (act_n0 >= 0) {
#pragma unroll 8
        for (int i = 0; i < 32; ++i) { const int kk = 2 * i + (lane >> 5); scr[kk * 33 + (lane & 31)] = W[(size_t)(k0 + kk) * Nact + act_n0 + (lane & 31)]; }
    } else {
#pragma unroll 8
        for (int i = 0; i < 32; ++i) { const int kk = 2 * i + (lane >> 5); scr[kk * 33 + (lane & 31)] = 0.f; }
    }
    LDS_WAIT(); asm volatile("" ::: "memory");
    const int c = lane & 7;
#pragma unroll
    for (int j = 0; j < 4; ++j) { const int n = (lane >> 3) + 8 * j; const LAS float* s = scr + (8 * c) * 33 + n;
        v4u o; o.x = pk2(s[0 * 33], s[1 * 33]); o.y = pk2(s[2 * 33], s[3 * 33]); o.z = pk2(s[4 * 33], s[5 * 33]); o.w = pk2(s[6 * 33], s[7 * 33]);
        *(GAS v4u*)(WT + (size_t)(n0 + n) * K + k0 + 8 * c) = o; }
    LDS_WAIT(); asm volatile("" ::: "memory");
}
template <int PERMK> __device__ __forceinline__ void transpose_w(const float* W, int K, int Nact, int Nv, bf16* WT, int item, LAS float* scr, int lane) {
    const int nblk = Nv / 32, kb = item / nblk, nb = item % nblk, n0 = 32 * nb;
    int act = n0;
    if (PERMK == 1) { const int pn = n0 >> 8, rem = n0 & 255; act = (rem >> 7) * FFH + 128 * pn + (rem & 127); }
    if (PERMK == 2) { if (n0 >= Nact) act = -1; }
    transpose_item(W, K, Nact, WT, 64 * kb, n0, act, scr, lane);
}

struct RowInfo { int b, s, ctx, mi, gr, gc; };
__device__ __forceinline__ RowInfo row_info(int r) { RowInfo q; q.b = r / SROWS; q.s = r - q.b * SROWS; q.ctx = q.s < CTXL; q.mi = q.ctx ? 4 : q.b; const int t = q.s - CTXL; q.gr = t >> 6; q.gc = t & 63; return q; }

__device__ __forceinline__ void mods_unit(const Args& a, int l, int cg, LAS float* red, int tid, int lane, int wave) {
    float sreg[5][4];
#pragma unroll
    for (int j = 0; j < 5; ++j)
#pragma unroll
        for (int i = 0; i < 4; ++i) { const int k = 256 * wave + 64 * i + lane; const float cv = (j < 4) ? a.c[j * DM + k] : a.c_ctx[k]; sreg[j][i] = silu_f(cv); }
    f32x4 acc[5];
#pragma unroll
    for (int j = 0; j < 5; ++j) acc[j] = (f32x4){0.f, 0.f, 0.f, 0.f};
    const float* wp = a.ada_w + ((size_t)l * DM + 256 * wave) * 12288 + cg * 256 + 4 * lane;
#pragma unroll
    for (int i = 0; i < 4; ++i) {
#pragma unroll 8
        for (int kk = 0; kk < 64; ++kk) {
            const f32x4 w4 = *(const GAS f32x4*)(wp + (size_t)(64 * i + kk) * 12288);
#pragma unroll
            for (int j = 0; j < 5; ++j) { const float sj = __uint_as_float(__builtin_amdgcn_readlane(__float_as_uint(sreg[j][i]), kk)); acc[j] += sj * w4; }
        }
    }
#pragma unroll
    for (int j = 0; j < 5; ++j) *(LAS f32x4*)(red + (wave * 5 + j) * 256 + 4 * lane) = acc[j];
    __syncthreads();
    for (int o = tid; o < 1280; o += 512) { const int j = o >> 8, col = o & 255; float s = a.ada_b[l * 12288 + cg * 256 + col];
#pragma unroll
        for (int w = 0; w < 8; ++w) s += red[(w * 5 + j) * 256 + col];
        ((float*)(a.ws + WS_MODS))[(size_t)(l * 5 + j) * 12288 + cg * 256 + col] = s; }
    __syncthreads();
}
__device__ __forceinline__ void rope_tables(const Args& a, int gtid, int gthreads) {
    float* tab = (float*)(a.ws + WS_TAB);
    for (int i = gtid; i < 64 * 64 + 64 * 32 + 64 * 16; i += gthreads) {
        int nf, base, idx = i;
        if (idx < 64 * 64) { nf = 64; base = TAB_R; } else if (idx < 64 * 64 + 64 * 32) { idx -= 64 * 64; nf = 32; base = TAB_G; } else { idx -= 64 * 64 + 64 * 32; nf = 16; base = TAB_M; }
        const int pos = idx / nf, j = idx % nf;
        const float freq = powf(10000.0f, -(float)j / (float)nf);
        const float ang = (float)pos * freq;
        tab[base + 2 * idx] = cosf(ang); tab[base + 2 * idx + 1] = sinf(ang);
    }
}
__device__ __forceinline__ void init_rows(const Args& a, int gw, int NGW, int lane) {
    float* X = (float*)(a.ws + WS_X); bf16* H = (bf16*)(a.ws + WS_R1); const float* mods = (const float*)(a.ws + WS_MODS);
    for (int r = gw; r < MROWS; r += NGW) {
        const RowInfo q = row_info(r);
        const float* src = q.ctx ? a.ctx + ((size_t)q.b * CTXL + q.s) * DM : a.x + ((size_t)q.b * SEQ + (q.s - CTXL)) * DM;
        const float* mp = mods + (size_t)(0 * 5 + q.mi) * 12288;
#pragma unroll
        for (int j = 0; j < 8; ++j) { const int c = 4 * lane + 256 * j; const f32x4 v = *(const GAS f32x4*)(src + c);
            *(GAS f32x4*)(X + (size_t)r * DM + c) = v;
            const f32x4 sh = *(const GAS f32x4*)(mp + c), sc = *(const GAS f32x4*)(mp + 2048 + c);
            const f32x4 h = v * (1.0f + sc) + sh; u32x2v w; w.x = pk2(h[0], h[1]); w.y = pk2(h[2], h[3]);
            *(GAS u32x2v*)(H + (size_t)r * DM + c) = w; }
    }
}
__device__ __forceinline__ void ln_rows(const Args& a, int l, int which, int gw, int NGW, int lane) {
    float* X = (float*)(a.ws + WS_X); const float* Y = (const float*)(a.ws + WS_SCY); bf16* H = (bf16*)(a.ws + WS_R1); const float* mods = (const float*)(a.ws + WS_MODS);
    const float* lng = a.ln_g + (size_t)(l * 2 + which) * DM; const float* lnb = a.ln_b + (size_t)(l * 2 + which) * DM;
    const bool last = (l == 3 && which == 1);
    const int gate_i = which ? 5 : 2, nl = which ? l + 1 : l, nsh = which ? 0 : 3, nsc = which ? 1 : 4;
    for (int r = gw; r < MROWS; r += NGW) {
        const RowInfo q = row_info(r);
        const float* gp = mods + (size_t)(l * 5 + q.mi) * 12288 + gate_i * 2048;
        f32x4 z[8]; float s = 0.f;
#pragma unroll
        for (int j = 0; j < 8; ++j) { const int c = 4 * lane + 256 * j; const f32x4 xv = *(const GAS f32x4*)(X + (size_t)r * DM + c), yv = *(const GAS f32x4*)(Y + (size_t)r * DM + c), gv = *(const GAS f32x4*)(gp + c);
            z[j] = DN_ALPHA * xv + gv * yv; s += (z[j][0] + z[j][1]) + (z[j][2] + z[j][3]); }
        const float mean = wave_sum(s) * (1.0f / DM); float s2 = 0.f;
#pragma unroll
        for (int j = 0; j < 8; ++j) { z[j] = z[j] - mean; s2 += (z[j][0] * z[j][0] + z[j][1] * z[j][1]) + (z[j][2] * z[j][2] + z[j][3] * z[j][3]); }
        const float rstd = 1.0f / sqrtf(wave_sum(s2) * (1.0f / DM) + LN_EPS);
        const float* mp = mods + (size_t)((last ? 0 : nl) * 5 + q.mi) * 12288;
#pragma unroll
        for (int j = 0; j < 8; ++j) { const int c = 4 * lane + 256 * j; const f32x4 g4 = *(const GAS f32x4*)(lng + c), b4 = *(const GAS f32x4*)(lnb + c);
            const f32x4 xn = z[j] * rstd * g4 + b4;
            if (last) { if (!q.ctx) *(GAS f32x4*)(a.out + ((size_t)q.b * SEQ + (q.s - CTXL)) * DM + c) = xn; }
            else { *(GAS f32x4*)(X + (size_t)r * DM + c) = xn;
                const f32x4 sh = *(const GAS f32x4*)(mp + nsh * 2048 + c), sc = *(const GAS f32x4*)(mp + nsc * 2048 + c);
                const f32x4 h = xn * (1.0f + sc) + sh; u32x2v w; w.x = pk2(h[0], h[1]); w.y = pk2(h[2], h[3]);
                *(GAS u32x2v*)(H + (size_t)r * DM + c) = w; } }
    }
}
__device__ __forceinline__ void ret_rope_rows(const Args& a, int gw, int NGW, int lane) {
    bf16* P = (bf16*)(a.ws + WS_PROJ); const float* tab = (const float*)(a.ws + WS_TAB) + TAB_R;
    for (int r = gw; r < MROWS; r += NGW) {
        const RowInfo q = row_info(r);
#pragma unroll
        for (int i = 0; i < 4; ++i) { const int it = lane + 64 * i, tensor = it >> 7, head = (it >> 4) & 7, half = (it >> 3) & 1, grp = it & 7;
            bf16* p1 = P + (size_t)r * RET_N + tensor * 2048 + head * 256 + half * 128 + grp * 8; bf16* p2 = p1 + 64;
            if (q.ctx && tensor == 0) continue;
            float x1[8], x2[8]; unpack8(*(const GAS v4u*)p1, x1); unpack8(*(const GAS v4u*)p2, x2);
            const float ksc = tensor ? 0.0625f : 1.0f;
            float o1[8], o2[8];
            if (!q.ctx) { const int pos = half ? q.gc : q.gr; const float* tp = tab + (pos * 64 + grp * 8) * 2;
#pragma unroll
                for (int e = 0; e < 8; ++e) { const float cs = tp[2 * e], sn = tp[2 * e + 1]; o1[e] = (x1[e] * cs - x2[e] * sn) * ksc; o2[e] = (x1[e] * sn + x2[e] * cs) * ksc; } }
            else {
#pragma unroll
                for (int e = 0; e < 8; ++e) { o1[e] = x1[e] * ksc; o2[e] = x2[e] * ksc; } }
            *(GAS v4u*)p1 = pack8(o1); *(GAS v4u*)p2 = pack8(o2); }
    }
}
__device__ __forceinline__ void gqa_normrope_rows(const Args& a, int gw, int NGW, int lane) {
    bf16* P = (bf16*)(a.ws + WS_PROJ); const float* tab = (const float*)(a.ws + WS_TAB) + TAB_G;
    const int li = lane & 15, hsub = lane >> 4;
    const int half = li >> 3, second = (li >> 2) & 1, fj0 = (li & 3) * 8;
    for (int r = gw; r < MROWS; r += NGW) {
        const RowInfo q = row_info(r);
#pragma unroll
        for (int pass = 0; pass < 5; ++pass) { const int head = pass * 4 + hsub;
            bf16* p = P + (size_t)r * GQA_N + head * 128 + li * 8;
            const float* gain = (head < 16 ? a.gqa_qn : a.gqa_kn) + li * 8;
            float x[8]; unpack8(*(const GAS v4u*)p, x);
            float ss = 0.f;
#pragma unroll
            for (int e = 0; e < 8; ++e) ss += x[e] * x[e];
            ss += __shfl_xor(ss, 1); ss += __shfl_xor(ss, 2); ss += __shfl_xor(ss, 4); ss += __shfl_xor(ss, 8);
            const float rs = 1.0f / sqrtf(ss * (1.0f / 128.0f) + LN_EPS);
#pragma unroll
            for (int e = 0; e < 8; ++e) x[e] = x[e] * rs * gain[e];
            float o[8];
            if (!q.ctx) { const int pos = half ? q.gc : q.gr; const float* tp = tab + (pos * 32 + fj0) * 2;
#pragma unroll
                for (int e = 0; e < 8; ++e) { const float other = __shfl_xor(x[e], 4); const float cs = tp[2 * e], sn = tp[2 * e + 1];
                    o[e] = second ? (other * sn + x[e] * cs) : (x[e] * cs - other * sn); } }
            else {
#pragma unroll
                for (int e = 0; e < 8; ++e) o[e] = x[e]; }
            *(GAS v4u*)p = pack8(o); }
    }
}
__device__ __forceinline__ void mla_norm_rows(const Args& a, int gw, int NGW, int lane) {
    const bf16* C = (const bf16*)(a.ws + WS_PROJ + PJ_MLA_C); bf16* CQN = (bf16*)(a.ws + WS_PROJ + PJ_MLA_CQN); bf16* CKVN = (bf16*)(a.ws + WS_PROJ + PJ_MLA_CKVN); bf16* KR = (bf16*)(a.ws + WS_PROJ + PJ_MLA_KR);
    const float* tab = (const float*)(a.ws + WS_TAB) + TAB_M;
    for (int r = gw; r < MROWS; r += NGW) {
        const RowInfo q = row_info(r);
#pragma unroll
        for (int t = 0; t < 2; ++t) { float x[8]; unpack8(*(const GAS v4u*)(C + (size_t)r * MLA_NP + t * 512 + lane * 8), x);
            float ss = 0.f;
#pragma unroll
            for (int e = 0; e < 8; ++e) ss += x[e] * x[e];
            const float rs = 1.0f / sqrtf(wave_sum(ss) * (1.0f / 512.0f) + LN_EPS);
            const float* gain = (t ? a.mla_kvn : a.mla_qn) + lane * 8; float o[8];
#pragma unroll
            for (int e = 0; e < 8; ++e) o[e] = x[e] * rs * gain[e];
            *(GAS v4u*)((t ? CKVN : CQN) + (size_t)r * 512 + lane * 8) = pack8(o); }
        { const float xv = bf2f(C[(size_t)r * MLA_NP + 1024 + lane]); const float other = __shfl_xor(xv, 16);
          float ov = xv;
          if (!q.ctx) { const int half = lane >> 5, second = (lane >> 4) & 1, fj = lane & 15; const int pos = half ? q.gc : q.gr; const float cs = tab[(pos * 16 + fj) * 2], sn = tab[(pos * 16 + fj) * 2 + 1];
              ov = second ? (other * sn + xv * cs) : (xv * cs - other * sn); }
          KR[(size_t)r * 64 + lane] = (bf16)f2bf(ov); }
    }
}
__device__ __forceinline__ void mla_qrope_rows(const Args& a, int gw, int NGW, int lane) {
    bf16* Q = (bf16*)(a.ws + WS_PROJ + PJ_MLA_Q); const float* tab = (const float*)(a.ws + WS_TAB) + TAB_M;
    const int li = lane & 7, hsub = lane >> 3;
    const int half = li >> 2, second = (li >> 1) & 1, fj0 = (li & 1) * 8;
    for (int r = gw; r < MROWS; r += NGW) {
        const RowInfo q = row_info(r);
        if (q.ctx) continue;
#pragma unroll
        for (int pass = 0; pass < 2; ++pass) { const int head = pass * 8 + hsub;
            bf16* p = Q + (size_t)r * MLA_QN + head * 192 + 128 + li * 8;
            float x[8]; unpack8(*(const GAS v4u*)p, x);
            const int pos = half ? q.gc : q.gr; const float* tp = tab + (pos * 16 + fj0) * 2; float o[8];
#pragma unroll
            for (int e = 0; e < 8; ++e) { const float other = __shfl_xor(x[e], 2); const float cs = tp[2 * e], sn = tp[2 * e + 1];
                o[e] = second ? (other * sn + x[e] * cs) : (x[e] * cs - other * sn); }
            *(GAS v4u*)p = pack8(o); }
    }
}
__device__ __forceinline__ void ret_readout_rows(const Args& a, int gw, int NGW, int lane) {
    const bf16* SO = (const bf16*)(a.ws + WS_SCY); const bf16* P = (const bf16*)(a.ws + WS_PROJ); bf16* A2 = (bf16*)(a.ws + WS_R1);
    for (int r = gw; r < MROWS; r += NGW) {
#pragma unroll
        for (int h = 0; h < 8; ++h) { const int c = h * 512 + lane * 8;
            float f[8], b[8], g[8]; unpack8(*(const GAS v4u*)(SO + (size_t)r * 4096 + c), f); unpack8(*(const GAS v4u*)(SO + ((size_t)MROWS + r) * 4096 + c), b);
            unpack8(*(const GAS v4u*)(P + (size_t)r * RET_N + 8192 + c), g);
            float ss = 0.f;
#pragma unroll
            for (int e = 0; e < 8; ++e) { f[e] += b[e]; ss += f[e] * f[e]; }
            const float rs = 1.0f / sqrtf(wave_sum(ss) * (1.0f / 512.0f) + LN_EPS); float o[8];
#pragma unroll
            for (int e = 0; e < 8; ++e) o[e] = f[e] * rs * silu_f(g[e]);
            *(GAS v4u*)(A2 + (size_t)r * 4096 + c) = pack8(o); }
    }
}
__device__ __forceinline__ void hg_readout_rows(const Args& a, int gw, int NGW, int lane) {
    const bf16* SO = (const bf16*)(a.ws + WS_SCY); const bf16* P = (const bf16*)(a.ws + WS_PROJ); bf16* A2 = (bf16*)(a.ws + WS_R1);
    const int li = lane & 15;
    for (int r = gw; r < MROWS; r += NGW) {
#pragma unroll
        for (int pass = 0; pass < 4; ++pass) { const int c = pass * 512 + lane * 8;
            float f[8], b[8], g[8]; unpack8(*(const GAS v4u*)(SO + (size_t)r * 2048 + c), f); unpack8(*(const GAS v4u*)(SO + ((size_t)MROWS + r) * 2048 + c), b);
            unpack8(*(const GAS v4u*)(P + (size_t)r * HG_N + 8192 + c), g);
            float ss = 0.f;
#pragma unroll
            for (int e = 0; e < 8; ++e) { f[e] += b[e]; ss += f[e] * f[e]; }
            ss += __shfl_xor(ss, 1); ss += __shfl_xor(ss, 2); ss += __shfl_xor(ss, 4); ss += __shfl_xor(ss, 8);
            const float rs = 1.0f / sqrtf(ss * (1.0f / 128.0f) + LN_EPS); const float* gain = a.hg_on + li * 8; float o[8];
#pragma unroll
            for (int e = 0; e < 8; ++e) o[e] = f[e] * rs * gain[e] * silu_f(g[e]);
            *(GAS v4u*)(A2 + (size_t)r * 2048 + c) = pack8(o); }
    }
}
__device__ __forceinline__ int scan_row(int p, int dir) { return dir ? (p < CTXL ? CTXL - 1 - p : SROWS + CTXL - 1 - p) : p; }
__device__ __forceinline__ void ret_scan_simple(const Args& a, LAS unsigned char* lds, int tid) {
    const bf16* P = (const bf16*)(a.ws + WS_PROJ); bf16* SO = (bf16*)(a.ws + WS_SCY);
    LAS float* qs = (LAS float*)lds; LAS float* ks = qs + 16 * 256; LAS float* vsm = ks + 16 * 256; LAS float* op = vsm + 16 * 128;
    const int dv = tid & 127, g = tid >> 7;
    for (int u = blockIdx.x; u < 256; u += gridDim.x) {
        const int b = u >> 6, h = (u >> 3) & 7, dir = (u >> 2) & 1, vs = u & 3;
        const float gamma = expf((dir ? a.ret_db : a.ret_df)[h]);
        float S[64];
#pragma unroll
        for (int j = 0; j < 64; ++j) S[j] = 0.f;
        for (int p0 = 0; p0 < SROWS; p0 += 16) {
            { const int pp = tid >> 5, ch = tid & 31; const size_t row = (size_t)b * SROWS + scan_row(p0 + pp, dir);
              float f[8]; unpack8(*(const GAS v4u*)(P + row * RET_N + h * 256 + ch * 8), f);
              *(LAS f32x4*)(qs + pp * 256 + ch * 8) = (f32x4){f[0], f[1], f[2], f[3]}; *(LAS f32x4*)(qs + pp * 256 + ch * 8 + 4) = (f32x4){f[4], f[5], f[6], f[7]};
              unpack8(*(const GAS v4u*)(P + row * RET_N + 2048 + h * 256 + ch * 8), f);
              *(LAS f32x4*)(ks + pp * 256 + ch * 8) = (f32x4){f[0], f[1], f[2], f[3]}; *(LAS f32x4*)(ks + pp * 256 + ch * 8 + 4) = (f32x4){f[4], f[5], f[6], f[7]};
              const u32x2v w = *(const GAS u32x2v*)(P + row * RET_N + 4096 + h * 512 + vs * 128 + ch * 4);
              *(LAS f32x4*)(vsm + pp * 128 + ch * 4) = (f32x4){bflo(w.x), bfhi(w.x), bflo(w.y), bfhi(w.y)}; }
            __syncthreads();
            for (int pp = 0; pp < 16; ++pp) {
                const float vv = vsm[pp * 128 + dv]; float acc = 0.f;
#pragma unroll
                for (int j4 = 0; j4 < 16; ++j4) { const f32x4 k4 = *(const LAS f32x4*)(ks + pp * 256 + 64 * g + 4 * j4), q4 = *(const LAS f32x4*)(qs + pp * 256 + 64 * g + 4 * j4);
#pragma unroll
                    for (int e = 0; e < 4; ++e) { S[4 * j4 + e] = fmaf(gamma, S[4 * j4 + e], k4[e] * vv); acc = fmaf(q4[e], S[4 * j4 + e], acc); } }
                op[(pp * 4 + g) * 128 + dv] = acc;
            }
            __syncthreads();
#pragma unroll
            for (int i = 0; i < 4; ++i) { const int idx = tid + 512 * i, pp = idx >> 7, d = idx & 127;
                const float o = (op[(pp * 4 + 0) * 128 + d] + op[(pp * 4 + 1) * 128 + d]) + (op[(pp * 4 + 2) * 128 + d] + op[(pp * 4 + 3) * 128 + d]);
                const size_t row = (size_t)b * SROWS + scan_row(p0 + pp, dir);
                SO[((size_t)dir * MROWS + row) * 4096 + h * 512 + vs * 128 + d] = (bf16)f2bf(o); }
        }
        __syncthreads();
    }
}
__device__ __forceinline__ void hg_scan_simple(const Args& a, LAS unsigned char* lds, int tid) {
    const bf16* P = (const bf16*)(a.ws + WS_PROJ); bf16* SO = (bf16*)(a.ws + WS_SCY);
    LAS float* qs = (LAS float*)lds; LAS float* fs = qs + 16 * 128; LAS float* kk = fs + 16 * 128; LAS float* is = kk + 16 * 128; LAS float* op = is + 16 * 64; LAS float* lbs = op + 16 * 8 * 64;
    const int dv = tid & 63, g8 = tid >> 6;
    for (int u = blockIdx.x; u < 256; u += gridDim.x) {
        const int b = u >> 6, h = (u >> 2) & 15, dir = (u >> 1) & 1, vs = u & 1;
        if (tid < 128) { const int col = h * 128 + tid; const float r0 = a.hg_lb_raw[col], r1 = a.hg_lb_raw[2048 + col], r2 = a.hg_lb_raw[4096 + col], r3 = a.hg_lb_raw[6144 + col];
            const float mx = fmaxf(fmaxf(r0, r1), fmaxf(r2, r3)); const float e0 = expf(r0 - mx), e1 = expf(r1 - mx), e2 = expf(r2 - mx), e3 = expf(r3 - mx); const float sum = (e0 + e1) + (e2 + e3);
            const float p0 = e0 / sum, p1 = e1 / sum, p2 = e2 / sum, p3 = e3 / sum; lbs[tid] = (((p0 + p1) + p2) + p3) - p0; }
        __syncthreads();
        float S[16];
#pragma unroll
        for (int j = 0; j < 16; ++j) S[j] = 0.f;
        for (int p0 = 0; p0 < SROWS; p0 += 16) {
            { const int pp = tid >> 5, ch = tid & 31; const size_t row = (size_t)b * SROWS + scan_row(p0 + pp, dir);
              const u32x2v wq = *(const GAS u32x2v*)(P + row * HG_N + h * 128 + ch * 4), wf = *(const GAS u32x2v*)(P + row * HG_N + (dir ? 4096 : 2048) + h * 128 + ch * 4);
              const float qv[4] = {bflo(wq.x), bfhi(wq.x), bflo(wq.y), bfhi(wq.y)}, fv[4] = {bflo(wf.x), bfhi(wf.x), bflo(wf.y), bfhi(wf.y)};
              f32x4 qo, fo, ko;
#pragma unroll
              for (int e = 0; e < 4; ++e) { const float lb = lbs[ch * 4 + e]; const float f = lb + (1.0f - lb) * sigmoid_f(fv[e]); qo[e] = silu_f(qv[e]); fo[e] = f; ko[e] = 1.0f - f; }
              *(LAS f32x4*)(qs + pp * 128 + ch * 4) = qo; *(LAS f32x4*)(fs + pp * 128 + ch * 4) = fo; *(LAS f32x4*)(kk + pp * 128 + ch * 4) = ko;
              const unsigned wi = *(const GAS unsigned*)(P + row * HG_N + 6144 + h * 128 + vs * 64 + ch * 2);
              *(LAS f32x2v*)(is + pp * 64 + ch * 2) = (f32x2v){bflo(wi), bfhi(wi)}; }
            __syncthreads();
            for (int pp = 0; pp < 16; ++pp) {
                const float iv = is[pp * 64 + dv]; float acc = 0.f;
#pragma unroll
                for (int j4 = 0; j4 < 4; ++j4) { const f32x4 f4 = *(const LAS f32x4*)(fs + pp * 128 + 16 * g8 + 4 * j4), k4 = *(const LAS f32x4*)(kk + pp * 128 + 16 * g8 + 4 * j4), q4 = *(const LAS f32x4*)(qs + pp * 128 + 16 * g8 + 4 * j4);
#pragma unroll
                    for (int e = 0; e < 4; ++e) { S[4 * j4 + e] = fmaf(f4[e], S[4 * j4 + e], k4[e] * iv); acc = fmaf(q4[e], S[4 * j4 + e], acc); } }
                op[(pp * 8 + g8) * 64 + dv] = acc;
            }
            __syncthreads();
#pragma unroll
            for (int i = 0; i < 2; ++i) { const int idx = tid + 512 * i, pp = idx >> 6, d = idx & 63; float o = 0.f;
#pragma unroll
                for (int w = 0; w < 8; ++w) o += op[(pp * 8 + w) * 64 + d];
                const size_t row = (size_t)b * SROWS + scan_row(p0 + pp, dir);
                SO[((size_t)dir * MROWS + row) * 2048 + h * 128 + vs * 64 + d] = (bf16)f2bf(o); }
        }
        __syncthreads();
    }
}
constexpr int NPH = 2 + 11 * 4;
#define IN(k) (lo <= (k) && (k) < hi)
#define SEAM(k) do { if (a.use_bar && hi > (k) + 1) xcd_barrier(bar); } while (0)
template <int l> __device__ __forceinline__ void run_layer(const Args& a, LAS unsigned char* lds, const XcdBarrier& bar, int tid, int lane, int wave, int G, int gw, int NGW) {
    const int lo = a.ph_lo, hi = a.ph_hi; unsigned char* ws = a.ws;
    bf16* const H = (bf16*)(ws + WS_R1); bf16* const PROJ = (bf16*)(ws + WS_PROJ); float* const Y = (float*)(ws + WS_SCY);
        const int pb = 2 + 11 * l;
        if (IN(pb)) {
            const bf16* Bt; int N; bf16* O;
            if (l == 0) { Bt = (const bf16*)(ws + WS_W_RET_IN); N = RET_N; O = PROJ; }
            else if (l == 1) { Bt = (const bf16*)(ws + WS_W_GQA_IN); N = GQA_N; O = PROJ; }
            else if (l == 2) { Bt = (const bf16*)(ws + WS_W_MLA_IN); N = MLA_NP; O = (bf16*)(ws + WS_PROJ + PJ_MLA_C); }
            else { Bt = (const bf16*)(ws + WS_W_HG_IN); N = HG_N; O = PROJ; }
            pg8::Gemm g{H, Bt, MROWS, N, DM}; pg8::StaticOrder S; S.init(MROWS, N, G, (int)blockIdx.x); pg8::EpiBf16P E{O, N};
            pg8::gemm_phase<pg8::EpiBf16P, pg8::StaticOrder, true, true>(lds, g, S, E);
            SEAM(pb);
        }
        if (IN(pb + 1) && l != 3) {
            if (l == 0) ret_rope_rows(a, gw, NGW, lane); else if (l == 1) gqa_normrope_rows(a, gw, NGW, lane); else mla_norm_rows(a, gw, NGW, lane);
            SEAM(pb + 1);
        }
        if (IN(pb + 2) && l == 2) {
            { pg8::Gemm g{(const bf16*)(ws + WS_PROJ + PJ_MLA_CQN), (const bf16*)(ws + WS_W_MLA_QUP), MROWS, MLA_QN, 512}; pg8::StaticOrder S; S.init(MROWS, MLA_QN, G, (int)blockIdx.x);
              pg8::EpiBf16P E{(bf16*)(ws + WS_PROJ + PJ_MLA_Q), MLA_QN}; pg8::gemm_phase<pg8::EpiBf16P, pg8::StaticOrder, true, true>(lds, g, S, E); }
            { pg8::Gemm g{(const bf16*)(ws + WS_PROJ + PJ_MLA_CKVN), (const bf16*)(ws + WS_W_MLA_KVUP), MROWS, MLA_KVN, 512}; pg8::StaticOrder S; S.init(MROWS, MLA_KVN, G, (int)blockIdx.x);
              pg8::EpiBf16P E{(bf16*)(ws + WS_PROJ + PJ_MLA_KV), MLA_KVN}; pg8::gemm_phase<pg8::EpiBf16P, pg8::StaticOrder, true, true>(lds, g, S, E); }
            SEAM(pb + 2);
        }
        if (IN(pb + 3) && l == 2) { mla_qrope_rows(a, gw, NGW, lane); SEAM(pb + 3); }
        if (IN(pb + 4)) {
            if (l == 0) scan::ret_scan_mfma((const bf16*)(ws + WS_PROJ), (bf16*)(ws + WS_SCY), a.ret_df, a.ret_db, lds, tid);
            else if (l == 3) hg_scan_simple(a, lds, tid);
            else {
                bf16* const A2 = (bf16*)(ws + WS_R1);
                for (int uidx = blockIdx.x; uidx < 1088; uidx += G) {
                    int b, h, qb, ctxu = 0;
                    if (uidx < 1024) { const int x = uidx & 7, y = (uidx >> 3) & 31, rnd = uidx >> 8;
                        if (l == 1) { const int combo = 2 * x + (y >> 4), w = (y & 15) + 16 * rnd; b = combo >> 2; h = (combo & 3) * 4 + (w >> 4); qb = w & 15; }
                        else { const int combo = 2 * x + (y >> 4) + 16 * rnd; b = combo >> 4; h = combo & 15; qb = y & 15; } }
                    else { const int c = uidx - 1024; b = c >> 4; h = c & 15; qb = 0; ctxu = 1; }
                    const size_t rb = (size_t)b * SROWS, r0 = rb + (ctxu ? 0 : CTXL + qb * 256); const int seq = ctxu ? CTXL : SROWS;
                    if (l == 1) { const bf16* QKV = PROJ; const int kvh = h >> 2;
                        att::attn_unit<8, 8, 2, GQA_N, GQA_N, GQA_N, GQA_N, DM>(QKV + r0 * GQA_N + h * 128, QKV + rb * GQA_N + 2048 + kvh * 128, QKV + rb * GQA_N + 2048 + kvh * 128,
                                             QKV + rb * GQA_N + 2560 + kvh * 128, A2 + r0 * DM + h * 128, seq, 0.08838834764831845f * 1.4426950408889634f, 8.0f / 0.08838834764831845f, (ATT_LAS char*)lds); }
                    else { const bf16* Q = (const bf16*)(ws + WS_PROJ + PJ_MLA_Q); const bf16* KV = (const bf16*)(ws + WS_PROJ + PJ_MLA_KV); const bf16* KR = (const bf16*)(ws + WS_PROJ + PJ_MLA_KR);
                        att::attn_unit<12, 4, 1, MLA_QN, MLA_KVN, 64, MLA_KVN, DM>(Q + r0 * MLA_QN + h * 192, KV + rb * MLA_KVN + h * 256, KR + rb * 64,
                                              KV + rb * MLA_KVN + h * 256 + 128, A2 + r0 * DM + h * 128, seq, 0.07216878364870323f * 1.4426950408889634f, 8.0f / 0.07216878364870323f, (ATT_LAS char*)lds); }
                }
            }
            SEAM(pb + 4);
        }
        if (IN(pb + 5) && (l == 0 || l == 3)) { if (l == 0) ret_readout_rows(a, gw, NGW, lane); else hg_readout_rows(a, gw, NGW, lane); SEAM(pb + 5); }
        if (IN(pb + 6)) {
            const bf16* Bt = (const bf16*)(ws + (l == 0 ? WS_W_RET_OUT : l == 1 ? WS_W_GQA_OUT : l == 2 ? WS_W_MLA_OUT : WS_W_HG_OUT)); const int K = (l == 0) ? 4096 : DM;
            pg8::Gemm g{(const bf16*)(ws + WS_R1), Bt, MROWS, DM, K}; pg8::StaticOrder S; S.init(MROWS, DM, G, (int)blockIdx.x); pg8::EpiF32P E{Y, DM};
            pg8::gemm_phase<pg8::EpiF32P, pg8::StaticOrder, true, true>(lds, g, S, E);
            SEAM(pb + 6);
        }
        if (IN(pb + 7)) { ln_rows(a, l, 0, gw, NGW, lane); SEAM(pb + 7); }
        if (IN(pb + 8)) {
            pg8::Gemm g{H, (const bf16*)(ws + WS_W_FFN_IN + l * FFN_IN_BYTES), MROWS, 2 * FFH, DM}; pg8::StaticOrder S; S.init(MROWS, 2 * FFH, G, (int)blockIdx.x); pg8::EpiSwiglu E{PROJ, FFH};
            pg8::gemm_phase<pg8::EpiSwiglu, pg8::StaticOrder, true, true>(lds, g, S, E);
            SEAM(pb + 8);
        }
        if (IN(pb + 9)) {
            pg8::Gemm g{PROJ, (const bf16*)(ws + WS_W_FFN_OUT + l * FFN_OUT_BYTES), MROWS, DM, FFH}; pg8::StaticOrder S; S.init(MROWS, DM, G, (int)blockIdx.x); pg8::EpiF32P E{Y, DM};
            pg8::gemm_phase<pg8::EpiF32P, pg8::StaticOrder, true, true>(lds, g, S, E);
            SEAM(pb + 9);
        }
        if (IN(pb + 10)) { ln_rows(a, l, 1, gw, NGW, lane); SEAM(pb + 10); }
    }
__global__ void __launch_bounds__(NWAVES * 64, 2) mk_fwd(Args a) {
    extern __shared__ __attribute__((aligned(16))) unsigned char lds_raw[];
    LAS unsigned char* lds = (LAS unsigned char*)lds_raw;
    const int tid = threadIdx.x, lane = tid & 63, wave = __builtin_amdgcn_readfirstlane(tid >> 6);
    const int G = gridDim.x, gw = blockIdx.x * NWAVES + wave, NGW = G * NWAVES;
    volatile LAS unsigned* MISC = (volatile LAS unsigned*)(lds + MISC_OFF);
    if (tid < 128) ((LAS unsigned*)(lds + MISC_OFF))[tid] = 0u;
    __syncthreads();
    gu32* ctl = (gu32*)(a.ws + WS_CTL);
    XcdBarrier bar; bar.bar = (unsigned*)ctl + CW_BAR; bar.x = 0; bar.st = nullptr;
    if (a.use_bar) bar = xcd_barrier_post((unsigned*)ctl + CW_BAR, MISC + 8);
    const int lo = a.ph_lo, hi = a.ph_hi;
    unsigned char* ws = a.ws;
    bf16* const H = (bf16*)(ws + WS_R1); bf16* const PROJ = (bf16*)(ws + WS_PROJ); float* const Y = (float*)(ws + WS_SCY);

    if (IN(0)) {
        LAS float* scr = (LAS float*)(lds + wave * 16384);
        constexpr int I_RI = 32 * (RET_N / 32), I_RO = 64 * 64, I_GI = 32 * (GQA_N / 32), I_GO = 32 * 64, I_MI = 32 * (MLA_NP / 32), I_MQ = 8 * (MLA_QN / 32), I_MK = 8 * (MLA_KVN / 32), I_MO = 32 * 64,
                      I_HI = 32 * (HG_N / 32), I_HO = 32 * 64, I_FI = 32 * (2 * FFH / 32), I_FO = (FFH / 64) * 64;
        constexpr int NITEMS = I_RI + I_RO + I_GI + I_GO + I_MI + I_MQ + I_MK + I_MO + I_HI + I_HO + 4 * I_FI + 4 * I_FO;
        for (int it = gw; it < NITEMS; it += NGW) {
            int r = it;
            if (r < I_RI) { transpose_w<0>(a.ret_w_in, DM, RET_N, RET_N, (bf16*)(ws + WS_W_RET_IN), r, scr, lane); continue; } r -= I_RI;
            if (r < I_RO) { transpose_w<0>(a.ret_w_out, 4096, DM, DM, (bf16*)(ws + WS_W_RET_OUT), r, scr, lane); continue; } r -= I_RO;
            if (r < I_GI) { transpose_w<0>(a.gqa_w_in, DM, GQA_N, GQA_N, (bf16*)(ws + WS_W_GQA_IN), r, scr, lane); continue; } r -= I_GI;
            if (r < I_GO) { transpose_w<0>(a.gqa_w_out, DM, DM, DM, (bf16*)(ws + WS_W_GQA_OUT), r, scr, lane); continue; } r -= I_GO;
            if (r < I_MI) { transpose_w<2>(a.mla_w_in, DM, MLA_NACT, MLA_NP, (bf16*)(ws + WS_W_MLA_IN), r, scr, lane); continue; } r -= I_MI;
            if (r < I_MQ) { transpose_w<0>(a.mla_w_qup, 512, MLA_QN, MLA_QN, (bf16*)(ws + WS_W_MLA_QUP), r, scr, lane); continue; } r -= I_MQ;
            if (r < I_MK) { transpose_w<0>(a.mla_w_kvup, 512, MLA_KVN, MLA_KVN, (bf16*)(ws + WS_W_MLA_KVUP), r, scr, lane); continue; } r -= I_MK;
            if (r < I_MO) { transpose_w<0>(a.mla_w_out, DM, DM, DM, (bf16*)(ws + WS_W_MLA_OUT), r, scr, lane); continue; } r -= I_MO;
            if (r < I_HI) { transpose_w<0>(a.hg_w_in, DM, HG_N, HG_N, (bf16*)(ws + WS_W_HG_IN), r, scr, lane); continue; } r -= I_HI;
            if (r < I_HO) { transpose_w<0>(a.hg_w_out, DM, DM, DM, (bf16*)(ws + WS_W_HG_OUT), r, scr, lane); continue; } r -= I_HO;
            if (r < 4 * I_FI) { const int l = r / I_FI; transpose_w<1>(a.ffn_w_in + (size_t)l * DM * 2 * FFH, DM, 2 * FFH, 2 * FFH, (bf16*)(ws + WS_W_FFN_IN + l * FFN_IN_BYTES), r % I_FI, scr, lane); continue; } r -= 4 * I_FI;
            { const int l = r / I_FO; transpose_w<0>(a.ffn_w_out + (size_t)l * FFH * DM, FFH, DM, DM, (bf16*)(ws + WS_W_FFN_OUT + l * FFN_OUT_BYTES), r % I_FO, scr, lane); }
        }
        __syncthreads();
        for (int u = blockIdx.x; u < 192; u += G) mods_unit(a, u / 48, u % 48, (LAS float*)lds, tid, lane, wave);
        rope_tables(a, blockIdx.x * (NWAVES * 64) + tid, G * NWAVES * 64);
        SEAM(0);
    }
    if (IN(1)) { init_rows(a, gw, NGW, lane); SEAM(1); }

    run_layer<0>(a, lds, bar, tid, lane, wave, G, gw, NGW);
    run_layer<1>(a, lds, bar, tid, lane, wave, G, gw, NGW);
    run_layer<2>(a, lds, bar, tid, lane, wave, G, gw, NGW);
    run_layer<3>(a, lds, bar, tid, lane, wave, G, gw, NGW);
}

#ifndef MK_PER_PHASE
#define MK_PER_PHASE 0
#endif
extern "C" void kernel_launch(void* const* d_in, const int* in_sizes, int n_in, void* d_out, int out_size, void* d_ws, size_t ws_size, hipStream_t stream) {
    static int grid = 0;
    if (grid == 0) {
        if (n_in != 28 || out_size != NBATCH * SEQ * DM || ws_size < WS_END) { fprintf(stderr, "kernel_launch: unexpected shapes (n_in %d out %d ws %zu)\n", n_in, out_size, ws_size); grid = -1; return; }
        int dev = 0, cus = 0, per_cu = 0;
        if (hipGetDevice(&dev) != hipSuccess || hipDeviceGetAttribute(&cus, hipDeviceAttributeMultiprocessorCount, dev) != hipSuccess) { grid = -1; return; }
        if (hipFuncSetAttribute((const void*)mk_fwd, hipFuncAttributeMaxDynamicSharedMemorySize, LDS_BYTES) != hipSuccess) { fprintf(stderr, "kernel_launch: hipFuncSetAttribute failed\n"); grid = -1; return; }
        if (hipOccupancyMaxActiveBlocksPerMultiprocessor(&per_cu, (const void*)mk_fwd, NWAVES * 64, LDS_BYTES) != hipSuccess || per_cu < 1) { fprintf(stderr, "kernel_launch: occupancy query says %d\n", per_cu); }
        (void)hipGetLastError();
        grid = cus;
    }
    if (grid < 0) return;
    if (hipMemsetAsync((char*)d_ws + WS_CTL, 0, CTL_ZERO_BYTES, stream) != hipSuccess) return;
    Args a{};
    const float** ap = (const float**)&a;
    for (int i = 0; i < 28; ++i) ap[i] = (const float*)d_in[i];
    a.out = (float*)d_out; a.ws = (unsigned char*)d_ws; a.pad = 0;
#if MK_PER_PHASE
    for (int p = 0; p < NPH; ++p) { a.ph_lo = p; a.ph_hi = p + 1; a.use_bar = 0; hipLaunchKernelGGL(mk_fwd, dim3(grid), dim3(NWAVES * 64), LDS_BYTES, stream, a); }
#else
    a.ph_lo = 0; a.ph_hi = NPH; a.use_bar = 1;
    hipLaunchKernelGGL(mk_fwd, dim3(grid), dim3(NWAVES * 64), LDS_BYTES, stream, a);
#endif
    const hipError_t le = hipPeekAtLastError();
    if (le != hipSuccess) fprintf(stderr, "kernel_launch: launch failed: %s\n", hipGetErrorName(le));
}
```

```cpp
#include <hip/hip_runtime.h>
#include <hip/hip_bf16.h>
#include <cstdio>
#include <cstdint>
namespace pg8 {
#define PG8_LAS __attribute__((address_space(3)))
typedef unsigned short bf16_t;
typedef short bf16x8 __attribute__((ext_vector_type(8)));
typedef float f32x4 __attribute__((ext_vector_type(4)));
typedef unsigned u32x4 __attribute__((ext_vector_type(4)));
constexpr int BM = 256, BK = 64, HALF = 128, HTB = HALF * BK * 2  , STAGE_BYTES = 8 * HTB, NXCD = 8, WGM = 8;

__host__ __device__ __forceinline__ int lds_byte(int r, int c) { const int st = (r >> 4) * 2 + (c >> 5), rr = r & 15, cc = c & 31, ob = rr * 64 + cc * 2; return st * 1024 + (ob ^ (((ob >> 9) & 1) << 5)); }
__host__ __device__ __forceinline__ void stage_rc(int b, int& R, int& C) { const int st = b / 1024, sb = b % 1024, swz = sb ^ (((sb >> 9) & 1) << 5); R = (st >> 1) * 16 + swz / 64; C = (st & 1) * 32 + (swz % 64) / 2; }
__host__ __device__ __forceinline__ int perm32(int rho) { const int n = rho >> 4, i = rho & 15; return 8 * (i >> 2) + 4 * n + (i & 3); }

struct Unit { int pm, pn; };
struct Gemm { const bf16_t* A; const bf16_t* Bt; int M, N, K; };

struct StaticOrder {
    int nM, nN, nwg, G, c;
    __host__ __device__ void init(int M, int N, int G_, int c_) { nM = M / BM; nN = N / BM; nwg = nM * nN; G = G_; c = c_; }
    __host__ __device__ bool next(int i, Unit& u) const {
        const long L = (long)i * G + c; if (L >= nwg) return false;
        int wgid = (int)L; { const int q = nwg / NXCD, r = nwg % NXCD, xcd = wgid % NXCD, off = wgid / NXCD; wgid = (xcd < r ? xcd * (q + 1) : r * (q + 1) + (xcd - r) * q) + off; }
        const int nig = WGM * nN, gid = wgid / nig, fm = gid * WGM, gsz = (nM - fm) < WGM ? (nM - fm) : WGM;
        u.pm = fm + ((wgid % nig) % gsz); u.pn = (wgid % nig) / gsz; return true;
    }
    __device__ __forceinline__ void a_ready(const Unit&) const {}
    __device__ __forceinline__ void done(const Unit&) const {}
};

__device__ __forceinline__ unsigned cvt_pk_bf16(float lo, float hi) { unsigned r; asm volatile("v_cvt_pk_bf16_f32 %0, %1, %2" : "=v"(r) : "v"(lo), "v"(hi)); return r; }
struct EpiBf16P {
    static constexpr bool PERM = true, AFTER_DRAIN = false;
    bf16_t* O; int ldc;
    __device__ __forceinline__ void operator()(const f32x4 (&acc)[2][2][4][2], const Unit& u, int wr, int wc, int fr, int fq) const {
        const int row0 = u.pm * BM + wr * 64 + fr, col0 = u.pn * BM + wc * 32 + 8 * fq;
#pragma unroll
        for (int ai = 0; ai < 2; ++ai)
#pragma unroll
            for (int m = 0; m < 4; ++m) { bf16_t* rowp = O + (size_t)(row0 + ai * HALF + m * 16) * ldc + col0;
#pragma unroll
                for (int bj = 0; bj < 2; ++bj) { const f32x4 v0 = acc[ai][bj][m][0], v1 = acc[ai][bj][m][1];
                    u32x4 w; w.x = cvt_pk_bf16(v0[0], v0[1]); w.y = cvt_pk_bf16(v0[2], v0[3]); w.z = cvt_pk_bf16(v1[0], v1[1]); w.w = cvt_pk_bf16(v1[2], v1[3]);
                    *(u32x4*)(rowp + bj * HALF) = w; } }
    }
};
struct EpiF32P {
    static constexpr bool PERM = false, AFTER_DRAIN = false;
    float* C; int ldc;
    __device__ __forceinline__ void operator()(const f32x4 (&acc)[2][2][4][2], const Unit& u, int wr, int wc, int fr, int fq) const {
        const int row0 = u.pm * BM + wr * 64 + fr, col0 = u.pn * BM + wc * 32 + 4 * fq;
#pragma unroll
        for (int ai = 0; ai < 2; ++ai)
#pragma unroll
            for (int m = 0; m < 4; ++m) { float* rowp = C + (size_t)(row0 + ai * HALF + m * 16) * ldc + col0;
#pragma unroll
                for (int bj = 0; bj < 2; ++bj)
#pragma unroll
                    for (int n = 0; n < 2; ++n) *(f32x4*)(rowp + bj * HALF + n * 16) = acc[ai][bj][m][n]; }
    }
};
__device__ __forceinline__ float silu_mul(float a, float b) { return a * b * __builtin_amdgcn_rcpf(1.0f + __builtin_amdgcn_exp2f(a * -1.4426950408889634f)); }
struct EpiSwiglu {
    static constexpr bool PERM = true, AFTER_DRAIN = false;
    bf16_t* O; int ldc;
    __device__ __forceinline__ void operator()(const f32x4 (&acc)[2][2][4][2], const Unit& u, int wr, int wc, int fr, int fq) const {
        const int row0 = u.pm * BM + wr * 64 + fr, col0 = u.pn * HALF + wc * 32 + 8 * fq;
#pragma unroll
        for (int ai = 0; ai < 2; ++ai)
#pragma unroll
            for (int m = 0; m < 4; ++m) { bf16_t* rowp = O + (size_t)(row0 + ai * HALF + m * 16) * ldc + col0;
                const f32x4 a0 = acc[ai][0][m][0], a1 = acc[ai][0][m][1], b0 = acc[ai][1][m][0], b1 = acc[ai][1][m][1];
                u32x4 w; w.x = cvt_pk_bf16(silu_mul(a0[0], b0[0]), silu_mul(a0[1], b0[1])); w.y = cvt_pk_bf16(silu_mul(a0[2], b0[2]), silu_mul(a0[3], b0[3]));
                w.z = cvt_pk_bf16(silu_mul(a1[0], b1[0]), silu_mul(a1[1], b1[1])); w.w = cvt_pk_bf16(silu_mul(a1[2], b1[2]), silu_mul(a1[3], b1[3]));
                *(u32x4*)rowp = w; }
    }
};

template <class Epi, class Sched, bool ALIGN_EPI = false, bool SP2 = false>
__device__ __forceinline__ void gemm_phase(PG8_LAS unsigned char* lds, const Gemm g, const Sched& S, const Epi& E) {
    const int tid = threadIdx.x, wid = __builtin_amdgcn_readfirstlane(tid >> 6), lane = tid & 63, wr = wid >> 2, wc = wid & 3, fr = lane & 15, fq = lane >> 4;
    const int K = g.K, nt = K / BK;
    unsigned voffA[2], voffB[2];
#pragma unroll
    for (int i = 0; i < 2; ++i) { int R, C; stage_rc(tid * 16 + i * 8192, R, C); const int Rb = Epi::PERM ? ((R & ~31) + perm32(R & 31)) : R;
        voffA[i] = (unsigned)(R * K + C) * 2u; voffB[i] = (unsigned)(Rb * K + C) * 2u; }
    const size_t kstep = (size_t)(BK * 2);
    const size_t hstep = (size_t)HALF * K * 2;
    const size_t tstep = 2 * hstep;
    const unsigned ldsw = (unsigned)wid * 1024u;
    const int aoff = lds_byte(wr * 64 + fr, fq * 8), boff = lds_byte(wc * 32 + fr, fq * 8);
#define PG8_SA(b, h) (((b) * 2 + (h)) * HTB)
#define PG8_SB(b, h) ((4 + (b) * 2 + (h)) * HTB)
#define PG8_STAGE(bufoff, gbase, voff) do { _Pragma("unroll") for (int _i = 0; _i < 2; ++_i) \
        __builtin_amdgcn_global_load_lds((const unsigned*)((const char*)(gbase) + (voff)[_i]), (PG8_LAS unsigned*)(lds + (bufoff) + ldsw + _i * 8192), 16, 0, 0); } while (0)
#define PG8_LDA(dst, b, h) do { _Pragma("unroll") for (int m = 0; m < 4; ++m) _Pragma("unroll") for (int k = 0; k < 2; ++k) dst[m][k] = *(const PG8_LAS bf16x8*)(lds + PG8_SA(b, h) + aoff + m * 2048 + k * 1024); } while (0)
#define PG8_LDB(dst, b, h) do { _Pragma("unroll") for (int n = 0; n < 2; ++n) _Pragma("unroll") for (int k = 0; k < 2; ++k) dst[n][k] = *(const PG8_LAS bf16x8*)(lds + PG8_SB(b, h) + boff + n * 2048 + k * 1024); } while (0)
#define PG8_MMA(ai, bj, At, Bt) do { __builtin_amdgcn_s_setprio(1); _Pragma("unroll") for (int m = 0; m < 4; ++m) _Pragma("unroll") for (int n = 0; n < 2; ++n) _Pragma("unroll") for (int k = 0; k < 2; ++k) \
        acc[ai][bj][m][n] = __builtin_amdgcn_mfma_f32_16x16x32_bf16(Bt[n][k], At[m][k], acc[ai][bj][m][n], 0, 0, 0); __builtin_amdgcn_s_setprio(0); } while (0)
#define PG8_WAIT_V(n) asm volatile("s_waitcnt vmcnt(" #n ")" ::: "memory")
#define PG8_WAIT_L(n) asm volatile("s_waitcnt lgkmcnt(" #n ")" ::: "memory")
#define PG8_BAR __builtin_amdgcn_s_barrier()
#define PG8_SCHED __builtin_amdgcn_sched_barrier(0)
    Unit cur, nxt; int ui = 0;
    if (!S.next(0, cur)) return;
    f32x4 acc[2][2][4][2];
#pragma unroll
    for (int a = 0; a < 2; ++a)
#pragma unroll
        for (int b = 0; b < 2; ++b)
#pragma unroll
            for (int m = 0; m < 4; ++m)
#pragma unroll
                for (int n = 0; n < 2; ++n) acc[a][b][m][n] = (f32x4){0.f, 0.f, 0.f, 0.f};
    bf16x8 At[4][2], B0[2][2], B1[2][2];
    const char* cA = (const char*)g.A + (size_t)cur.pm * tstep; const char* cB = (const char*)g.Bt + (size_t)cur.pn * tstep;
    S.a_ready(cur);
    if constexpr (SP2) {
        PG8_STAGE(PG8_SB(0, 0), cB, voffB); PG8_STAGE(PG8_SB(0, 1), cB + hstep, voffB); PG8_STAGE(PG8_SA(0, 0), cA, voffA); PG8_STAGE(PG8_SA(0, 1), cA + hstep, voffA);
        if (wr == 1) PG8_BAR;
        PG8_WAIT_V(2); PG8_BAR;
        PG8_STAGE(PG8_SB(1, 0), cB + kstep, voffB); PG8_STAGE(PG8_SA(1, 0), cA + kstep, voffA); PG8_STAGE(PG8_SB(1, 1), cB + hstep + kstep, voffB);
        PG8_WAIT_V(6); PG8_BAR;
    } else {
        PG8_STAGE(PG8_SB(0, 0), cB, voffB); PG8_STAGE(PG8_SA(0, 0), cA, voffA); PG8_STAGE(PG8_SB(0, 1), cB + hstep, voffB); PG8_STAGE(PG8_SA(0, 1), cA + hstep, voffA);
        if (wr == 1) PG8_BAR;
        PG8_WAIT_V(4); PG8_BAR;
        PG8_STAGE(PG8_SB(1, 0), cB + kstep, voffB); PG8_STAGE(PG8_SA(1, 0), cA + kstep, voffA); PG8_STAGE(PG8_SB(1, 1), cB + hstep + kstep, voffB);
        PG8_WAIT_V(6); PG8_BAR;
    }
    for (;;) {
        const bool has_next = S.next(ui + 1, nxt);
        const char* nA = has_next ? (const char*)g.A + (size_t)nxt.pm * tstep : cA; const char* nB = has_next ? (const char*)g.Bt + (size_t)nxt.pn * tstep : cB;
        for (int t = 0; t < nt; t += 2) {
            const bool last = (t == nt - 2);
            const char* a1 = cA + (size_t)(t + 1) * kstep;
            const char* a2 = last ? nA : cA + (size_t)(t + 2) * kstep; const char* b2 = last ? nB : cB + (size_t)(t + 2) * kstep;
            const char* a3 = a2 + kstep; const char* b3 = b2 + kstep;
            if (last && has_next) S.a_ready(nxt);
            if constexpr (SP2) {
            PG8_LDB(B0, 0, 0); PG8_LDB(B1, 0, 1); PG8_SCHED; PG8_LDA(At, 0, 0); PG8_STAGE(PG8_SA(1, 1), a1 + hstep, voffA);
            PG8_WAIT_V(8); PG8_WAIT_L(0); PG8_BAR; PG8_MMA(0, 0, At, B0); PG8_MMA(0, 1, At, B1); PG8_BAR; PG8_SCHED;
            PG8_LDA(At, 0, 1); PG8_STAGE(PG8_SB(0, 0), b2, voffB); PG8_STAGE(PG8_SB(0, 1), b2 + hstep, voffB); PG8_STAGE(PG8_SA(0, 0), a2, voffA);
            PG8_WAIT_V(8); PG8_WAIT_L(0); PG8_BAR; PG8_MMA(1, 0, At, B0); PG8_MMA(1, 1, At, B1); PG8_BAR; PG8_SCHED;
            PG8_LDB(B0, 1, 0); PG8_LDB(B1, 1, 1); PG8_SCHED; PG8_LDA(At, 1, 0); PG8_STAGE(PG8_SA(0, 1), a2 + hstep, voffA);
            PG8_WAIT_V(8); PG8_WAIT_L(0); PG8_BAR; PG8_MMA(0, 0, At, B0); PG8_MMA(0, 1, At, B1); PG8_BAR; PG8_SCHED;
            PG8_LDA(At, 1, 1); PG8_STAGE(PG8_SB(1, 0), b3, voffB); PG8_STAGE(PG8_SB(1, 1), b3 + hstep, voffB); PG8_STAGE(PG8_SA(1, 0), a3, voffA);
            PG8_WAIT_V(8); PG8_WAIT_L(0); PG8_BAR; PG8_MMA(1, 0, At, B0); PG8_MMA(1, 1, At, B1); PG8_BAR; PG8_SCHED;
            } else {
            PG8_LDB(B0, 0, 0); PG8_SCHED; PG8_LDA(At, 0, 0); PG8_STAGE(PG8_SA(1, 1), a1 + hstep, voffA);
            PG8_WAIT_L(8); PG8_BAR; PG8_WAIT_L(0); PG8_MMA(0, 0, At, B0); PG8_BAR; PG8_SCHED;
            PG8_LDB(B1, 0, 1); PG8_STAGE(PG8_SB(0, 0), b2, voffB);
            PG8_BAR; PG8_WAIT_L(0); PG8_MMA(0, 1, At, B1); PG8_BAR;
            PG8_LDA(At, 0, 1); PG8_STAGE(PG8_SA(0, 0), a2, voffA);
            PG8_BAR; PG8_WAIT_L(0); PG8_MMA(1, 0, At, B0); PG8_BAR; PG8_SCHED;
            PG8_STAGE(PG8_SB(0, 1), b2 + hstep, voffB);
            PG8_WAIT_V(6); PG8_BAR; PG8_MMA(1, 1, At, B1); PG8_BAR;
            PG8_LDB(B0, 1, 0); PG8_SCHED; PG8_LDA(At, 1, 0); PG8_STAGE(PG8_SA(0, 1), a2 + hstep, voffA);
            PG8_WAIT_L(8); PG8_BAR; PG8_WAIT_L(0); PG8_MMA(0, 0, At, B0); PG8_BAR; PG8_SCHED;
            PG8_LDB(B1, 1, 1); PG8_STAGE(PG8_SB(1, 0), b3, voffB);
            PG8_BAR; PG8_WAIT_L(0); PG8_MMA(0, 1, At, B1); PG8_BAR;
            PG8_LDA(At, 1, 1); PG8_STAGE(PG8_SA(1, 0), a3, voffA);
            PG8_BAR; PG8_WAIT_L(0); PG8_MMA(1, 0, At, B0); PG8_BAR; PG8_SCHED;
            PG8_STAGE(PG8_SB(1, 1), b3 + hstep, voffB);
            PG8_WAIT_V(6); PG8_BAR; PG8_MMA(1, 1, At, B1); PG8_BAR;
            }
        }
        if constexpr (ALIGN_EPI) { if (wr == 0) PG8_BAR; }
        if constexpr (!Epi::AFTER_DRAIN) { E(acc, cur, wr, wc, fr, fq); S.done(cur); }
        if (!has_next) break;
#pragma unroll
        for (int a = 0; a < 2; ++a)
#pragma unroll
            for (int b = 0; b < 2; ++b)
#pragma unroll
                for (int m = 0; m < 4; ++m)
#pragma unroll
                    for (int n = 0; n < 2; ++n) acc[a][b][m][n] = (f32x4){0.f, 0.f, 0.f, 0.f};
        cur = nxt; cA = nA; cB = nB; ++ui;
        if constexpr (ALIGN_EPI) { if (wr == 1) PG8_BAR; }
    }
    PG8_WAIT_V(0);
    if constexpr (!ALIGN_EPI) { if (wr == 0) PG8_BAR; }
    PG8_BAR;
    if constexpr (Epi::AFTER_DRAIN) { E.fused(acc, cur, wr, wc, fr, fq, lds, wid, lane); S.done(cur); }
#undef PG8_SA
#undef PG8_SB
#undef PG8_STAGE
#undef PG8_LDA
#undef PG8_LDB
#undef PG8_MMA
#undef PG8_WAIT_V
#undef PG8_WAIT_L
#undef PG8_BAR
#undef PG8_SCHED
}
}
namespace att {
using bf16x8 = __attribute__((ext_vector_type(8))) short;
using s16x4  = __attribute__((ext_vector_type(4))) short;
using f32x16 = __attribute__((ext_vector_type(16))) float;
using u32x4  = __attribute__((ext_vector_type(4))) unsigned;
typedef unsigned short bf16;
#define ATT_LAS __attribute__((address_space(3)))
constexpr int NW = 8, QBLK = 32, KVBLK = 64;
constexpr int SHM_V = KVBLK * 128 * 2;
#define ATT_SBAR() __builtin_amdgcn_sched_barrier(0)
__device__ __forceinline__ int crow(int r, int hi) { return (r & 3) + 8 * (r >> 2) + 4 * hi; }
__device__ __forceinline__ unsigned cvtpk(float lo, float hi) { unsigned r; asm volatile("v_cvt_pk_bf16_f32 %0, %1, %2" : "=v"(r) : "v"(lo), "v"(hi)); return r; }
__device__ __forceinline__ void partialSM(f32x16& p0, f32x16& p1, float& m_reg, float& mn, float& alpha, float C, float thr_raw) {
  float pmax = p0[0];
#pragma unroll
  for (int r = 1; r < 16; ++r) pmax = fmaxf(pmax, p0[r]);
#pragma unroll
  for (int r = 0; r < 16; ++r) pmax = fmaxf(pmax, p1[r]);
  { auto rr = __builtin_amdgcn_permlane32_swap(__float_as_uint(pmax), __float_as_uint(pmax), false, false);
    pmax = fmaxf(__uint_as_float(rr[0]), __uint_as_float(rr[1])); }
  if (__builtin_expect(__all(pmax - m_reg <= thr_raw), 1)) { mn = m_reg; alpha = 1.f; }
  else { mn = fmaxf(m_reg, pmax); alpha = __builtin_amdgcn_exp2f((m_reg - mn) * C); m_reg = mn; }
  float mnC = -mn * C;
#pragma unroll
  for (int r = 0; r < 16; ++r) p0[r] = fmaf(p0[r], C, mnC);
#pragma unroll
  for (int r = 0; r < 16; ++r) p1[r] = fmaf(p1[r], C, mnC);
#pragma unroll
  for (int r = 0; r < 16; ++r) p0[r] = __builtin_amdgcn_exp2f(p0[r]);
}
__device__ __forceinline__ void finishSM(f32x16& p0, f32x16& p1, float alpha, float& l_reg, bf16x8& pa0, bf16x8& pa1, bf16x8& pa2, bf16x8& pa3) {
#pragma unroll
  for (int r = 0; r < 16; ++r) p1[r] = __builtin_amdgcn_exp2f(p1[r]);
  float ps = 0;
#pragma unroll
  for (int r = 0; r < 16; ++r) ps += p0[r];
#pragma unroll
  for (int r = 0; r < 16; ++r) ps += p1[r];
  { auto rr = __builtin_amdgcn_permlane32_swap(__float_as_uint(ps), __float_as_uint(ps), false, false);
    ps = __uint_as_float(rr[0]) + __uint_as_float(rr[1]); }
  l_reg = l_reg * alpha + ps;
#define ATT_PK4(P, BASE, OUT) do { unsigned a0 = cvtpk(P[BASE + 0], P[BASE + 1]), a1 = cvtpk(P[BASE + 2], P[BASE + 3]);   \
    unsigned b0 = cvtpk(P[BASE + 4], P[BASE + 5]), b1 = cvtpk(P[BASE + 6], P[BASE + 7]);                              \
    auto r0 = __builtin_amdgcn_permlane32_swap(a0, b0, false, false); auto r1 = __builtin_amdgcn_permlane32_swap(a1, b1, false, false); \
    u32x4 w = {r0[0], r1[0], r0[1], r1[1]}; OUT = __builtin_bit_cast(bf16x8, w); } while (0)
  ATT_PK4(p0, 0, pa0); ATT_PK4(p0, 8, pa1); ATT_PK4(p1, 0, pa2); ATT_PK4(p1, 8, pa3);
}
template <int NQK> __device__ __forceinline__ int kswz(int row, int colB) { return row * (32 * NQK) + (colB ^ ((row & 7) << 4)); }
template <int NQK, int NQR> __device__ __forceinline__ void qkt(f32x16& p0, f32x16& p1, ATT_LAS const char* Ks, const bf16x8* qr, ATT_LAS const char* qx, int r32, int hi) {
  p0 = f32x16{}; p1 = f32x16{};
#pragma unroll
  for (int d0 = 0; d0 < NQK; ++d0) { int cb = (d0 * 16 + hi * 8) * 2;
    bf16x8 b0 = *(ATT_LAS const bf16x8*)(Ks + kswz<NQK>(r32, cb));
    bf16x8 b1 = *(ATT_LAS const bf16x8*)(Ks + kswz<NQK>(32 + r32, cb));
    bf16x8 qv; if (d0 < NQR) qv = qr[d0 < NQR ? d0 : 0]; else qv = *(ATT_LAS const bf16x8*)(qx + (d0 - NQR) * 1024);
    p0 = __builtin_amdgcn_mfma_f32_32x32x16_bf16(b0, qv, p0, 0, 0, 0);
    p1 = __builtin_amdgcn_mfma_f32_32x32x16_bf16(b1, qv, p1, 0, 0, 0); }
}
__device__ __forceinline__ int v_st(int k, int c) { const int kk = (k & ~0xC) | ((k & 4) << 1) | ((k & 8) >> 1); return ((kk >> 3) * 4 + (c >> 5)) * 512 + ((kk & 7) * 32 + (c & 31)) * 2; }
__device__ __forceinline__ int v_rd_base(int lane) { return ((lane & 3) << 3) | (((lane >> 2) & 3) << 6) | (((lane >> 4) & 1) << 5) | (((lane >> 5) & 1) << 8); }
constexpr int v_rd_off(int d0, int ks, int half) { return d0 * 512 + ks * 4096 + half * 2048; }
template <int OFF> __device__ __forceinline__ s16x4 tr_read(int vb) {
  s16x4 r; asm volatile("ds_read_b64_tr_b16 %0, %1 offset:%2" : "=&v"(r) : "v"(vb), "i"(OFF) : "memory"); return r;
}
template <int D0> __device__ __forceinline__ void pv_one(f32x16& od, int vb, bf16x8 pa0, bf16x8 pa1, bf16x8 pa2, bf16x8 pa3) {
  const s16x4 l0 = tr_read<v_rd_off(D0, 0, 0)>(vb), h0 = tr_read<v_rd_off(D0, 0, 1)>(vb), l1 = tr_read<v_rd_off(D0, 1, 0)>(vb), h1 = tr_read<v_rd_off(D0, 1, 1)>(vb);
  const s16x4 l2 = tr_read<v_rd_off(D0, 2, 0)>(vb), h2 = tr_read<v_rd_off(D0, 2, 1)>(vb), l3 = tr_read<v_rd_off(D0, 3, 0)>(vb), h3 = tr_read<v_rd_off(D0, 3, 1)>(vb);
  asm volatile("s_waitcnt lgkmcnt(0)" ::: "memory"); ATT_SBAR();
#define ATT_PK(L, H) (bf16x8){L[0], L[1], L[2], L[3], H[0], H[1], H[2], H[3]}
  od = __builtin_amdgcn_mfma_f32_32x32x16_bf16(pa0, ATT_PK(l0, h0), od, 0, 0, 0);
  od = __builtin_amdgcn_mfma_f32_32x32x16_bf16(pa1, ATT_PK(l1, h1), od, 0, 0, 0);
  od = __builtin_amdgcn_mfma_f32_32x32x16_bf16(pa2, ATT_PK(l2, h2), od, 0, 0, 0);
  od = __builtin_amdgcn_mfma_f32_32x32x16_bf16(pa3, ATT_PK(l3, h3), od, 0, 0, 0);
}
__device__ __forceinline__ void pv_d0(f32x16* o, int vb, bf16x8 pa0, bf16x8 pa1, bf16x8 pa2, bf16x8 pa3) {
  pv_one<0>(o[0], vb, pa0, pa1, pa2, pa3); pv_one<1>(o[1], vb, pa0, pa1, pa2, pa3); pv_one<2>(o[2], vb, pa0, pa1, pa2, pa3); pv_one<3>(o[3], vb, pa0, pa1, pa2, pa3);
}
template <int NQK> constexpr int shm_k() { return KVBLK * 32 * NQK; }
template <int NQK, int NQR> constexpr int shm_attn() { return 2 * SHM_V + 2 * shm_k<NQK>() + NW * 64 * 4 + NW * (NQK - NQR) * 1024; }

template <int NQK, int NQR, int SD, int ldq, int ldka, int ldkb, int ldv, int ldo>
__device__ __forceinline__ void attn_unit(const bf16* __restrict__ Qb, const bf16* __restrict__ KA, const bf16* __restrict__ KB,
                                          const bf16* __restrict__ Vh, bf16* __restrict__ Ob, int seq, float C, float thr_raw, ATT_LAS char* lds) {
  constexpr int SHM_K = shm_k<NQK>(), KCH = (2 * NQK * 64) / 512, NLD = KCH + 2;
  const int tid = threadIdx.x, wid = tid >> 6, lane = tid & 63, r32 = lane & 31, hi = lane >> 5;
  ATT_LAS char* V_lds = lds; ATT_LAS char* K_lds = lds + 2 * SHM_V;
  ATT_LAS float* ws = (ATT_LAS float*)(lds + 2 * SHM_V + 2 * SHM_K) + wid * 64; ATT_LAS float* li_l = ws; ATT_LAS float* al_l = ws + 32;
  float m_reg = -1e30f, l_reg = 0; f32x16 o[4] = {}; bf16x8 qr[NQR];
  const bf16* Qw = Qb + (long)(wid * QBLK + r32) * ldq + hi * 8;
  ATT_LAS char* qx = lds + 2 * SHM_V + 2 * SHM_K + NW * 64 * 4 + wid * ((NQK - NQR) * 1024) + lane * 16;
#pragma unroll
  for (int d0 = 0; d0 < NQR; ++d0) qr[d0] = *(const bf16x8*)(Qw + d0 * 16);
#pragma unroll
  for (int d0 = NQR; d0 < NQK; ++d0) *(ATT_LAS bf16x8*)(qx + (d0 - NQR) * 1024) = *(const bf16x8*)(Qw + d0 * 16);
  const int sr = tid >> 4, sc = (tid & 15) * 8, vst0 = v_st(sr, sc), vst1 = v_st(32 + sr, sc);
  const int sr2 = tid >> 3, sc2 = (tid & 7) * 8;
  const int vb0 = (int)(unsigned)(size_t)V_lds + v_rd_base(lane);
  struct { bf16x8 vs0, vs1, ks[KCH]; } sr_[SD];
#define ATT_SLOAD(i, k0) do { sr_[i].vs0 = *(const bf16x8*)(&Vh[(long)((k0) + sr) * ldv + sc]); sr_[i].vs1 = *(const bf16x8*)(&Vh[(long)((k0) + 32 + sr) * ldv + sc]); \
    sr_[i].ks[0] = *(const bf16x8*)(&KA[(long)((k0) + sr) * ldka + sc]); sr_[i].ks[1] = *(const bf16x8*)(&KA[(long)((k0) + 32 + sr) * ldka + sc]); \
    if constexpr (KCH == 3) sr_[i].ks[2] = *(const bf16x8*)(&KB[(long)((k0) + sr2) * ldkb + sc2]); } while (0)
#define ATT_SWRITE(b, i) do { *(ATT_LAS bf16x8*)(V_lds + (b) * SHM_V + vst0) = sr_[i].vs0; *(ATT_LAS bf16x8*)(V_lds + (b) * SHM_V + vst1) = sr_[i].vs1; \
    *(ATT_LAS bf16x8*)(K_lds + (b) * SHM_K + kswz<NQK>(sr, sc * 2)) = sr_[i].ks[0]; *(ATT_LAS bf16x8*)(K_lds + (b) * SHM_K + kswz<NQK>(32 + sr, sc * 2)) = sr_[i].ks[1]; \
    if constexpr (KCH == 3) *(ATT_LAS bf16x8*)(K_lds + (b) * SHM_K + kswz<NQK>(sr2, 256 + sc2 * 2)) = sr_[i].ks[2]; } while (0)
#define ATT_SWAIT() do { if constexpr (SD == 2) { if constexpr (NLD == 4) asm volatile("s_waitcnt vmcnt(4)" ::: "memory"); else asm volatile("s_waitcnt vmcnt(5)" ::: "memory"); } else asm volatile("s_waitcnt vmcnt(0)" ::: "memory"); } while (0)
#define ATT_RESC(a) do { if (__any((a) < 1.f)) { if (hi == 0) al_l[r32] = (a); asm volatile("s_waitcnt lgkmcnt(0)" ::: "memory"); \
    _Pragma("unroll") for (int d = 0; d < 4; ++d) _Pragma("unroll") for (int r = 0; r < 16; ++r) o[d][r] *= al_l[crow(r, hi)]; } } while (0)
  f32x16 pA0, pA1, pB0, pB1; float mnA, mnB, alA, alB; bf16x8 pa0, pa1, pa2, pa3; const int NT = seq / KVBLK;
  constexpr int SE = 0, SO = SD - 1;
  ATT_SLOAD(SE, 0); asm volatile("s_waitcnt vmcnt(0)" ::: "memory"); ATT_SWRITE(0, SE); __syncthreads();
  qkt<NQK, NQR>(pA0, pA1, K_lds, qr, qx, r32, hi); partialSM(pA0, pA1, m_reg, mnA, alA, C, thr_raw);
  ATT_SLOAD(SO, KVBLK); if constexpr (SD == 2) { if (2 < NT) ATT_SLOAD(SE, 2 * KVBLK); }
  ATT_SWAIT(); ATT_SWRITE(1, SO); __syncthreads();
  for (int j = 1; j + 1 < NT; j += 2) {
    ATT_SBAR(); qkt<NQK, NQR>(pB0, pB1, K_lds + SHM_K, qr, qx, r32, hi);
    finishSM(pA0, pA1, alA, l_reg, pa0, pa1, pa2, pa3); ATT_SBAR();
    ATT_SLOAD(SO, (j + SD) * KVBLK); ATT_SBAR();
    pv_d0(o, vb0, pa0, pa1, pa2, pa3); partialSM(pB0, pB1, m_reg, mnB, alB, C, thr_raw);
    __syncthreads(); ATT_SWAIT(); ATT_SWRITE(0, SE);
    ATT_RESC(alB); __syncthreads();
    ATT_SBAR(); qkt<NQK, NQR>(pA0, pA1, K_lds, qr, qx, r32, hi);
    finishSM(pB0, pB1, alB, l_reg, pa0, pa1, pa2, pa3); ATT_SBAR();
    if (SD == 1 || j + 3 < NT) ATT_SLOAD(SE, (j + 1 + SD) * KVBLK); ATT_SBAR();
    pv_d0(o, vb0 + SHM_V, pa0, pa1, pa2, pa3); partialSM(pA0, pA1, m_reg, mnA, alA, C, thr_raw);
    __syncthreads(); ATT_SWAIT(); ATT_SWRITE(1, SO);
    ATT_RESC(alA); __syncthreads();
  }
  ATT_SBAR(); qkt<NQK, NQR>(pB0, pB1, K_lds + SHM_K, qr, qx, r32, hi);
  finishSM(pA0, pA1, alA, l_reg, pa0, pa1, pa2, pa3); ATT_SBAR();
  pv_d0(o, vb0, pa0, pa1, pa2, pa3); partialSM(pB0, pB1, m_reg, mnB, alB, C, thr_raw);
  __syncthreads(); ATT_RESC(alB);
  finishSM(pB0, pB1, alB, l_reg, pa0, pa1, pa2, pa3); ATT_SBAR();
  pv_d0(o, vb0 + SHM_V, pa0, pa1, pa2, pa3);
  if (hi == 0) li_l[r32] = l_reg; asm volatile("s_waitcnt lgkmcnt(0)" ::: "memory");
  float rli[16];
#pragma unroll
  for (int r = 0; r < 16; ++r) rli[r] = __builtin_amdgcn_rcpf(li_l[crow(r, hi)]);
  bf16* Ow = Ob + (long)(wid * QBLK) * ldo;
#pragma unroll
  for (int r = 0; r < 16; ++r) { const int orow = crow(r, hi);
#pragma unroll
    for (int d0 = 0; d0 < 4; ++d0) { const float v = o[d0][r] * rli[r]; const unsigned u = __float_as_uint(v); Ow[(long)orow * ldo + d0 * 32 + r32] = (bf16)((u + 0x7fffu + ((u >> 16) & 1u)) >> 16); } }
  __syncthreads();
#undef ATT_SLOAD
#undef ATT_SWRITE
#undef ATT_SWAIT
#undef ATT_RESC
}
}

namespace scan {
using bf16x8 = __attribute__((ext_vector_type(8))) short;
using s16x4  = __attribute__((ext_vector_type(4))) short;
using f32x16 = __attribute__((ext_vector_type(16))) float;
using u32x4  = __attribute__((ext_vector_type(4))) unsigned;
using u32x2  = __attribute__((ext_vector_type(2))) unsigned;
using f32x4s = __attribute__((ext_vector_type(4))) float;
typedef unsigned short bf16;
#define SC_LAS __attribute__((address_space(3)))
#define SC_GAS __attribute__((address_space(1)))
__device__ __forceinline__ unsigned off_b(unsigned row, unsigned ch) { return 256u * row + 16u * (ch ^ (((row & 3u) << 2) | ((row >> 2) & 3u))); }
__device__ __forceinline__ unsigned row_rd(unsigned lane, unsigned s) { return off_b(lane & 31u, 2u * s + (lane >> 5)); }
__device__ __forceinline__ unsigned tr_rd(unsigned lane, unsigned c, unsigned ks, unsigned t) {
    const unsigned h = lane >> 5, blk = (lane >> 4) & 1u, q = (lane & 15u) >> 2, p = lane & 3u;
    return off_b(16u * ks + 8u * h + 4u * t + q, 4u * c + 2u * blk + (p >> 1)) + 8u * (p & 1u);
}
__device__ __forceinline__ int crow(int r, int hi) { return (r & 3) + 8 * (r >> 2) + 4 * hi; }
__device__ __forceinline__ unsigned cvtpk(float lo, float hi) { unsigned r; asm volatile("v_cvt_pk_bf16_f32 %0, %1, %2" : "=v"(r) : "v"(lo), "v"(hi)); return r; }
__device__ __forceinline__ s16x4 trr(unsigned addr) { s16x4 r; asm volatile("ds_read_b64_tr_b16 %0, %1" : "=v"(r) : "v"(addr) : "memory"); return r; }
#define SC_PK(L, H) (bf16x8){L[0], L[1], L[2], L[3], H[0], H[1], H[2], H[3]}
#define SC_PK4(P, BASE, OUT) do { unsigned a0 = cvtpk(P[BASE + 0], P[BASE + 1]), a1 = cvtpk(P[BASE + 2], P[BASE + 3]);   \
    unsigned b0 = cvtpk(P[BASE + 4], P[BASE + 5]), b1 = cvtpk(P[BASE + 6], P[BASE + 7]);                              \
    auto r0 = __builtin_amdgcn_permlane32_swap(a0, b0, false, false); auto r1 = __builtin_amdgcn_permlane32_swap(a1, b1, false, false); \
    u32x4 w = {r0[0], r1[0], r0[1], r1[1]}; OUT = __builtin_bit_cast(bf16x8, w); } while (0)
#define SC_MFMA(a, b, c) __builtin_amdgcn_mfma_f32_32x32x16_bf16((a), (b), (c), 0, 0, 0)

constexpr int KOFF = 0, VOFF = 32768, QOFF = 49152, TOFF = 81920, LDS_NEED = 147456;

__device__ __forceinline__ void ret_scan_mfma(const bf16* __restrict__ P, bf16* __restrict__ SO, const float* lgf, const float* lgb, SC_LAS unsigned char* lds, int tid) {
    constexpr int LDP = 12288, SR = 4352, MR = 17408;
    const unsigned lane = tid & 63; const int wave = __builtin_amdgcn_readfirstlane(tid >> 6), cb = wave >> 2, dvb = wave & 3, hi = lane >> 5, r32 = lane & 31;
    const unsigned ldsb = (unsigned)(size_t)lds;
    const unsigned rb_i = 256u * r32, m4_i = ((((unsigned)r32 & 3u) << 2) | (((unsigned)r32 >> 2) & 3u)) << 4, xk_i = m4_i ^ ((unsigned)hi << 4);
    const unsigned vtr0_i = ldsb + VOFF + tr_rd(lane, dvb, 0, 0), vtr1_i = ldsb + VOFF + tr_rd(lane, dvb, 0, 1);
    const unsigned ktb0_i = ldsb + KOFF + cb * 8192 + tr_rd(lane, 0, 0, 0), ktb1_i = ldsb + KOFF + cb * 8192 + tr_rd(lane, 0, 0, 1), q6_i = ((lane & 15u) >> 2) << 6;
    const int kr0 = tid >> 5, kc = tid & 31, vr0 = tid >> 4, vc = tid & 15;
    const unsigned kst0 = (kc >> 4) * 8192 + off_b(kr0, kc & 15), vst0 = off_b(vr0, vc);
    const unsigned kgo = (unsigned)(kr0 * LDP + kc * 8) * 2u, vgo = (unsigned)(vr0 * LDP + vc * 8) * 2u;
    for (int u = blockIdx.x; u < 256; u += gridDim.x) {
        const int b = u >> 6, h = (u >> 3) & 7, dir = (u >> 2) & 1, vs = u & 3;
        const float lg2 = (dir ? lgb : lgf)[h] * 1.4426950408889634f;
        const float g64 = __builtin_amdgcn_exp2f(64.0f * lg2);
        const float vsc0 = __builtin_amdgcn_exp2f((float)(dir ? vr0 : 63 - vr0) * lg2), vsc1 = __builtin_amdgcn_exp2f((float)(dir ? vr0 + 32 : 31 - vr0) * lg2);
        const int crow_i = cb * 32 + r32;
        const float osc = __builtin_amdgcn_exp2f((float)(dir ? -crow_i : crow_i - 63) * lg2);
        const SC_GAS char* Pq = (const SC_GAS char*)(P + (size_t)b * SR * LDP + h * 256);
        const SC_GAS char* Pv = (const SC_GAS char*)(P + (size_t)b * SR * LDP + 4096 + h * 512 + vs * 128);
        bf16* Ob = SO + ((size_t)dir * MR + (size_t)b * SR) * 4096 + h * 512 + vs * 128;
        f32x16 S[4];
#pragma unroll
        for (int j = 0; j < 4; ++j) S[j] = f32x16{};
        u32x4 kq[4], qq[4], vq[2];
#define chunk_base(n) (dir ? ((n) < 4 ? 256 - 64 * ((n) + 1) : SR - 64 * ((n) - 3)) : 64 * (n))
#define SC_GLOAD(n) do { const size_t cbo = (size_t)chunk_base(n) * (LDP * 2); \
        _Pragma("unroll") for (int j = 0; j < 4; ++j) { const SC_GAS char* pj = Pq + cbo + (size_t)j * (16 * LDP * 2); qq[j] = *(const SC_GAS u32x4*)(pj + kgo); kq[j] = *(const SC_GAS u32x4*)(pj + 4096 + kgo); } \
        _Pragma("unroll") for (int j = 0; j < 2; ++j) { const SC_GAS char* pj = Pv + cbo + (size_t)j * (32 * LDP * 2); vq[j] = *(const SC_GAS u32x4*)(pj + vgo); } } while (0)
        SC_GLOAD(0);
        for (int n = 0; n < 68; ++n) {
            unsigned rb = rb_i, m4 = m4_i, xk = xk_i, q6 = q6_i;
            asm volatile("" : "+v"(rb), "+v"(m4), "+v"(xk), "+v"(q6));
            __syncthreads();
#pragma unroll
            for (int j = 0; j < 4; ++j) {
#pragma unroll
                for (int r = 0; r < 16; ++r) S[j][r] *= g64;
#pragma unroll
                for (int g = 0; g < 4; ++g) { u32x2 w; w.x = cvtpk(S[j][4 * g], S[j][4 * g + 1]); w.y = cvtpk(S[j][4 * g + 2], S[j][4 * g + 3]);
                    *(SC_LAS u32x2*)(lds + TOFF + (dvb * 2 + cb) * 8192 + rb + (((unsigned)(4 * j + g) << 4) ^ m4) + 8 * hi) = w; }
            }
#pragma unroll
            for (int j = 0; j < 4; ++j) { *(SC_LAS u32x4*)(lds + KOFF + kst0 + (j & 1) * 4096 + (j >> 1) * 16384) = kq[j]; *(SC_LAS u32x4*)(lds + QOFF + kst0 + (j & 1) * 4096 + (j >> 1) * 16384) = qq[j]; }
#pragma unroll
            for (int j = 0; j < 2; ++j) { const u32x4 w = vq[j]; const float sc = j ? vsc1 : vsc0; u32x4 o;
                o.x = cvtpk(__uint_as_float(w.x << 16) * sc, __uint_as_float(w.x & 0xffff0000u) * sc); o.y = cvtpk(__uint_as_float(w.y << 16) * sc, __uint_as_float(w.y & 0xffff0000u) * sc);
                o.z = cvtpk(__uint_as_float(w.z << 16) * sc, __uint_as_float(w.z & 0xffff0000u) * sc); o.w = cvtpk(__uint_as_float(w.w << 16) * sc, __uint_as_float(w.w & 0xffff0000u) * sc);
                *(SC_LAS u32x4*)(lds + VOFF + vst0 + j * 8192) = o; }
            __syncthreads();
            if (n + 1 < 68) SC_GLOAD(n + 1);
            const bool need1 = dir ? true : (cb == 1);
            const bool use0 = dir ? (cb == 0) : true;
            f32x16 p0 = f32x16{}, p1 = f32x16{}, oT = f32x16{};
#pragma unroll 1
            for (int cq = 0; cq < 2; ++cq) {
                const unsigned sub = cq * 8192;
#pragma unroll
                for (int s8 = 0; s8 < 8; ++s8) {
                    const unsigned ra = rb + ((32u * s8) ^ xk) + sub;
                    const bf16x8 qf = *(const SC_LAS bf16x8*)(lds + ra + QOFF + cb * 16384);
                    const bf16x8 tf = *(const SC_LAS bf16x8*)(lds + ra + TOFF + dvb * 16384);
                    oT = SC_MFMA(tf, qf, oT);
                    if (use0) { const bf16x8 k0 = *(const SC_LAS bf16x8*)(lds + ra + KOFF + 0 * 16384); p0 = SC_MFMA(k0, qf, p0); }
                    if (need1) { const bf16x8 k1 = *(const SC_LAS bf16x8*)(lds + ra + KOFF + 1 * 16384); p1 = SC_MFMA(k1, qf, p1); }
                }
            }
#pragma unroll
            for (int r = 0; r < 16; ++r) { const int sr = crow(r, hi); const bool keep = dir ? (sr >= r32) : (sr <= r32);
                if (cb == 0) p0[r] = keep ? p0[r] : 0.f; else p1[r] = keep ? p1[r] : 0.f; }
            bf16x8 pa0, pa1, pa2, pa3; SC_PK4(p0, 0, pa0); SC_PK4(p0, 8, pa1); SC_PK4(p1, 0, pa2); SC_PK4(p1, 8, pa3);
            bf16x8 vf[4];
            { s16x4 l[4], hh[4];
#pragma unroll
              for (int kp = 0; kp < 4; ++kp) { l[kp] = trr(vtr0_i + (kp >> 1) * 8192 + (kp & 1) * 4096); hh[kp] = trr(vtr1_i + (kp >> 1) * 8192 + (kp & 1) * 4096); }
              asm volatile("s_waitcnt lgkmcnt(0)" : "+v"(l[0]), "+v"(l[1]), "+v"(l[2]), "+v"(l[3]), "+v"(hh[0]), "+v"(hh[1]), "+v"(hh[2]), "+v"(hh[3]) :: "memory");
#pragma unroll
              for (int kp = 0; kp < 4; ++kp) vf[kp] = SC_PK(l[kp], hh[kp]); }
            if (use0) { oT = SC_MFMA(vf[0], pa0, oT); oT = SC_MFMA(vf[1], pa1, oT); }
            if (need1) { oT = SC_MFMA(vf[2], pa2, oT); oT = SC_MFMA(vf[3], pa3, oT); }
            { bf16* op = Ob + (size_t)(chunk_base(n) + crow_i) * 4096 + dvb * 32 + 4 * hi;
#pragma unroll
              for (int g = 0; g < 4; ++g) { u32x2 w; w.x = cvtpk(oT[4 * g] * osc, oT[4 * g + 1] * osc); w.y = cvtpk(oT[4 * g + 2] * osc, oT[4 * g + 3] * osc); *(SC_GAS u32x2*)(op + 8 * g) = w; } }
#pragma unroll
            for (int c = 0; c < 4; ++c) {
                const unsigned cx = (((unsigned)c << 6) ^ q6) - q6;
                s16x4 l[4], hh[4];
#pragma unroll
                for (int kp = 0; kp < 4; ++kp) { l[kp] = trr(ktb0_i + cx + (kp >> 1) * 16384 + (kp & 1) * 4096); hh[kp] = trr(ktb1_i + cx + (kp >> 1) * 16384 + (kp & 1) * 4096); }
                asm volatile("s_waitcnt lgkmcnt(0)" : "+v"(l[0]), "+v"(l[1]), "+v"(l[2]), "+v"(l[3]), "+v"(hh[0]), "+v"(hh[1]), "+v"(hh[2]), "+v"(hh[3]) :: "memory");
#pragma unroll
                for (int kp = 0; kp < 4; ++kp) S[c] = SC_MFMA(SC_PK(l[kp], hh[kp]), vf[kp], S[c]);
            }
        }
#undef SC_GLOAD
#undef chunk_base
        __syncthreads();
    }
}
constexpr int HK = 0, HV = 16384, HQ = 32768, HT = 49152, HTOT = 81920, HE = 86016;
__device__ __forceinline__ void hg_scan_mfma(const bf16* __restrict__ P, bf16* __restrict__ SO, SC_LAS unsigned char* lds, int tid) {
    constexpr int LDP = 10240, SR = 4352, MR = 17408;
    const unsigned lane = tid & 63; const int wave = __builtin_amdgcn_readfirstlane(tid >> 6), cb = wave >> 2, dvb = wave & 3, hi = lane >> 5, r32 = lane & 31;
    const unsigned ldsb = (unsigned)(size_t)lds;
    const unsigned rb_i = 256u * r32, m4_i = ((((unsigned)r32 & 3u) << 2) | (((unsigned)r32 >> 2) & 3u)) << 4, xk_i = m4_i ^ ((unsigned)hi << 4);
    const unsigned vtr0_i = ldsb + HV + tr_rd(lane, dvb, 0, 0), vtr1_i = ldsb + HV + tr_rd(lane, dvb, 0, 1);
    const unsigned ktb0_i = ldsb + HK + tr_rd(lane, 0, 0, 0), ktb1_i = ldsb + HK + tr_rd(lane, 0, 0, 1), q6_i = ((lane & 15u) >> 2) << 6;
    const int ch = tid & 127, rq = __builtin_amdgcn_readfirstlane(tid >> 7);
    const int vr0 = tid >> 4, vc = tid & 15;
    const unsigned vst0 = off_b(vr0, vc), vgo = (unsigned)(vr0 * LDP + vc * 8) * 2u;
    SC_LAS float* tot = (SC_LAS float*)(lds + HTOT); SC_LAS float* etab = (SC_LAS float*)(lds + HE);
    for (int u = blockIdx.x; u < 128; u += gridDim.x) {
        const int b = u >> 5, h = (u >> 1) & 15, dir = u & 1;
        const bf16* Pq = P + (size_t)b * SR * LDP + h * 128 + ch;
        const int kko = dir ? 4096 : 2048;
        const SC_GAS char* Pv = (const SC_GAS char*)(P + (size_t)b * SR * LDP + 6144 + h * 128);
        bf16* Ob = SO + ((size_t)dir * MR + (size_t)b * SR) * 2048 + h * 128;
        const int crow_i = cb * 32 + r32;
        f32x16 S[2];
#pragma unroll
        for (int j = 0; j < 2; ++j) S[j] = f32x16{};
        unsigned short qr[16], kr[16]; u32x4 vq[2];
#define chunk_base(n) (dir ? ((n) < 4 ? 256 - 64 * ((n) + 1) : SR - 64 * ((n) - 3)) : 64 * (n))
#define HG_GLOAD(n) do { const bf16* pc = Pq + (size_t)(chunk_base(n) + 16 * rq) * LDP; \
        _Pragma("unroll") for (int j = 0; j < 16; ++j) { qr[j] = pc[(size_t)j * LDP]; kr[j] = pc[(size_t)j * LDP + kko]; } \
        const size_t cbo = (size_t)chunk_base(n) * (LDP * 2); \
        _Pragma("unroll") for (int j = 0; j < 2; ++j) vq[j] = *(const SC_GAS u32x4*)(Pv + cbo + (size_t)j * (32 * LDP * 2) + vgo); } while (0)
        HG_GLOAD(0);
        for (int n = 0; n < 68; ++n) {
            unsigned rb = rb_i, m4 = m4_i, xk = xk_i, q6 = q6_i;
            asm volatile("" : "+v"(rb), "+v"(m4), "+v"(xk), "+v"(q6));
            float kk[16]; float tp = 1.0f;
#pragma unroll
            for (int j = 0; j < 16; ++j) { kk[j] = __uint_as_float((unsigned)kr[j] << 16); tp *= (1.0f - kk[j]); }
            tot[((n & 1) * 4 + rq) * 128 + ch] = tp;
            __syncthreads();
#pragma unroll
            for (int j = 0; j < 2; ++j)
#pragma unroll
                for (int g = 0; g < 4; ++g) { u32x2 w; w.x = cvtpk(S[j][4 * g], S[j][4 * g + 1]); w.y = cvtpk(S[j][4 * g + 2], S[j][4 * g + 3]);
                    *(SC_LAS u32x2*)(lds + HT + dvb * 8192 + rb + (((unsigned)(8 * cb + 4 * j + g) << 4) ^ m4) + 8 * hi) = w; }
            { const float t0 = tot[((n & 1) * 4 + 0) * 128 + ch], t1 = tot[((n & 1) * 4 + 1) * 128 + ch], t2 = tot[((n & 1) * 4 + 2) * 128 + ch], t3 = tot[((n & 1) * 4 + 3) * 128 + ch];
              float run = dir ? (rq == 3 ? 1.0f : rq == 2 ? t3 : rq == 1 ? t3 * t2 : (t3 * t2) * t1) : (rq == 0 ? 1.0f : rq == 1 ? t0 : rq == 2 ? t0 * t1 : (t0 * t1) * t2);
              if (rq == 0) etab[ch] = (t0 * t1) * (t2 * t3);
#define HG_ELEM(j) do { run *= (1.0f - kk[j]); \
                  const float qi = __uint_as_float((unsigned)qr[j] << 16) * run, ki = kk[j] * __builtin_amdgcn_rcpf(run); \
                  const unsigned row = (16 * (rq & 1) + (j)), mrow = (((row & 3u) << 2) | ((row >> 2) & 3u)); \
                  const unsigned off = (rq >> 1) * 8192 + 256u * row + ((((unsigned)ch >> 3) ^ mrow) << 4) + ((unsigned)ch & 7u) * 2u; \
                  const unsigned qb = __float_as_uint(qi), kb = __float_as_uint(ki); \
                  *(SC_LAS unsigned short*)(lds + HQ + off) = (unsigned short)((qb + 0x7fffu + ((qb >> 16) & 1u)) >> 16); \
                  *(SC_LAS unsigned short*)(lds + HK + off) = (unsigned short)((kb + 0x7fffu + ((kb >> 16) & 1u)) >> 16); } while (0)
              if (dir) {
#pragma unroll
                  for (int jj = 0; jj < 16; ++jj) HG_ELEM(15 - jj);
              } else {
#pragma unroll
                  for (int jj = 0; jj < 16; ++jj) HG_ELEM(jj);
              } }
#undef HG_ELEM
#pragma unroll
            for (int j = 0; j < 2; ++j) *(SC_LAS u32x4*)(lds + HV + vst0 + j * 8192) = vq[j];
            __syncthreads();
            if (n + 1 < 68) HG_GLOAD(n + 1);
            const bool need1 = dir ? true : (cb == 1);
            const bool use0 = dir ? (cb == 0) : true;
            f32x16 p0 = f32x16{}, p1 = f32x16{}, oT = f32x16{};
#pragma unroll
            for (int s8 = 0; s8 < 8; ++s8) {
                const unsigned ra = rb + ((32u * s8) ^ xk);
                const bf16x8 qf = *(const SC_LAS bf16x8*)(lds + ra + HQ + cb * 8192);
                const bf16x8 tf = *(const SC_LAS bf16x8*)(lds + ra + HT + dvb * 8192);
                oT = SC_MFMA(tf, qf, oT);
                if (use0) { const bf16x8 k0 = *(const SC_LAS bf16x8*)(lds + ra + HK); p0 = SC_MFMA(k0, qf, p0); }
                if (need1) { const bf16x8 k1 = *(const SC_LAS bf16x8*)(lds + ra + HK + 8192); p1 = SC_MFMA(k1, qf, p1); }
            }
#pragma unroll
            for (int r = 0; r < 16; ++r) { const int sr = crow(r, hi); const bool keep = dir ? (sr >= r32) : (sr <= r32);
                if (cb == 0) p0[r] = keep ? p0[r] : 0.f; else p1[r] = keep ? p1[r] : 0.f; }
            bf16x8 pa0, pa1, pa2, pa3; SC_PK4(p0, 0, pa0); SC_PK4(p0, 8, pa1); SC_PK4(p1, 0, pa2); SC_PK4(p1, 8, pa3);
            bf16x8 vf[4];
            { s16x4 l[4], hh[4];
#pragma unroll
              for (int kp = 0; kp < 4; ++kp) { l[kp] = trr(vtr0_i + (kp >> 1) * 8192 + (kp & 1) * 4096); hh[kp] = trr(vtr1_i + (kp >> 1) * 8192 + (kp & 1) * 4096); }
              asm volatile("s_waitcnt lgkmcnt(0)" : "+v"(l[0]), "+v"(l[1]), "+v"(l[2]), "+v"(l[3]), "+v"(hh[0]), "+v"(hh[1]), "+v"(hh[2]), "+v"(hh[3]) :: "memory");
#pragma unroll
              for (int kp = 0; kp < 4; ++kp) vf[kp] = SC_PK(l[kp], hh[kp]); }
            if (use0) { oT = SC_MFMA(vf[0], pa0, oT); oT = SC_MFMA(vf[1], pa1, oT); }
            if (need1) { oT = SC_MFMA(vf[2], pa2, oT); oT = SC_MFMA(vf[3], pa3, oT); }
            { bf16* op = Ob + (size_t)(chunk_base(n) + crow_i) * 2048 + dvb * 32 + 4 * hi;
#pragma unroll
              for (int g = 0; g < 4; ++g) { u32x2 w; w.x = cvtpk(oT[4 * g], oT[4 * g + 1]); w.y = cvtpk(oT[4 * g + 2], oT[4 * g + 3]); *(SC_GAS u32x2*)(op + 8 * g) = w; } }
#pragma unroll
            for (int j = 0; j < 2; ++j) {
                const unsigned cx = (((unsigned)(2 * cb + j) << 6) ^ q6) - q6;
                s16x4 l[4], hh[4];
#pragma unroll
                for (int kp = 0; kp < 4; ++kp) { l[kp] = trr(ktb0_i + cx + (kp >> 1) * 8192 + (kp & 1) * 4096); hh[kp] = trr(ktb1_i + cx + (kp >> 1) * 8192 + (kp & 1) * 4096); }
                asm volatile("s_waitcnt lgkmcnt(0)" : "+v"(l[0]), "+v"(l[1]), "+v"(l[2]), "+v"(l[3]), "+v"(hh[0]), "+v"(hh[1]), "+v"(hh[2]), "+v"(hh[3]) :: "memory");
#pragma unroll
                for (int kp = 0; kp < 4; ++kp) S[j] = SC_MFMA(SC_PK(l[kp], hh[kp]), vf[kp], S[j]);
#pragma unroll
                for (int g = 0; g < 4; ++g) { const f32x4s e4 = *(const SC_LAS f32x4s*)(etab + 32 * (2 * cb + j) + 8 * g + 4 * hi);
                    S[j][4 * g] *= e4[0]; S[j][4 * g + 1] *= e4[1]; S[j][4 * g + 2] *= e4[2]; S[j][4 * g + 3] *= e4[3]; }
            }
        }
#undef HG_GLOAD
#undef chunk_base
        __syncthreads();
    }
}
}

#define GAS __attribute__((address_space(1)))
#define LAS __attribute__((address_space(3)))
typedef unsigned short bf16;
typedef unsigned v4u __attribute__((ext_vector_type(4)));
typedef float f32x4 __attribute__((ext_vector_type(4)));
typedef short bf16x8 __attribute__((ext_vector_type(8)));
typedef GAS unsigned gu32;
typedef GAS unsigned long long gu64;
#define RLX_AGENT __ATOMIC_RELAXED, __HIP_MEMORY_SCOPE_AGENT
#define LDS_WAIT() asm volatile("s_waitcnt lgkmcnt(0)" ::: "memory")
#define VM_WAIT() asm volatile("s_waitcnt vmcnt(0)" ::: "memory")
__device__ __forceinline__ unsigned long long rt() { return __builtin_amdgcn_s_memrealtime(); }
__device__ __forceinline__ unsigned f2bf(float f) { unsigned u = __builtin_bit_cast(unsigned, f); return (u + 0x7fffu + ((u >> 16) & 1u)) >> 16; }
__device__ __forceinline__ unsigned pk2(float lo, float hi) { return f2bf(lo) | (f2bf(hi) << 16); }

#define XB_TMO      128
#define XB_XCNT(j)  (256  + 64 * (j))
#define XB_XSUB(j)  (1280 + 64 * (j))
#define XB_XGEN(j)  (2304 + 64 * (j))
#define XB_TOP      3328
#define XB_TOPGEN   3392
#define XCD_BAR_WORDS 3456
#define XB_SPIN_CAP (1u << 18)

__device__ __forceinline__ unsigned xb_ld(unsigned* p)              { return __hip_atomic_load(p, __ATOMIC_RELAXED, __HIP_MEMORY_SCOPE_AGENT); }
__device__ __forceinline__ unsigned xb_add(unsigned* p, unsigned v) { return __hip_atomic_fetch_add(p, v, __ATOMIC_RELAXED, __HIP_MEMORY_SCOPE_AGENT); }
__device__ __forceinline__ unsigned xb_xcc_id() { return (unsigned)__builtin_amdgcn_s_getreg((3 << 11) | 20) & 0xFu; }
#define XB_SPIN(cond, bar) do { unsigned _sp = 0; while (cond) { __builtin_amdgcn_s_sleep(1); \
    if ((++_sp & 255u) == 0u) { if (xb_ld(&(bar)[XB_TMO])) break; if (_sp > XB_SPIN_CAP) { atomicAdd(&(bar)[XB_TMO], 1u); break; } } } } while (0)

struct XcdBarrier {
    unsigned* bar; unsigned x;
    volatile LAS unsigned* st;
};

__device__ __forceinline__ XcdBarrier xcd_barrier_post(unsigned* bar, volatile LAS unsigned* st) {
    XcdBarrier b; b.bar = bar; b.x = xb_xcc_id(); b.st = st;
    if (threadIdx.x == 0) (void)xb_add(&bar[XB_XCNT(b.x)], 1u);
    return b;
}
__device__ __forceinline__ void xcd_barrier_complete(unsigned* bar, unsigned x, unsigned& nloc, unsigned& nx) {
    const unsigned G = gridDim.x * gridDim.y * gridDim.z;
    unsigned sum, cnt, mine, sp = 0u;
    for (;;) {
        sum = 0u; cnt = 0u; mine = 0u;
#pragma unroll
        for (unsigned j = 0; j < 16; ++j) { const unsigned c = xb_ld(&bar[XB_XCNT(j)]); sum += c; cnt += (c > 0u) ? 1u : 0u; mine = (j == x) ? c : mine; }
        if (sum == G) break;
        __builtin_amdgcn_s_sleep(1);
        if ((++sp & 255u) == 0u) { if (xb_ld(&bar[XB_TMO])) break; if (sp > XB_SPIN_CAP) { atomicAdd(&bar[XB_TMO], 1u); break; } }
    }
    nloc = mine > 0u ? mine : 1u; nx = cnt > 0u ? cnt : 1u;
}

__device__ __forceinline__ void xcd_barrier(const XcdBarrier& b) {
    asm volatile("s_waitcnt vmcnt(0)" ::: "memory");
    __syncthreads();
    if (threadIdx.x == 0) {
        unsigned* bar = b.bar;
        __builtin_amdgcn_s_waitcnt(0);
        unsigned nloc = b.st[0], nx = b.st[1];
        if (nloc == 0u) { xcd_barrier_complete(bar, b.x, nloc, nx); b.st[0] = nloc; b.st[1] = nx; }
        const unsigned old = xb_add(&bar[XB_XSUB(b.x)], 1u);
        const unsigned gen = old / nloc;
        if (old + 1u == (gen + 1u) * nloc) {
            __builtin_amdgcn_fence(__ATOMIC_RELEASE, "agent");
            asm volatile("s_waitcnt vmcnt(0)" ::: "memory");
            const unsigned og = xb_add(&bar[XB_TOP], 1u);
            const unsigned tg = og / nx;
            if (og + 1u == (tg + 1u) * nx) xb_add(&bar[XB_TOPGEN], 1u);
            else XB_SPIN(xb_ld(&bar[XB_TOPGEN]) == tg, bar);
            __builtin_amdgcn_fence(__ATOMIC_ACQUIRE, "agent");
            xb_add(&bar[XB_XGEN(b.x)], 1u);
            asm volatile("s_waitcnt vmcnt(0)" ::: "memory");
        } else {
            XB_SPIN(xb_ld(&bar[XB_XGEN(b.x)]) == gen, bar);
            __builtin_amdgcn_fence(__ATOMIC_ACQUIRE, "agent");
            asm volatile("s_waitcnt vmcnt(0)" ::: "memory");
        }
    }
    __syncthreads();
}
constexpr int DM = 2048, NBATCH = 4, SEQ = 4096, CTXL = 256, SROWS = SEQ + CTXL, MROWS = NBATCH * SROWS;
constexpr int FFH = 5632;
constexpr int RET_N = 12288, GQA_N = 3072, MLA_NP = 1280, MLA_NACT = 1088, MLA_QN = 3072, MLA_KVN = 4096, HG_N = 10240;
constexpr float LN_EPS = 1e-6f, DN_ALPHA = 1.681792830507429f;
constexpr int NWAVES = 8;
constexpr size_t MiB = 1u << 20;
constexpr size_t WS_CTL = 0, CTL_ZERO_BYTES = 1 * MiB;
constexpr size_t WS_MODS = 1 * MiB, WS_TAB = 2 * MiB;
constexpr size_t WS_W_RET_IN = 4 * MiB, WS_W_RET_OUT = 52 * MiB, WS_W_GQA_IN = 68 * MiB, WS_W_GQA_OUT = 80 * MiB, WS_W_MLA_IN = 88 * MiB, WS_W_MLA_QUP = 93 * MiB, WS_W_MLA_KVUP = 96 * MiB,
                 WS_W_MLA_OUT = 100 * MiB, WS_W_HG_IN = 108 * MiB, WS_W_HG_OUT = 148 * MiB, WS_W_FFN_IN = 156 * MiB, WS_W_FFN_OUT = 332 * MiB;
constexpr size_t FFN_IN_BYTES = 44 * MiB, FFN_OUT_BYTES = 22 * MiB;
constexpr size_t WS_X = 420 * MiB, WS_R1 = 556 * MiB, WS_PROJ = 692 * MiB, WS_SCY = 1100 * MiB, WS_END = 1372 * MiB;
constexpr size_t PJ_MLA_Q = 0, PJ_MLA_KV = 102 * MiB, PJ_MLA_C = 238 * MiB, PJ_MLA_CQN = 281 * MiB, PJ_MLA_CKVN = 298 * MiB, PJ_MLA_KR = 315 * MiB;
constexpr int CW_BAR = 4096;
constexpr int TAB_R = 0, TAB_G = 64 * 64 * 2, TAB_M = TAB_G + 64 * 32 * 2, TAB_LB = TAB_M + 64 * 16 * 2;
constexpr int LDS_BYTES = 150528, MISC_OFF = LDS_BYTES - 512;

typedef __attribute__((ext_vector_type(4))) unsigned short bf16x4v;
typedef __attribute__((ext_vector_type(2))) unsigned u32x2v;
typedef __attribute__((ext_vector_type(2))) float f32x2v;

__device__ __forceinline__ float bf2f(unsigned short b) { return __uint_as_float(((unsigned)b) << 16); }
__device__ __forceinline__ float bflo(unsigned w) { return __uint_as_float(w << 16); }
__device__ __forceinline__ float bfhi(unsigned w) { return __uint_as_float(w & 0xffff0000u); }
__device__ __forceinline__ float wave_sum(float v) {
#pragma unroll
    for (int o = 1; o < 64; o <<= 1) v += __shfl_xor(v, o);
    return v;
}
__device__ __forceinline__ float silu_f(float x) { return x / (1.0f + __expf(-x)); }
__device__ __forceinline__ float sigmoid_f(float x) { return 1.0f / (1.0f + __expf(-x)); }
__device__ __forceinline__ void unpack8(const v4u w, float* f) { f[0] = bflo(w.x); f[1] = bfhi(w.x); f[2] = bflo(w.y); f[3] = bfhi(w.y); f[4] = bflo(w.z); f[5] = bfhi(w.z); f[6] = bflo(w.w); f[7] = bfhi(w.w); }
__device__ __forceinline__ v4u pack8(const float* f) { v4u w; w.x = pk2(f[0], f[1]); w.y = pk2(f[2], f[3]); w.z = pk2(f[4], f[5]); w.w = pk2(f[6], f[7]); return w; }

struct Args {
    const float *x, *c, *ctx, *c_ctx, *ada_w, *ada_b, *ln_g, *ln_b, *ffn_w_in, *ffn_w_out;
    const float *ret_w_in, *ret_df, *ret_db, *ret_w_out;
    const float *gqa_w_in, *gqa_qn, *gqa_kn, *gqa_w_out;
    const float *mla_w_in, *mla_qn, *mla_w_qup, *mla_kvn, *mla_w_kvup, *mla_w_out;
    const float *hg_w_in, *hg_lb_raw, *hg_on, *hg_w_out;
    float* out; unsigned char* ws; int ph_lo, ph_hi, use_bar, pad;
};

__device__ __forceinline__ void transpose_item(const float* W, int K, int Nact, bf16* WT, int k0, int n0, int act_n0, LAS float* scr, int lane) {
    if (act_n0 >= 0) {
#pragma unroll 8
        for (int i = 0; i < 32; ++i) { const int kk = 2 * i + (lane >> 5); scr[kk * 33 + (lane & 31)] = W[(size_t)(k0 + kk) * Nact + act_n0 + (lane & 31)]; }
    } else {
#pragma unroll 8
        for (int i = 0; i < 32; ++i) { const int kk = 2 * i + (lane >> 5); scr[kk * 33 + (lane & 31)] = 0.f; }
    }
    LDS_WAIT(); asm volatile("" ::: "memory");
    const int c = lane & 7;
#pragma unroll
    for (int j = 0; j < 4; ++j) { const int n = (lane >> 3) + 8 * j; const LAS float* s = scr + (8 * c) * 33 + n;
        v4u o; o.x = pk2(s[0 * 33], s[1 * 33]); o.y = pk2(s[2 * 33], s[3 * 33]); o.z = pk2(s[4 * 33], s[5 * 33]); o.w = pk2(s[6 * 33], s[7 * 33]);
        *(GAS v4u*)(WT + (size_t)(n0 + n) * K + k0 + 8 * c) = o; }
    LDS_WAIT(); asm volatile("" ::: "memory");
}
template <int PERMK> __device__ __forceinline__ void transpose_w(const float* W, int K, int Nact, int Nv, bf16* WT, int item, LAS float* scr, int lane) {
    const int nblk = Nv / 32, kb = item / nblk, nb = item % nblk, n0 = 32 * nb;
    int act = n0;
    if (PERMK == 1) { const int pn = n0 >> 8, rem = n0 & 255; act = (rem >> 7) * FFH + 128 * pn + (rem & 127); }
    if (PERMK == 2) { if (n0 >= Nact) act = -1; }
    transpose_item(W, K, Nact, WT, 64 * kb, n0, act, scr, lane);
}

struct RowInfo { int b, s, ctx, mi, gr, gc; };
__device__ __forceinline__ RowInfo row_info(int r) { RowInfo q; q.b = r / SROWS; q.s = r - q.b * SROWS; q.ctx = q.s < CTXL; q.mi = q.ctx ? 4 : q.b; const int t = q.s - CTXL; q.gr = t >> 6; q.gc = t & 63; return q; }

__device__ __forceinline__ void mods_unit(const Args& a, int l, int cg, LAS float* red, int tid, int lane, int wave) {
    float sreg[5][4];
#pragma unroll
    for (int j = 0; j < 5; ++j)
#pragma unroll
        for (int i = 0; i < 4; ++i) { const int k = 256 * wave + 64 * i + lane; const float cv = (j < 4) ? a.c[j * DM + k] : a.c_ctx[k]; sreg[j][i] = silu_f(cv); }
    f32x4 acc[5];
#pragma unroll
    for (int j = 0; j < 5; ++j) acc[j] = (f32x4){0.f, 0.f, 0.f, 0.f};
    const float* wp = a.ada_w + ((size_t)l * DM + 256 * wave) * 12288 + cg * 256 + 4 * lane;
#pragma unroll
    for (int i = 0; i < 4; ++i) {
#pragma unroll 8
        for (int kk = 0; kk < 64; ++kk) {
            const f32x4 w4 = *(const GAS f32x4*)(wp + (size_t)(64 * i + kk) * 12288);
#pragma unroll
            for (int j = 0; j < 5; ++j) { const float sj = __uint_as_float(__builtin_amdgcn_readlane(__float_as_uint(sreg[j][i]), kk)); acc[j] += sj * w4; }
        }
    }
#pragma unroll
    for (int j = 0; j < 5; ++j) *(LAS f32x4*)(red + (wave * 5 + j) * 256 + 4 * lane) = acc[j];
    __syncthreads();
    for (int o = tid; o < 1280; o += 512) { const int j = o >> 8, col = o & 255; float s = a.ada_b[l * 12288 + cg * 256 + col];
#pragma unroll
        for (int w = 0; w < 8; ++w) s += red[(w * 5 + j) * 256 + col];
        ((float*)(a.ws + WS_MODS))[(size_t)(l * 5 + j) * 12288 + cg * 256 + col] = s; }
    __syncthreads();
}
__device__ __forceinline__ void rope_tables(const Args& a, int gtid, int gthreads) {
    float* tab = (float*)(a.ws + WS_TAB);
    for (int i = gtid; i < 64 * 64 + 64 * 32 + 64 * 16; i += gthreads) {
        int nf, base, idx = i;
        if (idx < 64 * 64) { nf = 64; base = TAB_R; } else if (idx < 64 * 64 + 64 * 32) { idx -= 64 * 64; nf = 32; base = TAB_G; } else { idx -= 64 * 64 + 64 * 32; nf = 16; base = TAB_M; }
        const int pos = idx / nf, j = idx % nf;
        const float freq = powf(10000.0f, -(float)j / (float)nf);
        const float ang = (float)pos * freq;
        tab[base + 2 * idx] = cosf(ang); tab[base + 2 * idx + 1] = sinf(ang);
    }
    for (int col = gtid; col < 2048; col += gthreads) { const float r0 = a.hg_lb_raw[col], r1 = a.hg_lb_raw[2048 + col], r2 = a.hg_lb_raw[4096 + col], r3 = a.hg_lb_raw[6144 + col];
        const float mx = fmaxf(fmaxf(r0, r1), fmaxf(r2, r3)); const float e0 = expf(r0 - mx), e1 = expf(r1 - mx), e2 = expf(r2 - mx), e3 = expf(r3 - mx); const float sum = (e0 + e1) + (e2 + e3);
        const float p0 = e0 / sum, p1 = e1 / sum, p2 = e2 / sum, p3 = e3 / sum; tab[TAB_LB + col] = (((p0 + p1) + p2) + p3) - p0; }
}
__device__ __forceinline__ void init_rows(const Args& a, int gw, int NGW, int lane) {
    float* X = (float*)(a.ws + WS_X); bf16* H = (bf16*)(a.ws + WS_R1); const float* mods = (const float*)(a.ws + WS_MODS);
    for (int r = gw; r < MROWS; r += NGW) {
        const RowInfo q = row_info(r);
        const float* src = q.ctx ? a.ctx + ((size_t)q.b * CTXL + q.s) * DM : a.x + ((size_t)q.b * SEQ + (q.s - CTXL)) * DM;
        const float* mp = mods + (size_t)(0 * 5 + q.mi) * 12288;
#pragma unroll
        for (int j = 0; j < 8; ++j) { const int c = 4 * lane + 256 * j; const f32x4 v = *(const GAS f32x4*)(src + c);
            *(GAS f32x4*)(X + (size_t)r * DM + c) = v;
            const f32x4 sh = *(const GAS f32x4*)(mp + c), sc = *(const GAS f32x4*)(mp + 2048 + c);
            const f32x4 h = v * (1.0f + sc) + sh; u32x2v w; w.x = pk2(h[0], h[1]); w.y = pk2(h[2], h[3]);
            *(GAS u32x2v*)(H + (size_t)r * DM + c) = w; }
    }
}
__device__ __forceinline__ void ln_rows(const Args& a, int l, int which, int gw, int NGW, int lane) {
    float* X = (float*)(a.ws + WS_X); const float* Y = (const float*)(a.ws + WS_SCY); bf16* H = (bf16*)(a.ws + WS_R1); const float* mods = (const float*)(a.ws + WS_MODS);
    const float* lng = a.ln_g + (size_t)(l * 2 + which) * DM; const float* lnb = a.ln_b + (size_t)(l * 2 + which) * DM;
    const bool last = (l == 3 && which == 1);
    const int gate_i = which ? 5 : 2, nl = which ? l + 1 : l, nsh = which ? 0 : 3, nsc = which ? 1 : 4;
    for (int r = gw; r < MROWS; r += NGW) {
        const RowInfo q = row_info(r);
        const float* gp = mods + (size_t)(l * 5 + q.mi) * 12288 + gate_i * 2048;
        f32x4 z[8]; float s = 0.f;
#pragma unroll
        for (int j = 0; j < 8; ++j) { const int c = 4 * lane + 256 * j; const f32x4 xv = *(const GAS f32x4*)(X + (size_t)r * DM + c), yv = *(const GAS f32x4*)(Y + (size_t)r * DM + c), gv = *(const GAS f32x4*)(gp + c);
            z[j] = DN_ALPHA * xv + gv * yv; s += (z[j][0] + z[j][1]) + (z[j][2] + z[j][3]); }
        const float mean = wave_sum(s) * (1.0f / DM); float s2 = 0.f;
#pragma unroll
        for (int j = 0; j < 8; ++j) { z[j] = z[j] - mean; s2 += (z[j][0] * z[j][0] + z[j][1] * z[j][1]) + (z[j][2] * z[j][2] + z[j][3] * z[j][3]); }
        const float rstd = 1.0f / sqrtf(wave_sum(s2) * (1.0f / DM) + LN_EPS);
        const float* mp = mods + (size_t)((last ? 0 : nl) * 5 + q.mi) * 12288;
#pragma unroll
        for (int j = 0; j < 8; ++j) { const int c = 4 * lane + 256 * j; const f32x4 g4 = *(const GAS f32x4*)(lng + c), b4 = *(const GAS f32x4*)(lnb + c);
            const f32x4 xn = z[j] * rstd * g4 + b4;
            if (last) { if (!q.ctx) *(GAS f32x4*)(a.out + ((size_t)q.b * SEQ + (q.s - CTXL)) * DM + c) = xn; }
            else { *(GAS f32x4*)(X + (size_t)r * DM + c) = xn;
                const f32x4 sh = *(const GAS f32x4*)(mp + nsh * 2048 + c), sc = *(const GAS f32x4*)(mp + nsc * 2048 + c);
                const f32x4 h = xn * (1.0f + sc) + sh; u32x2v w; w.x = pk2(h[0], h[1]); w.y = pk2(h[2], h[3]);
                *(GAS u32x2v*)(H + (size_t)r * DM + c) = w; } }
    }
}
__device__ __forceinline__ void ret_rope_rows(const Args& a, int gw, int NGW, int lane) {
    bf16* P = (bf16*)(a.ws + WS_PROJ); const float* tab = (const float*)(a.ws + WS_TAB) + TAB_R;
    for (int r = gw; r < MROWS; r += NGW) {
        const RowInfo q = row_info(r);
#pragma unroll
        for (int i = 0; i < 4; ++i) { const int it = lane + 64 * i, tensor = it >> 7, head = (it >> 4) & 7, half = (it >> 3) & 1, grp = it & 7;
            bf16* p1 = P + (size_t)r * RET_N + tensor * 2048 + head * 256 + half * 128 + grp * 8; bf16* p2 = p1 + 64;
            if (q.ctx && tensor == 0) continue;
            float x1[8], x2[8]; unpack8(*(const GAS v4u*)p1, x1); unpack8(*(const GAS v4u*)p2, x2);
            const float ksc = tensor ? 0.0625f : 1.0f;
            float o1[8], o2[8];
            if (!q.ctx) { const int pos = half ? q.gc : q.gr; const float* tp = tab + (pos * 64 + grp * 8) * 2;
#pragma unroll
                for (int e = 0; e < 8; ++e) { const float cs = tp[2 * e], sn = tp[2 * e + 1]; o1[e] = (x1[e] * cs - x2[e] * sn) * ksc; o2[e] = (x1[e] * sn + x2[e] * cs) * ksc; } }
            else {
#pragma unroll
                for (int e = 0; e < 8; ++e) { o1[e] = x1[e] * ksc; o2[e] = x2[e] * ksc; } }
            *(GAS v4u*)p1 = pack8(o1); *(GAS v4u*)p2 = pack8(o2); }
    }
}
__device__ __forceinline__ void gqa_normrope_rows(const Args& a, int gw, int NGW, int lane) {
    bf16* P = (bf16*)(a.ws + WS_PROJ); const float* tab = (const float*)(a.ws + WS_TAB) + TAB_G;
    const int li = lane & 15, hsub = lane >> 4;
    const int half = li >> 3, second = (li >> 2) & 1, fj0 = (li & 3) * 8;
    for (int r = gw; r < MROWS; r += NGW) {
        const RowInfo q = row_info(r);
#pragma unroll
        for (int pass = 0; pass < 5; ++pass) { const int head = pass * 4 + hsub;
            bf16* p = P + (size_t)r * GQA_N + head * 128 + li * 8;
            const float* gain = (head < 16 ? a.gqa_qn : a.gqa_kn) + li * 8;
            float x[8]; unpack8(*(const GAS v4u*)p, x);
            float ss = 0.f;
#pragma unroll
            for (int e = 0; e < 8; ++e) ss += x[e] * x[e];
            ss += __shfl_xor(ss, 1); ss += __shfl_xor(ss, 2); ss += __shfl_xor(ss, 4); ss += __shfl_xor(ss, 8);
            const float rs = 1.0f / sqrtf(ss * (1.0f / 128.0f) + LN_EPS);
#pragma unroll
            for (int e = 0; e < 8; ++e) x[e] = x[e] * rs * gain[e];
            float o[8];
            if (!q.ctx) { const int pos = half ? q.gc : q.gr; const float* tp = tab + (pos * 32 + fj0) * 2;
#pragma unroll
                for (int e = 0; e < 8; ++e) { const float other = __shfl_xor(x[e], 4); const float cs = tp[2 * e], sn = tp[2 * e + 1];
                    o[e] = second ? (other * sn + x[e] * cs) : (x[e] * cs - other * sn); } }
            else {
#pragma unroll
                for (int e = 0; e < 8; ++e) o[e] = x[e]; }
            *(GAS v4u*)p = pack8(o); }
    }
}
__device__ __forceinline__ void mla_norm_rows(const Args& a, int gw, int NGW, int lane) {
    const bf16* C = (const bf16*)(a.ws + WS_PROJ + PJ_MLA_C); bf16* CQN = (bf16*)(a.ws + WS_PROJ + PJ_MLA_CQN); bf16* CKVN = (bf16*)(a.ws + WS_PROJ + PJ_MLA_CKVN); bf16* KR = (bf16*)(a.ws + WS_PROJ + PJ_MLA_KR);
    const float* tab = (const float*)(a.ws + WS_TAB) + TAB_M;
    for (int r = gw; r < MROWS; r += NGW) {
        const RowInfo q = row_info(r);
#pragma unroll
        for (int t = 0; t < 2; ++t) { float x[8]; unpack8(*(const GAS v4u*)(C + (size_t)r * MLA_NP + t * 512 + lane * 8), x);
            float ss = 0.f;
#pragma unroll
            for (int e = 0; e < 8; ++e) ss += x[e] * x[e];
            const float rs = 1.0f / sqrtf(wave_sum(ss) * (1.0f / 512.0f) + LN_EPS);
            const float* gain = (t ? a.mla_kvn : a.mla_qn) + lane * 8; float o[8];
#pragma unroll
            for (int e = 0; e < 8; ++e) o[e] = x[e] * rs * gain[e];
            *(GAS v4u*)((t ? CKVN : CQN) + (size_t)r * 512 + lane * 8) = pack8(o); }
        { const float xv = bf2f(C[(size_t)r * MLA_NP + 1024 + lane]); const float other = __shfl_xor(xv, 16);
          float ov = xv;
          if (!q.ctx) { const int half = lane >> 5, second = (lane >> 4) & 1, fj = lane & 15; const int pos = half ? q.gc : q.gr; const float cs = tab[(pos * 16 + fj) * 2], sn = tab[(pos * 16 + fj) * 2 + 1];
              ov = second ? (other * sn + xv * cs) : (xv * cs - other * sn); }
          KR[(size_t)r * 64 + lane] = (bf16)f2bf(ov); }
    }
}
__device__ __forceinline__ void mla_qrope_rows(const Args& a, int gw, int NGW, int lane) {
    bf16* Q = (bf16*)(a.ws + WS_PROJ + PJ_MLA_Q); const float* tab = (const float*)(a.ws + WS_TAB) + TAB_M;
    const int li = lane & 7, hsub = lane >> 3;
    const int half = li >> 2, second = (li >> 1) & 1, fj0 = (li & 1) * 8;
    for (int r = gw; r < MROWS; r += NGW) {
        const RowInfo q = row_info(r);
        if (q.ctx) continue;
#pragma unroll
        for (int pass = 0; pass < 2; ++pass) { const int head = pass * 8 + hsub;
            bf16* p = Q + (size_t)r * MLA_QN + head * 192 + 128 + li * 8;
            float x[8]; unpack8(*(const GAS v4u*)p, x);
            const int pos = half ? q.gc : q.gr; const float* tp = tab + (pos * 16 + fj0) * 2; float o[8];
#pragma unroll
            for (int e = 0; e < 8; ++e) { const float other = __shfl_xor(x[e], 2); const float cs = tp[2 * e], sn = tp[2 * e + 1];
                o[e] = second ? (other * sn + x[e] * cs) : (x[e] * cs - other * sn); }
            *(GAS v4u*)p = pack8(o); }
    }
}
__device__ __forceinline__ void ret_readout_rows(const Args& a, int gw, int NGW, int lane) {
    const bf16* SO = (const bf16*)(a.ws + WS_SCY); const bf16* P = (const bf16*)(a.ws + WS_PROJ); bf16* A2 = (bf16*)(a.ws + WS_R1);
    for (int r = gw; r < MROWS; r += NGW) {
#pragma unroll
        for (int h = 0; h < 8; ++h) { const int c = h * 512 + lane * 8;
            float f[8], b[8], g[8]; unpack8(*(const GAS v4u*)(SO + (size_t)r * 4096 + c), f); unpack8(*(const GAS v4u*)(SO + ((size_t)MROWS + r) * 4096 + c), b);
            unpack8(*(const GAS v4u*)(P + (size_t)r * RET_N + 8192 + c), g);
            float ss = 0.f;
#pragma unroll
            for (int e = 0; e < 8; ++e) { f[e] += b[e]; ss += f[e] * f[e]; }
            const float rs = 1.0f / sqrtf(wave_sum(ss) * (1.0f / 512.0f) + LN_EPS); float o[8];
#pragma unroll
            for (int e = 0; e < 8; ++e) o[e] = f[e] * rs * silu_f(g[e]);
            *(GAS v4u*)(A2 + (size_t)r * 4096 + c) = pack8(o); }
    }
}
__device__ __forceinline__ void hg_readout_rows(const Args& a, int gw, int NGW, int lane) {
    const bf16* SO = (const bf16*)(a.ws + WS_SCY); const bf16* P = (const bf16*)(a.ws + WS_PROJ); bf16* A2 = (bf16*)(a.ws + WS_R1);
    const int li = lane & 15;
    for (int r = gw; r < MROWS; r += NGW) {
#pragma unroll
        for (int pass = 0; pass < 4; ++pass) { const int c = pass * 512 + lane * 8;
            float f[8], b[8], g[8]; unpack8(*(const GAS v4u*)(SO + (size_t)r * 2048 + c), f); unpack8(*(const GAS v4u*)(SO + ((size_t)MROWS + r) * 2048 + c), b);
            unpack8(*(const GAS v4u*)(P + (size_t)r * HG_N + 8192 + c), g);
            float ss = 0.f;
#pragma unroll
            for (int e = 0; e < 8; ++e) { f[e] += b[e]; ss += f[e] * f[e]; }
            ss += __shfl_xor(ss, 1); ss += __shfl_xor(ss, 2); ss += __shfl_xor(ss, 4); ss += __shfl_xor(ss, 8);
            const float rs = 1.0f / sqrtf(ss * (1.0f / 128.0f) + LN_EPS); const float* gain = a.hg_on + li * 8; float o[8];
#pragma unroll
            for (int e = 0; e < 8; ++e) o[e] = f[e] * rs * gain[e] * silu_f(g[e]);
            *(GAS v4u*)(A2 + (size_t)r * 2048 + c) = pack8(o); }
    }
}
__device__ __forceinline__ void hg_prep_rows(const Args& a, int gw, int NGW, int lane) {
    bf16* P = (bf16*)(a.ws + WS_PROJ); const float* lbt = (const float*)(a.ws + WS_TAB) + TAB_LB;
    for (int r = gw; r < MROWS; r += NGW) {
#pragma unroll
        for (int pass = 0; pass < 12; ++pass) { const int c = pass * 512 + lane * 8;
            bf16* p = P + (size_t)r * HG_N + c; float x[8], o[8]; unpack8(*(const GAS v4u*)p, x);
            if (pass < 4) {
#pragma unroll
                for (int e = 0; e < 8; ++e) o[e] = silu_f(x[e]); }
            else { const float* lb = lbt + (c & 2047);
#pragma unroll
                for (int e = 0; e < 8; ++e) o[e] = (1.0f - lb[e]) / (1.0f + __expf(x[e])); }
            *(GAS v4u*)p = pack8(o); }
    }
}
__device__ __forceinline__ int scan_row(int p, int dir) { return dir ? (p < CTXL ? CTXL - 1 - p : SROWS + CTXL - 1 - p) : p; }
__device__ __forceinline__ void ret_scan_simple(const Args& a, LAS unsigned char* lds, int tid) {
    const bf16* P = (const bf16*)(a.ws + WS_PROJ); bf16* SO = (bf16*)(a.ws + WS_SCY);
    LAS float* qs = (LAS float*)lds; LAS float* ks = qs + 16 * 256; LAS float* vsm = ks + 16 * 256; LAS float* op = vsm + 16 * 128;
    const int dv = tid & 127, g = tid >> 7;
    for (int u = blockIdx.x; u < 256; u += gridDim.x) {
        const int b = u >> 6, h = (u >> 3) & 7, dir = (u >> 2) & 1, vs = u & 3;
        const float gamma = expf((dir ? a.ret_db : a.ret_df)[h]);
        float S[64];
#pragma unroll
        for (int j = 0; j < 64; ++j) S[j] = 0.f;
        for (int p0 = 0; p0 < SROWS; p0 += 16) {
            { const int pp = tid >> 5, ch = tid & 31; const size_t row = (size_t)b * SROWS + scan_row(p0 + pp, dir);
              float f[8]; unpack8(*(const GAS v4u*)(P + row * RET_N + h * 256 + ch * 8), f);
              *(LAS f32x4*)(qs + pp * 256 + ch * 8) = (f32x4){f[0], f[1], f[2], f[3]}; *(LAS f32x4*)(qs + pp * 256 + ch * 8 + 4) = (f32x4){f[4], f[5], f[6], f[7]};
              unpack8(*(const GAS v4u*)(P + row * RET_N + 2048 + h * 256 + ch * 8), f);
              *(LAS f32x4*)(ks + pp * 256 + ch * 8) = (f32x4){f[0], f[1], f[2], f[3]}; *(LAS f32x4*)(ks + pp * 256 + ch * 8 + 4) = (f32x4){f[4], f[5], f[6], f[7]};
              const u32x2v w = *(const GAS u32x2v*)(P + row * RET_N + 4096 + h * 512 + vs * 128 + ch * 4);
              *(LAS f32x4*)(vsm + pp * 128 + ch * 4) = (f32x4){bflo(w.x), bfhi(w.x), bflo(w.y), bfhi(w.y)}; }
            __syncthreads();
            for (int pp = 0; pp < 16; ++pp) {
                const float vv = vsm[pp * 128 + dv]; float acc = 0.f;
#pragma unroll
                for (int j4 = 0; j4 < 16; ++j4) { const f32x4 k4 = *(const LAS f32x4*)(ks + pp * 256 + 64 * g + 4 * j4), q4 = *(const LAS f32x4*)(qs + pp * 256 + 64 * g + 4 * j4);
#pragma unroll
                    for (int e = 0; e < 4; ++e) { S[4 * j4 + e] = fmaf(gamma, S[4 * j4 + e], k4[e] * vv); acc = fmaf(q4[e], S[4 * j4 + e], acc); } }
                op[(pp * 4 + g) * 128 + dv] = acc;
            }
            __syncthreads();
#pragma unroll
            for (int i = 0; i < 4; ++i) { const int idx = tid + 512 * i, pp = idx >> 7, d = idx & 127;
                const float o = (op[(pp * 4 + 0) * 128 + d] + op[(pp * 4 + 1) * 128 + d]) + (op[(pp * 4 + 2) * 128 + d] + op[(pp * 4 + 3) * 128 + d]);
                const size_t row = (size_t)b * SROWS + scan_row(p0 + pp, dir);
                SO[((size_t)dir * MROWS + row) * 4096 + h * 512 + vs * 128 + d] = (bf16)f2bf(o); }
        }
        __syncthreads();
    }
}
__device__ __forceinline__ void hg_scan_simple(const Args& a, LAS unsigned char* lds, int tid) {
    const bf16* P = (const bf16*)(a.ws + WS_PROJ); bf16* SO = (bf16*)(a.ws + WS_SCY);
    LAS float* qs = (LAS float*)lds; LAS float* fs = qs + 16 * 128; LAS float* kk = fs + 16 * 128; LAS float* is = kk + 16 * 128; LAS float* op = is + 16 * 64; LAS float* lbs = op + 16 * 8 * 64;
    const int dv = tid & 63, g8 = tid >> 6;
    for (int u = blockIdx.x; u < 256; u += gridDim.x) {
        const int b = u >> 6, h = (u >> 2) & 15, dir = (u >> 1) & 1, vs = u & 1;
        if (tid < 128) { const int col = h * 128 + tid; const float r0 = a.hg_lb_raw[col], r1 = a.hg_lb_raw[2048 + col], r2 = a.hg_lb_raw[4096 + col], r3 = a.hg_lb_raw[6144 + col];
            const float mx = fmaxf(fmaxf(r0, r1), fmaxf(r2, r3)); const float e0 = expf(r0 - mx), e1 = expf(r1 - mx), e2 = expf(r2 - mx), e3 = expf(r3 - mx); const float sum = (e0 + e1) + (e2 + e3);
            const float p0 = e0 / sum, p1 = e1 / sum, p2 = e2 / sum, p3 = e3 / sum; lbs[tid] = (((p0 + p1) + p2) + p3) - p0; }
        __syncthreads();
        float S[16];
#pragma unroll
        for (int j = 0; j < 16; ++j) S[j] = 0.f;
        for (int p0 = 0; p0 < SROWS; p0 += 16) {
            { const int pp = tid >> 5, ch = tid & 31; const size_t row = (size_t)b * SROWS + scan_row(p0 + pp, dir);
              const u32x2v wq = *(const GAS u32x2v*)(P + row * HG_N + h * 128 + ch * 4), wf = *(const GAS u32x2v*)(P + row * HG_N + (dir ? 4096 : 2048) + h * 128 + ch * 4);
              const float qv[4] = {bflo(wq.x), bfhi(wq.x), bflo(wq.y), bfhi(wq.y)}, fv[4] = {bflo(wf.x), bfhi(wf.x), bflo(wf.y), bfhi(wf.y)};
              f32x4 qo, fo, ko;
#pragma unroll
              for (int e = 0; e < 4; ++e) { const float lb = lbs[ch * 4 + e]; const float f = lb + (1.0f - lb) * sigmoid_f(fv[e]); qo[e] = silu_f(qv[e]); fo[e] = f; ko[e] = 1.0f - f; }
              *(LAS f32x4*)(qs + pp * 128 + ch * 4) = qo; *(LAS f32x4*)(fs + pp * 128 + ch * 4) = fo; *(LAS f32x4*)(kk + pp * 128 + ch * 4) = ko;
              const unsigned wi = *(const GAS unsigned*)(P + row * HG_N + 6144 + h * 128 + vs * 64 + ch * 2);
              *(LAS f32x2v*)(is + pp * 64 + ch * 2) = (f32x2v){bflo(wi), bfhi(wi)}; }
            __syncthreads();
            for (int pp = 0; pp < 16; ++pp) {
                const float iv = is[pp * 64 + dv]; float acc = 0.f;
#pragma unroll
                for (int j4 = 0; j4 < 4; ++j4) { const f32x4 f4 = *(const LAS f32x4*)(fs + pp * 128 + 16 * g8 + 4 * j4), k4 = *(const LAS f32x4*)(kk + pp * 128 + 16 * g8 + 4 * j4), q4 = *(const LAS f32x4*)(qs + pp * 128 + 16 * g8 + 4 * j4);
#pragma unroll
                    for (int e = 0; e < 4; ++e) { S[4 * j4 + e] = fmaf(f4[e], S[4 * j4 + e], k4[e] * iv); acc = fmaf(q4[e], S[4 * j4 + e], acc); } }
                op[(pp * 8 + g8) * 64 + dv] = acc;
            }
            __syncthreads();
#pragma unroll
            for (int i = 0; i < 2; ++i) { const int idx = tid + 512 * i, pp = idx >> 6, d = idx & 63; float o = 0.f;
#pragma unroll
                for (int w = 0; w < 8; ++w) o += op[(pp * 8 + w) * 64 + d];
                const size_t row = (size_t)b * SROWS + scan_row(p0 + pp, dir);
                SO[((size_t)dir * MROWS + row) * 2048 + h * 128 + vs * 64 + d] = (bf16)f2bf(o); }
        }
        __syncthreads();
    }
}
constexpr int NPH = 2 + 11 * 4;
#define IN(k) (lo <= (k) && (k) < hi)
#define SEAM(k) do { if (a.use_bar && hi > (k) + 1) xcd_barrier(bar); } while (0)
template <int l> __device__ __forceinline__ void run_layer(const Args& a, LAS unsigned char* lds, const XcdBarrier& bar, int tid, int lane, int wave, int G, int gw, int NGW) {
    const int lo = a.ph_lo, hi = a.ph_hi; unsigned char* ws = a.ws;
    bf16* const H = (bf16*)(ws + WS_R1); bf16* const PROJ = (bf16*)(ws + WS_PROJ); float* const Y = (float*)(ws + WS_SCY);
        const int pb = 2 + 11 * l;
        if (IN(pb)) {
            const bf16* Bt; int N; bf16* O;
            if (l == 0) { Bt = (const bf16*)(ws + WS_W_RET_IN); N = RET_N; O = PROJ; }
            else if (l == 1) { Bt = (const bf16*)(ws + WS_W_GQA_IN); N = GQA_N; O = PROJ; }
            else if (l == 2) { Bt = (const bf16*)(ws + WS_W_MLA_IN); N = MLA_NP; O = (bf16*)(ws + WS_PROJ + PJ_MLA_C); }
            else { Bt = (const bf16*)(ws + WS_W_HG_IN); N = HG_N; O = PROJ; }
            pg8::Gemm g{H, Bt, MROWS, N, DM}; pg8::StaticOrder S; S.init(MROWS, N, G, (int)blockIdx.x); pg8::EpiBf16P E{O, N};
            pg8::gemm_phase<pg8::EpiBf16P, pg8::StaticOrder, true, true>(lds, g, S, E);
            SEAM(pb);
        }
        if (IN(pb + 1)) {
            if (l == 0) ret_rope_rows(a, gw, NGW, lane); else if (l == 1) gqa_normrope_rows(a, gw, NGW, lane); else if (l == 2) mla_norm_rows(a, gw, NGW, lane); else hg_prep_rows(a, gw, NGW, lane);
            SEAM(pb + 1);
        }
        if (IN(pb + 2) && l == 2) {
            { pg8::Gemm g{(const bf16*)(ws + WS_PROJ + PJ_MLA_CQN), (const bf16*)(ws + WS_W_MLA_QUP), MROWS, MLA_QN, 512}; pg8::StaticOrder S; S.init(MROWS, MLA_QN, G, (int)blockIdx.x);
              pg8::EpiBf16P E{(bf16*)(ws + WS_PROJ + PJ_MLA_Q), MLA_QN}; pg8::gemm_phase<pg8::EpiBf16P, pg8::StaticOrder, true, true>(lds, g, S, E); }
            { pg8::Gemm g{(const bf16*)(ws + WS_PROJ + PJ_MLA_CKVN), (const bf16*)(ws + WS_W_MLA_KVUP), MROWS, MLA_KVN, 512}; pg8::StaticOrder S; S.init(MROWS, MLA_KVN, G, (int)blockIdx.x);
              pg8::EpiBf16P E{(bf16*)(ws + WS_PROJ + PJ_MLA_KV), MLA_KVN}; pg8::gemm_phase<pg8::EpiBf16P, pg8::StaticOrder, true, true>(lds, g, S, E); }
            SEAM(pb + 2);
        }
        if (IN(pb + 3) && l == 2) { mla_qrope_rows(a, gw, NGW, lane); SEAM(pb + 3); }
        if (IN(pb + 4)) {
            if (l == 0) scan::ret_scan_mfma((const bf16*)(ws + WS_PROJ), (bf16*)(ws + WS_SCY), a.ret_df, a.ret_db, lds, tid);
            else if (l == 3) scan::hg_scan_mfma((const bf16*)(ws + WS_PROJ), (bf16*)(ws + WS_SCY), lds, tid);
            else {
                bf16* const A2 = (bf16*)(ws + WS_R1);
                for (int uidx = blockIdx.x; uidx < 1088; uidx += G) {
                    int b, h, qb, ctxu = 0;
                    if (uidx < 1024) { const int x = uidx & 7, y = (uidx >> 3) & 31, rnd = uidx >> 8;
                        if (l == 1) { const int combo = 2 * x + (y >> 4), w = (y & 15) + 16 * rnd; b = combo >> 2; h = (combo & 3) * 4 + (w >> 4); qb = w & 15; }
                        else { const int combo = 2 * x + (y >> 4) + 16 * rnd; b = combo >> 4; h = combo & 15; qb = y & 15; } }
                    else { const int c = uidx - 1024; b = c >> 4; h = c & 15; qb = 0; ctxu = 1; }
                    const size_t rb = (size_t)b * SROWS, r0 = rb + (ctxu ? 0 : CTXL + qb * 256); const int seq = ctxu ? CTXL : SROWS;
                    if (l == 1) { const bf16* QKV = PROJ; const int kvh = h >> 2;
                        att::attn_unit<8, 8, 2, GQA_N, GQA_N, GQA_N, GQA_N, DM>(QKV + r0 * GQA_N + h * 128, QKV + rb * GQA_N + 2048 + kvh * 128, QKV + rb * GQA_N + 2048 + kvh * 128,
                                             QKV + rb * GQA_N + 2560 + kvh * 128, A2 + r0 * DM + h * 128, seq, 0.08838834764831845f * 1.4426950408889634f, 8.0f / 0.08838834764831845f, (ATT_LAS char*)lds); }
                    else { const bf16* Q = (const bf16*)(ws + WS_PROJ + PJ_MLA_Q); const bf16* KV = (const bf16*)(ws + WS_PROJ + PJ_MLA_KV); const bf16* KR = (const bf16*)(ws + WS_PROJ + PJ_MLA_KR);
                        att::attn_unit<12, 4, 1, MLA_QN, MLA_KVN, 64, MLA_KVN, DM>(Q + r0 * MLA_QN + h * 192, KV + rb * MLA_KVN + h * 256, KR + rb * 64,
                                              KV + rb * MLA_KVN + h * 256 + 128, A2 + r0 * DM + h * 128, seq, 0.07216878364870323f * 1.4426950408889634f, 8.0f / 0.07216878364870323f, (ATT_LAS char*)lds); }
                }
            }
            SEAM(pb + 4);
        }
        if (IN(pb + 5) && (l == 0 || l == 3)) { if (l == 0) ret_readout_rows(a, gw, NGW, lane); else hg_readout_rows(a, gw, NGW, lane); SEAM(pb + 5); }
        if (IN(pb + 6)) {
            const bf16* Bt = (const bf16*)(ws + (l == 0 ? WS_W_RET_OUT : l == 1 ? WS_W_GQA_OUT : l == 2 ? WS_W_MLA_OUT : WS_W_HG_OUT)); const int K = (l == 0) ? 4096 : DM;
            pg8::Gemm g{(const bf16*)(ws + WS_R1), Bt, MROWS, DM, K}; pg8::StaticOrder S; S.init(MROWS, DM, G, (int)blockIdx.x); pg8::EpiF32P E{Y, DM};
            pg8::gemm_phase<pg8::EpiF32P, pg8::StaticOrder, true, true>(lds, g, S, E);
            SEAM(pb + 6);
        }
        if (IN(pb + 7)) { ln_rows(a, l, 0, gw, NGW, lane); SEAM(pb + 7); }
        if (IN(pb + 8)) {
            pg8::Gemm g{H, (const bf16*)(ws + WS_W_FFN_IN + l * FFN_IN_BYTES), MROWS, 2 * FFH, DM}; pg8::StaticOrder S; S.init(MROWS, 2 * FFH, G, (int)blockIdx.x); pg8::EpiSwiglu E{PROJ, FFH};
            pg8::gemm_phase<pg8::EpiSwiglu, pg8::StaticOrder, true, true>(lds, g, S, E);
            SEAM(pb + 8);
        }
        if (IN(pb + 9)) {
            pg8::Gemm g{PROJ, (const bf16*)(ws + WS_W_FFN_OUT + l * FFN_OUT_BYTES), MROWS, DM, FFH}; pg8::StaticOrder S; S.init(MROWS, DM, G, (int)blockIdx.x); pg8::EpiF32P E{Y, DM};
            pg8::gemm_phase<pg8::EpiF32P, pg8::StaticOrder, true, true>(lds, g, S, E);
            SEAM(pb + 9);
        }
        if (IN(pb + 10)) { ln_rows(a, l, 1, gw, NGW, lane); SEAM(pb + 10); }
    }
__global__ void __launch_bounds__(NWAVES * 64, 2) mk_fwd(Args a) {
    extern __shared__ __attribute__((aligned(16))) unsigned char lds_raw[];
    LAS unsigned char* lds = (LAS unsigned char*)lds_raw;
    const int tid = threadIdx.x, lane = tid & 63, wave = __builtin_amdgcn_readfirstlane(tid >> 6);
    const int G = gridDim.x, gw = blockIdx.x * NWAVES + wave, NGW = G * NWAVES;
    volatile LAS unsigned* MISC = (volatile LAS unsigned*)(lds + MISC_OFF);
    if (tid < 128) ((LAS unsigned*)(lds + MISC_OFF))[tid] = 0u;
    __syncthreads();
    gu32* ctl = (gu32*)(a.ws + WS_CTL);
    XcdBarrier bar; bar.bar = (unsigned*)ctl + CW_BAR; bar.x = 0; bar.st = nullptr;
    if (a.use_bar) bar = xcd_barrier_post((unsigned*)ctl + CW_BAR, MISC + 8);
    const int lo = a.ph_lo, hi = a.ph_hi;
    unsigned char* ws = a.ws;
    bf16* const H = (bf16*)(ws + WS_R1); bf16* const PROJ = (bf16*)(ws + WS_PROJ); float* const Y = (float*)(ws + WS_SCY);

    if (IN(0)) {
        LAS float* scr = (LAS float*)(lds + wave * 16384);
        constexpr int I_RI = 32 * (RET_N / 32), I_RO = 64 * 64, I_GI = 32 * (GQA_N / 32), I_GO = 32 * 64, I_MI = 32 * (MLA_NP / 32), I_MQ = 8 * (MLA_QN / 32), I_MK = 8 * (MLA_KVN / 32), I_MO = 32 * 64,
                      I_HI = 32 * (HG_N / 32), I_HO = 32 * 64, I_FI = 32 * (2 * FFH / 32), I_FO = (FFH / 64) * 64;
        constexpr int NITEMS = I_RI + I_RO + I_GI + I_GO + I_MI + I_MQ + I_MK + I_MO + I_HI + I_HO + 4 * I_FI + 4 * I_FO;
        for (int it = gw; it < NITEMS; it += NGW) {
            int r = it;
            if (r < I_RI) { transpose_w<0>(a.ret_w_in, DM, RET_N, RET_N, (bf16*)(ws + WS_W_RET_IN), r, scr, lane); continue; } r -= I_RI;
            if (r < I_RO) { transpose_w<0>(a.ret_w_out, 4096, DM, DM, (bf16*)(ws + WS_W_RET_OUT), r, scr, lane); continue; } r -= I_RO;
            if (r < I_GI) { transpose_w<0>(a.gqa_w_in, DM, GQA_N, GQA_N, (bf16*)(ws + WS_W_GQA_IN), r, scr, lane); continue; } r -= I_GI;
            if (r < I_GO) { transpose_w<0>(a.gqa_w_out, DM, DM, DM, (bf16*)(ws + WS_W_GQA_OUT), r, scr, lane); continue; } r -= I_GO;
            if (r < I_MI) { transpose_w<2>(a.mla_w_in, DM, MLA_NACT, MLA_NP, (bf16*)(ws + WS_W_MLA_IN), r, scr, lane); continue; } r -= I_MI;
            if (r < I_MQ) { transpose_w<0>(a.mla_w_qup, 512, MLA_QN, MLA_QN, (bf16*)(ws + WS_W_MLA_QUP), r, scr, lane); continue; } r -= I_MQ;
            if (r < I_MK) { transpose_w<0>(a.mla_w_kvup, 512, MLA_KVN, MLA_KVN, (bf16*)(ws + WS_W_MLA_KVUP), r, scr, lane); continue; } r -= I_MK;
            if (r < I_MO) { transpose_w<0>(a.mla_w_out, DM, DM, DM, (bf16*)(ws + WS_W_MLA_OUT), r, scr, lane); continue; } r -= I_MO;
            if (r < I_HI) { transpose_w<0>(a.hg_w_in, DM, HG_N, HG_N, (bf16*)(ws + WS_W_HG_IN), r, scr, lane); continue; } r -= I_HI;
            if (r < I_HO) { transpose_w<0>(a.hg_w_out, DM, DM, DM, (bf16*)(ws + WS_W_HG_OUT), r, scr, lane); continue; } r -= I_HO;
            if (r < 4 * I_FI) { const int l = r / I_FI; transpose_w<1>(a.ffn_w_in + (size_t)l * DM * 2 * FFH, DM, 2 * FFH, 2 * FFH, (bf16*)(ws + WS_W_FFN_IN + l * FFN_IN_BYTES), r % I_FI, scr, lane); continue; } r -= 4 * I_FI;
            { const int l = r / I_FO; transpose_w<0>(a.ffn_w_out + (size_t)l * FFH * DM, FFH, DM, DM, (bf16*)(ws + WS_W_FFN_OUT + l * FFN_OUT_BYTES), r % I_FO, scr, lane); }
        }
        __syncthreads();
        for (int u = blockIdx.x; u < 192; u += G) mods_unit(a, u / 48, u % 48, (LAS float*)lds, tid, lane, wave);
        rope_tables(a, blockIdx.x * (NWAVES * 64) + tid, G * NWAVES * 64);
        SEAM(0);
    }
    if (IN(1)) { init_rows(a, gw, NGW, lane); SEAM(1); }

    run_layer<0>(a, lds, bar, tid, lane, wave, G, gw, NGW);
    run_layer<1>(a, lds, bar, tid, lane, wave, G, gw, NGW);
    run_layer<2>(a, lds, bar, tid, lane, wave, G, gw, NGW);
    run_layer<3>(a, lds, bar, tid, lane, wave, G, gw, NGW);
}

#ifndef MK_PER_PHASE
#define MK_PER_PHASE 0
#endif
extern "C" void kernel_launch(void* const* d_in, const int* in_sizes, int n_in, void* d_out, int out_size, void* d_ws, size_t ws_size, hipStream_t stream) {
    static int grid = 0;
    if (grid == 0) {
        if (n_in != 28 || out_size != NBATCH * SEQ * DM || ws_size < WS_END) { fprintf(stderr, "kernel_launch: unexpected shapes (n_in %d out %d ws %zu)\n", n_in, out_size, ws_size); grid = -1; return; }
        int dev = 0, cus = 0, per_cu = 0;
        if (hipGetDevice(&dev) != hipSuccess || hipDeviceGetAttribute(&cus, hipDeviceAttributeMultiprocessorCount, dev) != hipSuccess) { grid = -1; return; }
        if (hipFuncSetAttribute((const void*)mk_fwd, hipFuncAttributeMaxDynamicSharedMemorySize, LDS_BYTES) != hipSuccess) { fprintf(stderr, "kernel_launch: hipFuncSetAttribute failed\n"); grid = -1; return; }
        if (hipOccupancyMaxActiveBlocksPerMultiprocessor(&per_cu, (const void*)mk_fwd, NWAVES * 64, LDS_BYTES) != hipSuccess || per_cu < 1) { fprintf(stderr, "kernel_launch: occupancy query says %d\n", per_cu); }
        (void)hipGetLastError();
        grid = cus;
    }
    if (grid < 0) return;
    if (hipMemsetAsync((char*)d_ws + WS_CTL, 0, CTL_ZERO_BYTES, stream) != hipSuccess) return;
    Args a{};
    const float** ap = (const float**)&a;
    for (int i = 0; i < 28; ++i) ap[i] = (const float*)d_in[i];
    a.out = (float*)d_out; a.ws = (unsigned char*)d_ws; a.pad = 0;
#if MK_PER_PHASE
    for (int p = 0; p < NPH; ++p) { a.ph_lo = p; a.ph_hi = p + 1; a.use_bar = 0; hipLaunchKernelGGL(mk_fwd, dim3(grid), dim3(NWAVES * 64), LDS_BYTES, stream, a); }
#else
    a.ph_lo = 0; a.ph_hi = NPH; a.use_bar = 1;
    hipLaunchKernelGGL(mk_fwd, dim3(grid), dim3(NWAVES * 64), LDS_BYTES, stream, a);
#endif
    const hipError_t le = hipPeekAtLastError();
    if (le != hipSuccess) fprintf(stderr, "kernel_launch: launch failed: %s\n", hipGetErrorName(le));
}
```

```cpp
#include <hip/hip_runtime.h>
#include <hip/hip_bf16.h>
#include <cstdio>
#include <cstdint>
namespace pg8 {
#define PG8_LAS __attribute__((address_space(3)))
typedef unsigned short bf16_t;
typedef short bf16x8 __attribute__((ext_vector_type(8)));
typedef float f32x4 __attribute__((ext_vector_type(4)));
typedef unsigned u32x4 __attribute__((ext_vector_type(4)));
constexpr int BM = 256, BK = 64, HALF = 128, HTB = HALF * BK * 2  , STAGE_BYTES = 8 * HTB, NXCD = 8, WGM = 8;

__host__ __device__ __forceinline__ int lds_byte(int r, int c) { const int st = (r >> 4) * 2 + (c >> 5), rr = r & 15, cc = c & 31, ob = rr * 64 + cc * 2; return st * 1024 + (ob ^ (((ob >> 9) & 1) << 5)); }
__host__ __device__ __forceinline__ void stage_rc(int b, int& R, int& C) { const int st = b / 1024, sb = b % 1024, swz = sb ^ (((sb >> 9) & 1) << 5); R = (st >> 1) * 16 + swz / 64; C = (st & 1) * 32 + (swz % 64) / 2; }
__host__ __device__ __forceinline__ int perm32(int rho) { const int n = rho >> 4, i = rho & 15; return 8 * (i >> 2) + 4 * n + (i & 3); }

struct Unit { int pm, pn, kb, nt, ks; };
struct Gemm { const bf16_t* A; const bf16_t* Bt; int M, N, K; };

struct StaticOrder {
    int nM, nN, nwg, G, c, ntk;
    __host__ __device__ void init(int M, int N, int K, int G_, int c_) { nM = M / BM; nN = N / BM; nwg = nM * nN; G = G_; c = c_; ntk = K / BK; }
    __host__ __device__ bool next(int i, Unit& u) const {
        const long L = (long)i * G + c; if (L >= nwg) return false;
        int wgid = (int)L; { const int q = nwg / NXCD, r = nwg % NXCD, xcd = wgid % NXCD, off = wgid / NXCD; wgid = (xcd < r ? xcd * (q + 1) : r * (q + 1) + (xcd - r) * q) + off; }
        const int nig = WGM * nN, gid = wgid / nig, fm = gid * WGM, gsz = (nM - fm) < WGM ? (nM - fm) : WGM;
        u.pm = fm + ((wgid % nig) % gsz); u.pn = (wgid % nig) / gsz; u.kb = 0; u.nt = ntk; u.ks = 0; return true;
    }
    __device__ __forceinline__ void a_ready(const Unit&) const {}
    __device__ __forceinline__ void done(const Unit&) const {}
};

struct LatCtxOrder {
    StaticOrder lat; int G, c, ntk, nsplit;
    __host__ __device__ void init(int K, int G_, int c_, int nsplit_) { lat.init(64 * BM, 8 * BM, K, G_, c_); G = G_; c = c_; ntk = K / BK; nsplit = nsplit_; }
    __host__ __device__ bool next(int i, Unit& u) const {
        const long L = (long)i * G + c;
        if (L < 512) { lat.next(i, u); u.pm = 17 * (u.pm >> 4) + 1 + (u.pm & 15); return true; }
        const int j = (int)(L - 512); if (j >= 32 * nsplit) return false;
        const int tile = j / nsplit, ks = j - tile * nsplit; u.pm = 17 * (tile >> 3); u.pn = tile & 7; u.nt = ntk / nsplit; u.kb = ks * u.nt; u.ks = ks; return true;
    }
    __device__ __forceinline__ void a_ready(const Unit&) const {}
    __device__ __forceinline__ void done(const Unit&) const {}
};

__device__ __forceinline__ unsigned cvt_pk_bf16(float lo, float hi) { unsigned r; asm volatile("v_cvt_pk_bf16_f32 %0, %1, %2" : "=v"(r) : "v"(lo), "v"(hi)); return r; }
struct EpiBf16P {
    static constexpr bool PERM = true, AFTER_DRAIN = false;
    bf16_t* O; int ldc;
    __device__ __forceinline__ void operator()(const f32x4 (&acc)[2][2][4][2], const Unit& u, int wr, int wc, int fr, int fq) const {
        const int row0 = u.pm * BM + wr * 64 + fr, col0 = u.pn * BM + wc * 32 + 8 * fq;
#pragma unroll
        for (int ai = 0; ai < 2; ++ai)
#pragma unroll
            for (int m = 0; m < 4; ++m) { bf16_t* rowp = O + (size_t)(row0 + ai * HALF + m * 16) * ldc + col0;
#pragma unroll
                for (int bj = 0; bj < 2; ++bj) { const f32x4 v0 = acc[ai][bj][m][0], v1 = acc[ai][bj][m][1];
                    u32x4 w; w.x = cvt_pk_bf16(v0[0], v0[1]); w.y = cvt_pk_bf16(v0[2], v0[3]); w.z = cvt_pk_bf16(v1[0], v1[1]); w.w = cvt_pk_bf16(v1[2], v1[3]);
                    *(u32x4*)(rowp + bj * HALF) = w; } }
    }
};
struct EpiF32P {
    static constexpr bool PERM = false, AFTER_DRAIN = false;
    float* C; int ldc; float* CS; int ctx_nsplit;
    __device__ __forceinline__ void operator()(const f32x4 (&acc)[2][2][4][2], const Unit& u, int wr, int wc, int fr, int fq) const {
        const int col0 = u.pn * BM + wc * 32 + 4 * fq; int row0 = u.pm * BM + wr * 64 + fr; float* base = C;
        if (ctx_nsplit > 1 && (u.pm % 17) == 0) { base = CS + (size_t)u.ks * (1024 * (size_t)ldc); row0 = (u.pm / 17) * BM + wr * 64 + fr; }
#pragma unroll
        for (int ai = 0; ai < 2; ++ai)
#pragma unroll
            for (int m = 0; m < 4; ++m) { float* rowp = base + (size_t)(row0 + ai * HALF + m * 16) * ldc + col0;
#pragma unroll
                for (int bj = 0; bj < 2; ++bj)
#pragma unroll
                    for (int n = 0; n < 2; ++n) *(f32x4*)(rowp + bj * HALF + n * 16) = acc[ai][bj][m][n]; }
    }
};
__device__ __forceinline__ float silu_mul(float a, float b) { return a * b * __builtin_amdgcn_rcpf(1.0f + __builtin_amdgcn_exp2f(a * -1.4426950408889634f)); }
struct EpiSwiglu {
    static constexpr bool PERM = true, AFTER_DRAIN = false;
    bf16_t* O; int ldc;
    __device__ __forceinline__ void operator()(const f32x4 (&acc)[2][2][4][2], const Unit& u, int wr, int wc, int fr, int fq) const {
        const int row0 = u.pm * BM + wr * 64 + fr, col0 = u.pn * HALF + wc * 32 + 8 * fq;
#pragma unroll
        for (int ai = 0; ai < 2; ++ai)
#pragma unroll
            for (int m = 0; m < 4; ++m) { bf16_t* rowp = O + (size_t)(row0 + ai * HALF + m * 16) * ldc + col0;
                const f32x4 a0 = acc[ai][0][m][0], a1 = acc[ai][0][m][1], b0 = acc[ai][1][m][0], b1 = acc[ai][1][m][1];
                u32x4 w; w.x = cvt_pk_bf16(silu_mul(a0[0], b0[0]), silu_mul(a0[1], b0[1])); w.y = cvt_pk_bf16(silu_mul(a0[2], b0[2]), silu_mul(a0[3], b0[3]));
                w.z = cvt_pk_bf16(silu_mul(a1[0], b1[0]), silu_mul(a1[1], b1[1])); w.w = cvt_pk_bf16(silu_mul(a1[2], b1[2]), silu_mul(a1[3], b1[3]));
                *(u32x4*)rowp = w; }
    }
};

template <class Epi, class Sched, bool ALIGN_EPI = false, bool SP2 = false>
__device__ __forceinline__ void gemm_phase(PG8_LAS unsigned char* lds, const Gemm g, const Sched& S, const Epi& E) {
    const int tid = threadIdx.x, wid = __builtin_amdgcn_readfirstlane(tid >> 6), lane = tid & 63, wr = wid >> 2, wc = wid & 3, fr = lane & 15, fq = lane >> 4;
    const int K = g.K;
    unsigned voffA[2], voffB[2];
#pragma unroll
    for (int i = 0; i < 2; ++i) { int R, C; stage_rc(tid * 16 + i * 8192, R, C); const int Rb = Epi::PERM ? ((R & ~31) + perm32(R & 31)) : R;
        voffA[i] = (unsigned)(R * K + C) * 2u; voffB[i] = (unsigned)(Rb * K + C) * 2u; }
    const size_t kstep = (size_t)(BK * 2);
    const size_t hstep = (size_t)HALF * K * 2;
    const size_t tstep = 2 * hstep;
    const unsigned ldsw = (unsigned)wid * 1024u;
    const int aoff = lds_byte(wr * 64 + fr, fq * 8), boff = lds_byte(wc * 32 + fr, fq * 8);
#define PG8_SA(b, h) (((b) * 2 + (h)) * HTB)
#define PG8_SB(b, h) ((4 + (b) * 2 + (h)) * HTB)
#define PG8_STAGE(bufoff, gbase, voff) do { _Pragma("unroll") for (int _i = 0; _i < 2; ++_i) \
        __builtin_amdgcn_global_load_lds((const unsigned*)((const char*)(gbase) + (voff)[_i]), (PG8_LAS unsigned*)(lds + (bufoff) + ldsw + _i * 8192), 16, 0, 0); } while (0)
#define PG8_LDA(dst, b, h) do { _Pragma("unroll") for (int m = 0; m < 4; ++m) _Pragma("unroll") for (int k = 0; k < 2; ++k) dst[m][k] = *(const PG8_LAS bf16x8*)(lds + PG8_SA(b, h) + aoff + m * 2048 + k * 1024); } while (0)
#define PG8_LDB(dst, b, h) do { _Pragma("unroll") for (int n = 0; n < 2; ++n) _Pragma("unroll") for (int k = 0; k < 2; ++k) dst[n][k] = *(const PG8_LAS bf16x8*)(lds + PG8_SB(b, h) + boff + n * 2048 + k * 1024); } while (0)
#define PG8_MMA(ai, bj, At, Bt) do { __builtin_amdgcn_s_setprio(1); _Pragma("unroll") for (int m = 0; m < 4; ++m) _Pragma("unroll") for (int n = 0; n < 2; ++n) _Pragma("unroll") for (int k = 0; k < 2; ++k) \
        acc[ai][bj][m][n] = __builtin_amdgcn_mfma_f32_16x16x32_bf16(Bt[n][k], At[m][k], acc[ai][bj][m][n], 0, 0, 0); __builtin_amdgcn_s_setprio(0); } while (0)
#define PG8_WAIT_V(n) asm volatile("s_waitcnt vmcnt(" #n ")" ::: "memory")
#define PG8_WAIT_L(n) asm volatile("s_waitcnt lgkmcnt(" #n ")" ::: "memory")
#define PG8_BAR __builtin_amdgcn_s_barrier()
#define PG8_SCHED __builtin_amdgcn_sched_barrier(0)
    Unit cur, nxt; int ui = 0;
    if (!S.next(0, cur)) return;
    f32x4 acc[2][2][4][2];
#pragma unroll
    for (int a = 0; a < 2; ++a)
#pragma unroll
        for (int b = 0; b < 2; ++b)
#pragma unroll
            for (int m = 0; m < 4; ++m)
#pragma unroll
                for (int n = 0; n < 2; ++n) acc[a][b][m][n] = (f32x4){0.f, 0.f, 0.f, 0.f};
    bf16x8 At[4][2], B0[2][2], B1[2][2];
    const char* cA = (const char*)g.A + (size_t)cur.pm * tstep + (size_t)cur.kb * kstep; const char* cB = (const char*)g.Bt + (size_t)cur.pn * tstep + (size_t)cur.kb * kstep;
    S.a_ready(cur);
    if constexpr (SP2) {
        PG8_STAGE(PG8_SB(0, 0), cB, voffB); PG8_STAGE(PG8_SB(0, 1), cB + hstep, voffB); PG8_STAGE(PG8_SA(0, 0), cA, voffA); PG8_STAGE(PG8_SA(0, 1), cA + hstep, voffA);
        if (wr == 1) PG8_BAR;
        PG8_WAIT_V(2); PG8_BAR;
        PG8_STAGE(PG8_SB(1, 0), cB + kstep, voffB); PG8_STAGE(PG8_SA(1, 0), cA + kstep, voffA); PG8_STAGE(PG8_SB(1, 1), cB + hstep + kstep, voffB);
        PG8_WAIT_V(6); PG8_BAR;
    } else {
        PG8_STAGE(PG8_SB(0, 0), cB, voffB); PG8_STAGE(PG8_SA(0, 0), cA, voffA); PG8_STAGE(PG8_SB(0, 1), cB + hstep, voffB); PG8_STAGE(PG8_SA(0, 1), cA + hstep, voffA);
        if (wr == 1) PG8_BAR;
        PG8_WAIT_V(4); PG8_BAR;
        PG8_STAGE(PG8_SB(1, 0), cB + kstep, voffB); PG8_STAGE(PG8_SA(1, 0), cA + kstep, voffA); PG8_STAGE(PG8_SB(1, 1), cB + hstep + kstep, voffB);
        PG8_WAIT_V(6); PG8_BAR;
    }
    for (;;) {
        const bool has_next = S.next(ui + 1, nxt);
        const char* nA = has_next ? (const char*)g.A + (size_t)nxt.pm * tstep + (size_t)nxt.kb * kstep : cA; const char* nB = has_next ? (const char*)g.Bt + (size_t)nxt.pn * tstep + (size_t)nxt.kb * kstep : cB;
        const int nt = cur.nt;
        for (int t = 0; t < nt; t += 2) {
            const bool last = (t == nt - 2);
            const char* a1 = cA + (size_t)(t + 1) * kstep;
            const char* a2 = last ? nA : cA + (size_t)(t + 2) * kstep; const char* b2 = last ? nB : cB + (size_t)(t + 2) * kstep;
            const char* a3 = a2 + kstep; const char* b3 = b2 + kstep;
            if (last && has_next) S.a_ready(nxt);
            if constexpr (SP2) {
            PG8_LDB(B0, 0, 0); PG8_LDB(B1, 0, 1); PG8_SCHED; PG8_LDA(At, 0, 0); PG8_STAGE(PG8_SA(1, 1), a1 + hstep, voffA);
            PG8_WAIT_V(8); PG8_WAIT_L(0); PG8_BAR; PG8_MMA(0, 0, At, B0); PG8_MMA(0, 1, At, B1); PG8_BAR; PG8_SCHED;
            PG8_LDA(At, 0, 1); PG8_STAGE(PG8_SB(0, 0), b2, voffB); PG8_STAGE(PG8_SB(0, 1), b2 + hstep, voffB); PG8_STAGE(PG8_SA(0, 0), a2, voffA);
            PG8_WAIT_V(8); PG8_WAIT_L(0); PG8_BAR; PG8_MMA(1, 0, At, B0); PG8_MMA(1, 1, At, B1); PG8_BAR; PG8_SCHED;
            PG8_LDB(B0, 1, 0); PG8_LDB(B1, 1, 1); PG8_SCHED; PG8_LDA(At, 1, 0); PG8_STAGE(PG8_SA(0, 1), a2 + hstep, voffA);
            PG8_WAIT_V(8); PG8_WAIT_L(0); PG8_BAR; PG8_MMA(0, 0, At, B0); PG8_MMA(0, 1, At, B1); PG8_BAR; PG8_SCHED;
            PG8_LDA(At, 1, 1); PG8_STAGE(PG8_SB(1, 0), b3, voffB); PG8_STAGE(PG8_SB(1, 1), b3 + hstep, voffB); PG8_STAGE(PG8_SA(1, 0), a3, voffA);
            PG8_WAIT_V(8); PG8_WAIT_L(0); PG8_BAR; PG8_MMA(1, 0, At, B0); PG8_MMA(1, 1, At, B1); PG8_BAR; PG8_SCHED;
            } else {
            PG8_LDB(B0, 0, 0); PG8_SCHED; PG8_LDA(At, 0, 0); PG8_STAGE(PG8_SA(1, 1), a1 + hstep, voffA);
            PG8_WAIT_L(8); PG8_BAR; PG8_WAIT_L(0); PG8_MMA(0, 0, At, B0); PG8_BAR; PG8_SCHED;
            PG8_LDB(B1, 0, 1); PG8_STAGE(PG8_SB(0, 0), b2, voffB);
            PG8_BAR; PG8_WAIT_L(0); PG8_MMA(0, 1, At, B1); PG8_BAR;
            PG8_LDA(At, 0, 1); PG8_STAGE(PG8_SA(0, 0), a2, voffA);
            PG8_BAR; PG8_WAIT_L(0); PG8_MMA(1, 0, At, B0); PG8_BAR; PG8_SCHED;
            PG8_STAGE(PG8_SB(0, 1), b2 + hstep, voffB);
            PG8_WAIT_V(6); PG8_BAR; PG8_MMA(1, 1, At, B1); PG8_BAR;
            PG8_LDB(B0, 1, 0); PG8_SCHED; PG8_LDA(At, 1, 0); PG8_STAGE(PG8_SA(0, 1), a2 + hstep, voffA);
            PG8_WAIT_L(8); PG8_BAR; PG8_WAIT_L(0); PG8_MMA(0, 0, At, B0); PG8_BAR; PG8_SCHED;
            PG8_LDB(B1, 1, 1); PG8_STAGE(PG8_SB(1, 0), b3, voffB);
            PG8_BAR; PG8_WAIT_L(0); PG8_MMA(0, 1, At, B1); PG8_BAR;
            PG8_LDA(At, 1, 1); PG8_STAGE(PG8_SA(1, 0), a3, voffA);
            PG8_BAR; PG8_WAIT_L(0); PG8_MMA(1, 0, At, B0); PG8_BAR; PG8_SCHED;
            PG8_STAGE(PG8_SB(1, 1), b3 + hstep, voffB);
            PG8_WAIT_V(6); PG8_BAR; PG8_MMA(1, 1, At, B1); PG8_BAR;
            }
        }
        if constexpr (ALIGN_EPI) { if (wr == 0) PG8_BAR; }
        if constexpr (!Epi::AFTER_DRAIN) { E(acc, cur, wr, wc, fr, fq); S.done(cur); }
        if (!has_next) break;
#pragma unroll
        for (int a = 0; a < 2; ++a)
#pragma unroll
            for (int b = 0; b < 2; ++b)
#pragma unroll
                for (int m = 0; m < 4; ++m)
#pragma unroll
                    for (int n = 0; n < 2; ++n) acc[a][b][m][n] = (f32x4){0.f, 0.f, 0.f, 0.f};
        cur = nxt; cA = nA; cB = nB; ++ui;
        if constexpr (ALIGN_EPI) { if (wr == 1) PG8_BAR; }
    }
    PG8_WAIT_V(0);
    if constexpr (!ALIGN_EPI) { if (wr == 0) PG8_BAR; }
    PG8_BAR;
    if constexpr (Epi::AFTER_DRAIN) { E.fused(acc, cur, wr, wc, fr, fq, lds, wid, lane); S.done(cur); }
#undef PG8_SA
#undef PG8_SB
#undef PG8_STAGE
#undef PG8_LDA
#undef PG8_LDB
#undef PG8_MMA
#undef PG8_WAIT_V
#undef PG8_WAIT_L
#undef PG8_BAR
#undef PG8_SCHED
}
}
namespace att {
using bf16x8 = __attribute__((ext_vector_type(8))) short;
using s16x4  = __attribute__((ext_vector_type(4))) short;
using f32x16 = __attribute__((ext_vector_type(16))) float;
using u32x4  = __attribute__((ext_vector_type(4))) unsigned;
typedef unsigned short bf16;
#define ATT_LAS __attribute__((address_space(3)))
constexpr int NW = 8, QBLK = 32, KVBLK = 64;
constexpr int SHM_V = KVBLK * 128 * 2;
#define ATT_SBAR() __builtin_amdgcn_sched_barrier(0)
__device__ __forceinline__ int crow(int r, int hi) { return (r & 3) + 8 * (r >> 2) + 4 * hi; }
__device__ __forceinline__ unsigned cvtpk(float lo, float hi) { unsigned r; asm volatile("v_cvt_pk_bf16_f32 %0, %1, %2" : "=v"(r) : "v"(lo), "v"(hi)); return r; }
__device__ __forceinline__ void partialSM(f32x16& p0, f32x16& p1, float& m_reg, float& mn, float& alpha, float C, float thr_raw) {
  float pmax = p0[0];
#pragma unroll
  for (int r = 1; r < 16; ++r) pmax = fmaxf(pmax, p0[r]);
#pragma unroll
  for (int r = 0; r < 16; ++r) pmax = fmaxf(pmax, p1[r]);
  { auto rr = __builtin_amdgcn_permlane32_swap(__float_as_uint(pmax), __float_as_uint(pmax), false, false);
    pmax = fmaxf(__uint_as_float(rr[0]), __uint_as_float(rr[1])); }
  if (__builtin_expect(__all(pmax - m_reg <= thr_raw), 1)) { mn = m_reg; alpha = 1.f; }
  else { mn = fmaxf(m_reg, pmax); alpha = __builtin_amdgcn_exp2f((m_reg - mn) * C); m_reg = mn; }
  float mnC = -mn * C;
#pragma unroll
  for (int r = 0; r < 16; ++r) p0[r] = fmaf(p0[r], C, mnC);
#pragma unroll
  for (int r = 0; r < 16; ++r) p1[r] = fmaf(p1[r], C, mnC);
#pragma unroll
  for (int r = 0; r < 16; ++r) p0[r] = __builtin_amdgcn_exp2f(p0[r]);
}
__device__ __forceinline__ void finishSM(f32x16& p0, f32x16& p1, float alpha, float& l_reg, bf16x8& pa0, bf16x8& pa1, bf16x8& pa2, bf16x8& pa3) {
#pragma unroll
  for (int r = 0; r < 16; ++r) p1[r] = __builtin_amdgcn_exp2f(p1[r]);
  float ps = 0;
#pragma unroll
  for (int r = 0; r < 16; ++r) ps += p0[r];
#pragma unroll
  for (int r = 0; r < 16; ++r) ps += p1[r];
  { auto rr = __builtin_amdgcn_permlane32_swap(__float_as_uint(ps), __float_as_uint(ps), false, false);
    ps = __uint_as_float(rr[0]) + __uint_as_float(rr[1]); }
  l_reg = l_reg * alpha + ps;
#define ATT_PK4(P, BASE, OUT) do { unsigned a0 = cvtpk(P[BASE + 0], P[BASE + 1]), a1 = cvtpk(P[BASE + 2], P[BASE + 3]);   \
    unsigned b0 = cvtpk(P[BASE + 4], P[BASE + 5]), b1 = cvtpk(P[BASE + 6], P[BASE + 7]);                              \
    auto r0 = __builtin_amdgcn_permlane32_swap(a0, b0, false, false); auto r1 = __builtin_amdgcn_permlane32_swap(a1, b1, false, false); \
    u32x4 w = {r0[0], r1[0], r0[1], r1[1]}; OUT = __builtin_bit_cast(bf16x8, w); } while (0)
  ATT_PK4(p0, 0, pa0); ATT_PK4(p0, 8, pa1); ATT_PK4(p1, 0, pa2); ATT_PK4(p1, 8, pa3);
}
template <int NQK> __device__ __forceinline__ int kswz(int row, int colB) { return row * (32 * NQK) + (colB ^ ((row & 7) << 4)); }
template <int NQK, int NQR> __device__ __forceinline__ void qkt(f32x16& p0, f32x16& p1, ATT_LAS const char* Ks, const bf16x8* qr, ATT_LAS const char* qx, int r32, int hi) {
  p0 = f32x16{}; p1 = f32x16{};
#pragma unroll
  for (int d0 = 0; d0 < NQK; ++d0) { int cb = (d0 * 16 + hi * 8) * 2;
    bf16x8 b0 = *(ATT_LAS const bf16x8*)(Ks + kswz<NQK>(r32, cb));
    bf16x8 b1 = *(ATT_LAS const bf16x8*)(Ks + kswz<NQK>(32 + r32, cb));
    bf16x8 qv; if (d0 < NQR) qv = qr[d0 < NQR ? d0 : 0]; else qv = *(ATT_LAS const bf16x8*)(qx + (d0 - NQR) * 1024);
    p0 = __builtin_amdgcn_mfma_f32_32x32x16_bf16(b0, qv, p0, 0, 0, 0);
    p1 = __builtin_amdgcn_mfma_f32_32x32x16_bf16(b1, qv, p1, 0, 0, 0); }
}
__device__ __forceinline__ int v_st(int k, int c) { const int kk = (k & ~0xC) | ((k & 4) << 1) | ((k & 8) >> 1); return ((kk >> 3) * 4 + (c >> 5)) * 512 + ((kk & 7) * 32 + (c & 31)) * 2; }
__device__ __forceinline__ int v_rd_base(int lane) { return ((lane & 3) << 3) | (((lane >> 2) & 3) << 6) | (((lane >> 4) & 1) << 5) | (((lane >> 5) & 1) << 8); }
constexpr int v_rd_off(int d0, int ks, int half) { return d0 * 512 + ks * 4096 + half * 2048; }
template <int OFF> __device__ __forceinline__ s16x4 tr_read(int vb) {
  s16x4 r; asm volatile("ds_read_b64_tr_b16 %0, %1 offset:%2" : "=&v"(r) : "v"(vb), "i"(OFF) : "memory"); return r;
}
template <int D0> __device__ __forceinline__ void pv_one(f32x16& od, int vb, bf16x8 pa0, bf16x8 pa1, bf16x8 pa2, bf16x8 pa3) {
  const s16x4 l0 = tr_read<v_rd_off(D0, 0, 0)>(vb), h0 = tr_read<v_rd_off(D0, 0, 1)>(vb), l1 = tr_read<v_rd_off(D0, 1, 0)>(vb), h1 = tr_read<v_rd_off(D0, 1, 1)>(vb);
  const s16x4 l2 = tr_read<v_rd_off(D0, 2, 0)>(vb), h2 = tr_read<v_rd_off(D0, 2, 1)>(vb), l3 = tr_read<v_rd_off(D0, 3, 0)>(vb), h3 = tr_read<v_rd_off(D0, 3, 1)>(vb);
  asm volatile("s_waitcnt lgkmcnt(0)" ::: "memory"); ATT_SBAR();
#define ATT_PK(L, H) (bf16x8){L[0], L[1], L[2], L[3], H[0], H[1], H[2], H[3]}
  od = __builtin_amdgcn_mfma_f32_32x32x16_bf16(pa0, ATT_PK(l0, h0), od, 0, 0, 0);
  od = __builtin_amdgcn_mfma_f32_32x32x16_bf16(pa1, ATT_PK(l1, h1), od, 0, 0, 0);
  od = __builtin_amdgcn_mfma_f32_32x32x16_bf16(pa2, ATT_PK(l2, h2), od, 0, 0, 0);
  od = __builtin_amdgcn_mfma_f32_32x32x16_bf16(pa3, ATT_PK(l3, h3), od, 0, 0, 0);
}
__device__ __forceinline__ void pv_d0(f32x16* o, int vb, bf16x8 pa0, bf16x8 pa1, bf16x8 pa2, bf16x8 pa3) {
  pv_one<0>(o[0], vb, pa0, pa1, pa2, pa3); pv_one<1>(o[1], vb, pa0, pa1, pa2, pa3); pv_one<2>(o[2], vb, pa0, pa1, pa2, pa3); pv_one<3>(o[3], vb, pa0, pa1, pa2, pa3);
}
template <int NQK> constexpr int shm_k() { return KVBLK * 32 * NQK; }
template <int NQK, int NQR> constexpr int shm_attn() { return 2 * SHM_V + 2 * shm_k<NQK>() + NW * 64 * 4 + NW * (NQK - NQR) * 1024; }

template <int NQK, int NQR, int SD, int ldq, int ldka, int ldkb, int ldv, int ldo>
__device__ __forceinline__ void attn_unit(const bf16* __restrict__ Qb, const bf16* __restrict__ KA, const bf16* __restrict__ KB,
                                          const bf16* __restrict__ Vh, bf16* __restrict__ Ob, int seq, float C, float thr_raw, ATT_LAS char* lds) {
  constexpr int SHM_K = shm_k<NQK>(), KCH = (2 * NQK * 64) / 512, NLD = KCH + 2;
  const int tid = threadIdx.x, wid = tid >> 6, lane = tid & 63, r32 = lane & 31, hi = lane >> 5;
  ATT_LAS char* V_lds = lds; ATT_LAS char* K_lds = lds + 2 * SHM_V;
  ATT_LAS float* ws = (ATT_LAS float*)(lds + 2 * SHM_V + 2 * SHM_K) + wid * 64; ATT_LAS float* li_l = ws; ATT_LAS float* al_l = ws + 32;
  float m_reg = -1e30f, l_reg = 0; f32x16 o[4] = {}; bf16x8 qr[NQR];
  const bf16* Qw = Qb + (long)(wid * QBLK + r32) * ldq + hi * 8;
  ATT_LAS char* qx = lds + 2 * SHM_V + 2 * SHM_K + NW * 64 * 4 + wid * ((NQK - NQR) * 1024) + lane * 16;
#pragma unroll
  for (int d0 = 0; d0 < NQR; ++d0) qr[d0] = *(const bf16x8*)(Qw + d0 * 16);
#pragma unroll
  for (int d0 = NQR; d0 < NQK; ++d0) *(ATT_LAS bf16x8*)(qx + (d0 - NQR) * 1024) = *(const bf16x8*)(Qw + d0 * 16);
  const int sr = tid >> 4, sc = (tid & 15) * 8, vst0 = v_st(sr, sc), vst1 = v_st(32 + sr, sc);
  const int sr2 = tid >> 3, sc2 = (tid & 7) * 8;
  const int vb0 = (int)(unsigned)(size_t)V_lds + v_rd_base(lane);
  struct { bf16x8 vs0, vs1, ks[KCH]; } sr_[SD];
#define ATT_SLOAD(i, k0) do { sr_[i].vs0 = *(const bf16x8*)(&Vh[(long)((k0) + sr) * ldv + sc]); sr_[i].vs1 = *(const bf16x8*)(&Vh[(long)((k0) + 32 + sr) * ldv + sc]); \
    sr_[i].ks[0] = *(const bf16x8*)(&KA[(long)((k0) + sr) * ldka + sc]); sr_[i].ks[1] = *(const bf16x8*)(&KA[(long)((k0) + 32 + sr) * ldka + sc]); \
    if constexpr (KCH == 3) sr_[i].ks[2] = *(const bf16x8*)(&KB[(long)((k0) + sr2) * ldkb + sc2]); } while (0)
#define ATT_SWRITE(b, i) do { *(ATT_LAS bf16x8*)(V_lds + (b) * SHM_V + vst0) = sr_[i].vs0; *(ATT_LAS bf16x8*)(V_lds + (b) * SHM_V + vst1) = sr_[i].vs1; \
    *(ATT_LAS bf16x8*)(K_lds + (b) * SHM_K + kswz<NQK>(sr, sc * 2)) = sr_[i].ks[0]; *(ATT_LAS bf16x8*)(K_lds + (b) * SHM_K + kswz<NQK>(32 + sr, sc * 2)) = sr_[i].ks[1]; \
    if constexpr (KCH == 3) *(ATT_LAS bf16x8*)(K_lds + (b) * SHM_K + kswz<NQK>(sr2, 256 + sc2 * 2)) = sr_[i].ks[2]; } while (0)
#define ATT_SWAIT() do { if constexpr (SD == 2) { if constexpr (NLD == 4) asm volatile("s_waitcnt vmcnt(4)" ::: "memory"); else asm volatile("s_waitcnt vmcnt(5)" ::: "memory"); } else asm volatile("s_waitcnt vmcnt(0)" ::: "memory"); } while (0)
#define ATT_RESC(a) do { if (__any((a) < 1.f)) { if (hi == 0) al_l[r32] = (a); asm volatile("s_waitcnt lgkmcnt(0)" ::: "memory"); \
    _Pragma("unroll") for (int d = 0; d < 4; ++d) _Pragma("unroll") for (int r = 0; r < 16; ++r) o[d][r] *= al_l[crow(r, hi)]; } } while (0)
  f32x16 pA0, pA1, pB0, pB1; float mnA, mnB, alA, alB; bf16x8 pa0, pa1, pa2, pa3; const int NT = seq / KVBLK;
  constexpr int SE = 0, SO = SD - 1;
  ATT_SLOAD(SE, 0); asm volatile("s_waitcnt vmcnt(0)" ::: "memory"); ATT_SWRITE(0, SE); __syncthreads();
  qkt<NQK, NQR>(pA0, pA1, K_lds, qr, qx, r32, hi); partialSM(pA0, pA1, m_reg, mnA, alA, C, thr_raw);
  ATT_SLOAD(SO, KVBLK); if constexpr (SD == 2) { if (2 < NT) ATT_SLOAD(SE, 2 * KVBLK); }
  ATT_SWAIT(); ATT_SWRITE(1, SO); __syncthreads();
  for (int j = 1; j + 1 < NT; j += 2) {
    ATT_SBAR(); qkt<NQK, NQR>(pB0, pB1, K_lds + SHM_K, qr, qx, r32, hi);
    finishSM(pA0, pA1, alA, l_reg, pa0, pa1, pa2, pa3); ATT_SBAR();
    ATT_SLOAD(SO, (j + SD) * KVBLK); ATT_SBAR();
    pv_d0(o, vb0, pa0, pa1, pa2, pa3); partialSM(pB0, pB1, m_reg, mnB, alB, C, thr_raw);
    __syncthreads(); ATT_SWAIT(); ATT_SWRITE(0, SE);
    ATT_RESC(alB); __syncthreads();
    ATT_SBAR(); qkt<NQK, NQR>(pA0, pA1, K_lds, qr, qx, r32, hi);
    finishSM(pB0, pB1, alB, l_reg, pa0, pa1, pa2, pa3); ATT_SBAR();
    if (SD == 1 || j + 3 < NT) ATT_SLOAD(SE, (j + 1 + SD) * KVBLK); ATT_SBAR();
    pv_d0(o, vb0 + SHM_V, pa0, pa1, pa2, pa3); partialSM(pA0, pA1, m_reg, mnA, alA, C, thr_raw);
    __syncthreads(); ATT_SWAIT(); ATT_SWRITE(1, SO);
    ATT_RESC(alA); __syncthreads();
  }
  ATT_SBAR(); qkt<NQK, NQR>(pB0, pB1, K_lds + SHM_K, qr, qx, r32, hi);
  finishSM(pA0, pA1, alA, l_reg, pa0, pa1, pa2, pa3); ATT_SBAR();
  pv_d0(o, vb0, pa0, pa1, pa2, pa3); partialSM(pB0, pB1, m_reg, mnB, alB, C, thr_raw);
  __syncthreads(); ATT_RESC(alB);
  finishSM(pB0, pB1, alB, l_reg, pa0, pa1, pa2, pa3); ATT_SBAR();
  pv_d0(o, vb0 + SHM_V, pa0, pa1, pa2, pa3);
  if (hi == 0) li_l[r32] = l_reg; asm volatile("s_waitcnt lgkmcnt(0)" ::: "memory");
  float rli[16];
#pragma unroll
  for (int r = 0; r < 16; ++r) rli[r] = __builtin_amdgcn_rcpf(li_l[crow(r, hi)]);
  bf16* Ow = Ob + (long)(wid * QBLK) * ldo;
#pragma unroll
  for (int r = 0; r < 16; ++r) { const int orow = crow(r, hi);
#pragma unroll
    for (int d0 = 0; d0 < 4; ++d0) { const float v = o[d0][r] * rli[r]; const unsigned u = __float_as_uint(v); Ow[(long)orow * ldo + d0 * 32 + r32] = (bf16)((u + 0x7fffu + ((u >> 16) & 1u)) >> 16); } }
  __syncthreads();
#undef ATT_SLOAD
#undef ATT_SWRITE
#undef ATT_SWAIT
#undef ATT_RESC
}
}

namespace scan {
using bf16x8 = __attribute__((ext_vector_type(8))) short;
using s16x4  = __attribute__((ext_vector_type(4))) short;
using f32x16 = __attribute__((ext_vector_type(16))) float;
using u32x4  = __attribute__((ext_vector_type(4))) unsigned;
using u32x2  = __attribute__((ext_vector_type(2))) unsigned;
using f32x4s = __attribute__((ext_vector_type(4))) float;
typedef unsigned short bf16;
#define SC_LAS __attribute__((address_space(3)))
#define SC_GAS __attribute__((address_space(1)))
__device__ __forceinline__ unsigned off_b(unsigned row, unsigned ch) { return 256u * row + 16u * (ch ^ (((row & 3u) << 2) | ((row >> 2) & 3u))); }
__device__ __forceinline__ unsigned row_rd(unsigned lane, unsigned s) { return off_b(lane & 31u, 2u * s + (lane >> 5)); }
__device__ __forceinline__ unsigned tr_rd(unsigned lane, unsigned c, unsigned ks, unsigned t) {
    const unsigned h = lane >> 5, blk = (lane >> 4) & 1u, q = (lane & 15u) >> 2, p = lane & 3u;
    return off_b(16u * ks + 8u * h + 4u * t + q, 4u * c + 2u * blk + (p >> 1)) + 8u * (p & 1u);
}
__device__ __forceinline__ int crow(int r, int hi) { return (r & 3) + 8 * (r >> 2) + 4 * hi; }
__device__ __forceinline__ unsigned cvtpk(float lo, float hi) { unsigned r; asm volatile("v_cvt_pk_bf16_f32 %0, %1, %2" : "=v"(r) : "v"(lo), "v"(hi)); return r; }
__device__ __forceinline__ s16x4 trr(unsigned addr) { s16x4 r; asm volatile("ds_read_b64_tr_b16 %0, %1" : "=v"(r) : "v"(addr) : "memory"); return r; }
#define SC_PK(L, H) (bf16x8){L[0], L[1], L[2], L[3], H[0], H[1], H[2], H[3]}
#define SC_PK4(P, BASE, OUT) do { unsigned a0 = cvtpk(P[BASE + 0], P[BASE + 1]), a1 = cvtpk(P[BASE + 2], P[BASE + 3]);   \
    unsigned b0 = cvtpk(P[BASE + 4], P[BASE + 5]), b1 = cvtpk(P[BASE + 6], P[BASE + 7]);                              \
    auto r0 = __builtin_amdgcn_permlane32_swap(a0, b0, false, false); auto r1 = __builtin_amdgcn_permlane32_swap(a1, b1, false, false); \
    u32x4 w = {r0[0], r1[0], r0[1], r1[1]}; OUT = __builtin_bit_cast(bf16x8, w); } while (0)
#define SC_MFMA(a, b, c) __builtin_amdgcn_mfma_f32_32x32x16_bf16((a), (b), (c), 0, 0, 0)

constexpr int KOFF = 0, VOFF = 32768, QOFF = 49152, TOFF = 81920, LDS_NEED = 147456;

__device__ __forceinline__ void ret_scan_mfma(const bf16* __restrict__ P, bf16* __restrict__ SO, const float* lgf, const float* lgb, SC_LAS unsigned char* lds, int tid) {
    constexpr int LDP = 12288, SR = 4352, MR = 17408;
    const unsigned lane = tid & 63; const int wave = __builtin_amdgcn_readfirstlane(tid >> 6), cb = wave >> 2, dvb = wave & 3, hi = lane >> 5, r32 = lane & 31;
    const unsigned ldsb = (unsigned)(size_t)lds;
    const unsigned rb_i = 256u * r32, m4_i = ((((unsigned)r32 & 3u) << 2) | (((unsigned)r32 >> 2) & 3u)) << 4, xk_i = m4_i ^ ((unsigned)hi << 4);
    const unsigned vtr0_i = ldsb + VOFF + tr_rd(lane, dvb, 0, 0), vtr1_i = ldsb + VOFF + tr_rd(lane, dvb, 0, 1);
    const unsigned ktb0_i = ldsb + KOFF + cb * 8192 + tr_rd(lane, 0, 0, 0), ktb1_i = ldsb + KOFF + cb * 8192 + tr_rd(lane, 0, 0, 1), q6_i = ((lane & 15u) >> 2) << 6;
    const int kr0 = tid >> 5, kc = tid & 31, vr0 = tid >> 4, vc = tid & 15;
    const unsigned kst0 = (kc >> 4) * 8192 + off_b(kr0, kc & 15), vst0 = off_b(vr0, vc);
    const unsigned kgo = (unsigned)(kr0 * LDP + kc * 8) * 2u, vgo = (unsigned)(vr0 * LDP + vc * 8) * 2u;
    for (int u = blockIdx.x; u < 256; u += gridDim.x) {
        const int b = u >> 6, h = (u >> 3) & 7, dir = (u >> 2) & 1, vs = u & 3;
        const float lg2 = (dir ? lgb : lgf)[h] * 1.4426950408889634f;
        const float g64 = __builtin_amdgcn_exp2f(64.0f * lg2);
        const float vsc0 = __builtin_amdgcn_exp2f((float)(dir ? vr0 : 63 - vr0) * lg2), vsc1 = __builtin_amdgcn_exp2f((float)(dir ? vr0 + 32 : 31 - vr0) * lg2);
        const int crow_i = cb * 32 + r32;
        const float osc = __builtin_amdgcn_exp2f((float)(dir ? -crow_i : crow_i - 63) * lg2);
        const SC_GAS char* Pq = (const SC_GAS char*)(P + (size_t)b * SR * LDP + h * 256);
        const SC_GAS char* Pv = (const SC_GAS char*)(P + (size_t)b * SR * LDP + 4096 + h * 512 + vs * 128);
        bf16* Ob = SO + ((size_t)dir * MR + (size_t)b * SR) * 4096 + h * 512 + vs * 128;
        f32x16 S[4];
#pragma unroll
        for (int j = 0; j < 4; ++j) S[j] = f32x16{};
        u32x4 kq[4], qq[4], vq[2];
#define chunk_base(n) (dir ? ((n) < 4 ? 256 - 64 * ((n) + 1) : SR - 64 * ((n) - 3)) : 64 * (n))
#define SC_GLOAD(n) do { const size_t cbo = (size_t)chunk_base(n) * (LDP * 2); \
        _Pragma("unroll") for (int j = 0; j < 4; ++j) { const SC_GAS char* pj = Pq + cbo + (size_t)j * (16 * LDP * 2); qq[j] = *(const SC_GAS u32x4*)(pj + kgo); kq[j] = *(const SC_GAS u32x4*)(pj + 4096 + kgo); } \
        _Pragma("unroll") for (int j = 0; j < 2; ++j) { const SC_GAS char* pj = Pv + cbo + (size_t)j * (32 * LDP * 2); vq[j] = *(const SC_GAS u32x4*)(pj + vgo); } } while (0)
        SC_GLOAD(0);
        for (int n = 0; n < 68; ++n) {
            unsigned rb = rb_i, m4 = m4_i, xk = xk_i, q6 = q6_i;
            asm volatile("" : "+v"(rb), "+v"(m4), "+v"(xk), "+v"(q6));
            __syncthreads();
#pragma unroll
            for (int j = 0; j < 4; ++j) {
#pragma unroll
                for (int r = 0; r < 16; ++r) S[j][r] *= g64;
#pragma unroll
                for (int g = 0; g < 4; ++g) { u32x2 w; w.x = cvtpk(S[j][4 * g], S[j][4 * g + 1]); w.y = cvtpk(S[j][4 * g + 2], S[j][4 * g + 3]);
                    *(SC_LAS u32x2*)(lds + TOFF + (dvb * 2 + cb) * 8192 + rb + (((unsigned)(4 * j + g) << 4) ^ m4) + 8 * hi) = w; }
            }
#pragma unroll
            for (int j = 0; j < 4; ++j) { *(SC_LAS u32x4*)(lds + KOFF + kst0 + (j & 1) * 4096 + (j >> 1) * 16384) = kq[j]; *(SC_LAS u32x4*)(lds + QOFF + kst0 + (j & 1) * 4096 + (j >> 1) * 16384) = qq[j]; }
#pragma unroll
            for (int j = 0; j < 2; ++j) { const u32x4 w = vq[j]; const float sc = j ? vsc1 : vsc0; u32x4 o;
                o.x = cvtpk(__uint_as_float(w.x << 16) * sc, __uint_as_float(w.x & 0xffff0000u) * sc); o.y = cvtpk(__uint_as_float(w.y << 16) * sc, __uint_as_float(w.y & 0xffff0000u) * sc);
                o.z = cvtpk(__uint_as_float(w.z << 16) * sc, __uint_as_float(w.z & 0xffff0000u) * sc); o.w = cvtpk(__uint_as_float(w.w << 16) * sc, __uint_as_float(w.w & 0xffff0000u) * sc);
                *(SC_LAS u32x4*)(lds + VOFF + vst0 + j * 8192) = o; }
            __syncthreads();
            if (n + 1 < 68) SC_GLOAD(n + 1);
            const bool need1 = dir ? true : (cb == 1);
            const bool use0 = dir ? (cb == 0) : true;
            f32x16 p0 = f32x16{}, p1 = f32x16{}, oT = f32x16{};
#pragma unroll 1
            for (int cq = 0; cq < 2; ++cq) {
                const unsigned sub = cq * 8192;
#pragma unroll
                for (int s8 = 0; s8 < 8; ++s8) {
                    const unsigned ra = rb + ((32u * s8) ^ xk) + sub;
                    const bf16x8 qf = *(const SC_LAS bf16x8*)(lds + ra + QOFF + cb * 16384);
                    const bf16x8 tf = *(const SC_LAS bf16x8*)(lds + ra + TOFF + dvb * 16384);
                    oT = SC_MFMA(tf, qf, oT);
                    if (use0) { const bf16x8 k0 = *(const SC_LAS bf16x8*)(lds + ra + KOFF + 0 * 16384); p0 = SC_MFMA(k0, qf, p0); }
                    if (need1) { const bf16x8 k1 = *(const SC_LAS bf16x8*)(lds + ra + KOFF + 1 * 16384); p1 = SC_MFMA(k1, qf, p1); }
                }
            }
#pragma unroll
            for (int r = 0; r < 16; ++r) { const int sr = crow(r, hi); const bool keep = dir ? (sr >= r32) : (sr <= r32);
                if (cb == 0) p0[r] = keep ? p0[r] : 0.f; else p1[r] = keep ? p1[r] : 0.f; }
            bf16x8 pa0, pa1, pa2, pa3; SC_PK4(p0, 0, pa0); SC_PK4(p0, 8, pa1); SC_PK4(p1, 0, pa2); SC_PK4(p1, 8, pa3);
            bf16x8 vf[4];
            { s16x4 l[4], hh[4];
#pragma unroll
              for (int kp = 0; kp < 4; ++kp) { l[kp] = trr(vtr0_i + (kp >> 1) * 8192 + (kp & 1) * 4096); hh[kp] = trr(vtr1_i + (kp >> 1) * 8192 + (kp & 1) * 4096); }
              asm volatile("s_waitcnt lgkmcnt(0)" : "+v"(l[0]), "+v"(l[1]), "+v"(l[2]), "+v"(l[3]), "+v"(hh[0]), "+v"(hh[1]), "+v"(hh[2]), "+v"(hh[3]) :: "memory");
#pragma unroll
              for (int kp = 0; kp < 4; ++kp) vf[kp] = SC_PK(l[kp], hh[kp]); }
            if (use0) { oT = SC_MFMA(vf[0], pa0, oT); oT = SC_MFMA(vf[1], pa1, oT); }
            if (need1) { oT = SC_MFMA(vf[2], pa2, oT); oT = SC_MFMA(vf[3], pa3, oT); }
            { bf16* op = Ob + (size_t)(chunk_base(n) + crow_i) * 4096 + dvb * 32 + 4 * hi;
#pragma unroll
              for (int g = 0; g < 4; ++g) { u32x2 w; w.x = cvtpk(oT[4 * g] * osc, oT[4 * g + 1] * osc); w.y = cvtpk(oT[4 * g + 2] * osc, oT[4 * g + 3] * osc); *(SC_GAS u32x2*)(op + 8 * g) = w; } }
#pragma unroll
            for (int c = 0; c < 4; ++c) {
                const unsigned cx = (((unsigned)c << 6) ^ q6) - q6;
                s16x4 l[4], hh[4];
#pragma unroll
                for (int kp = 0; kp < 4; ++kp) { l[kp] = trr(ktb0_i + cx + (kp >> 1) * 16384 + (kp & 1) * 4096); hh[kp] = trr(ktb1_i + cx + (kp >> 1) * 16384 + (kp & 1) * 4096); }
                asm volatile("s_waitcnt lgkmcnt(0)" : "+v"(l[0]), "+v"(l[1]), "+v"(l[2]), "+v"(l[3]), "+v"(hh[0]), "+v"(hh[1]), "+v"(hh[2]), "+v"(hh[3]) :: "memory");
#pragma unroll
                for (int kp = 0; kp < 4; ++kp) S[c] = SC_MFMA(SC_PK(l[kp], hh[kp]), vf[kp], S[c]);
            }
        }
#undef SC_GLOAD
#undef chunk_base
        __syncthreads();
    }
}
constexpr int HK = 0, HV = 16384, HQ = 32768, HT = 49152, HTOT = 81920, HE = 86016;
__device__ __forceinline__ void hg_scan_mfma(const bf16* __restrict__ P, bf16* __restrict__ SO, SC_LAS unsigned char* lds, int tid) {
    constexpr int LDP = 10240, SR = 4352, MR = 17408;
    const unsigned lane = tid & 63; const int wave = __builtin_amdgcn_readfirstlane(tid >> 6), cb = wave >> 2, dvb = wave & 3, hi = lane >> 5, r32 = lane & 31;
    const unsigned ldsb = (unsigned)(size_t)lds;
    const unsigned rb_i = 256u * r32, m4_i = ((((unsigned)r32 & 3u) << 2) | (((unsigned)r32 >> 2) & 3u)) << 4, xk_i = m4_i ^ ((unsigned)hi << 4);
    const unsigned vtr0_i = ldsb + HV + tr_rd(lane, dvb, 0, 0), vtr1_i = ldsb + HV + tr_rd(lane, dvb, 0, 1);
    const unsigned ktb0_i = ldsb + HK + tr_rd(lane, 0, 0, 0), ktb1_i = ldsb + HK + tr_rd(lane, 0, 0, 1), q6_i = ((lane & 15u) >> 2) << 6;
    const int ch = tid & 127, rq = __builtin_amdgcn_readfirstlane(tid >> 7);
    const int vr0 = tid >> 4, vc = tid & 15;
    const unsigned vst0 = off_b(vr0, vc), vgo = (unsigned)(vr0 * LDP + vc * 8) * 2u;
    SC_LAS float* tot = (SC_LAS float*)(lds + HTOT); SC_LAS float* etab = (SC_LAS float*)(lds + HE);
    for (int u = blockIdx.x; u < 128; u += gridDim.x) {
        const int b = u >> 5, h = (u >> 1) & 15, dir = u & 1;
        const bf16* Pq = P + (size_t)b * SR * LDP + h * 128 + ch;
        const int kko = dir ? 4096 : 2048;
        const SC_GAS char* Pv = (const SC_GAS char*)(P + (size_t)b * SR * LDP + 6144 + h * 128);
        bf16* Ob = SO + ((size_t)dir * MR + (size_t)b * SR) * 2048 + h * 128;
        const int crow_i = cb * 32 + r32;
        f32x16 S[2];
#pragma unroll
        for (int j = 0; j < 2; ++j) S[j] = f32x16{};
        unsigned short qr[16], kr[16]; u32x4 vq[2];
#define chunk_base(n) (dir ? ((n) < 4 ? 256 - 64 * ((n) + 1) : SR - 64 * ((n) - 3)) : 64 * (n))
#define HG_GLOAD(n) do { const bf16* pc = Pq + (size_t)(chunk_base(n) + 16 * rq) * LDP; \
        _Pragma("unroll") for (int j = 0; j < 16; ++j) { qr[j] = pc[(size_t)j * LDP]; kr[j] = pc[(size_t)j * LDP + kko]; } \
        const size_t cbo = (size_t)chunk_base(n) * (LDP * 2); \
        _Pragma("unroll") for (int j = 0; j < 2; ++j) vq[j] = *(const SC_GAS u32x4*)(Pv + cbo + (size_t)j * (32 * LDP * 2) + vgo); } while (0)
        HG_GLOAD(0);
        for (int n = 0; n < 68; ++n) {
            unsigned rb = rb_i, m4 = m4_i, xk = xk_i, q6 = q6_i;
            asm volatile("" : "+v"(rb), "+v"(m4), "+v"(xk), "+v"(q6));
            float kk[16]; float tp = 1.0f;
#pragma unroll
            for (int j = 0; j < 16; ++j) { kk[j] = __uint_as_float((unsigned)kr[j] << 16); tp *= (1.0f - kk[j]); }
            tot[((n & 1) * 4 + rq) * 128 + ch] = tp;
            __syncthreads();
#pragma unroll
            for (int j = 0; j < 2; ++j)
#pragma unroll
                for (int g = 0; g < 4; ++g) { u32x2 w; w.x = cvtpk(S[j][4 * g], S[j][4 * g + 1]); w.y = cvtpk(S[j][4 * g + 2], S[j][4 * g + 3]);
                    *(SC_LAS u32x2*)(lds + HT + dvb * 8192 + rb + (((unsigned)(8 * cb + 4 * j + g) << 4) ^ m4) + 8 * hi) = w; }
            { const float t0 = tot[((n & 1) * 4 + 0) * 128 + ch], t1 = tot[((n & 1) * 4 + 1) * 128 + ch], t2 = tot[((n & 1) * 4 + 2) * 128 + ch], t3 = tot[((n & 1) * 4 + 3) * 128 + ch];
              float run = dir ? (rq == 3 ? 1.0f : rq == 2 ? t3 : rq == 1 ? t3 * t2 : (t3 * t2) * t1) : (rq == 0 ? 1.0f : rq == 1 ? t0 : rq == 2 ? t0 * t1 : (t0 * t1) * t2);
              if (rq == 0) etab[ch] = (t0 * t1) * (t2 * t3);
#define HG_ELEM(j) do { run *= (1.0f - kk[j]); \
                  const float qi = __uint_as_float((unsigned)qr[j] << 16) * run, ki = kk[j] * __builtin_amdgcn_rcpf(run); \
                  const unsigned row = (16 * (rq & 1) + (j)), mrow = (((row & 3u) << 2) | ((row >> 2) & 3u)); \
                  const unsigned off = (rq >> 1) * 8192 + 256u * row + ((((unsigned)ch >> 3) ^ mrow) << 4) + ((unsigned)ch & 7u) * 2u; \
                  const unsigned qb = __float_as_uint(qi), kb = __float_as_uint(ki); \
                  *(SC_LAS unsigned short*)(lds + HQ + off) = (unsigned short)((qb + 0x7fffu + ((qb >> 16) & 1u)) >> 16); \
                  *(SC_LAS unsigned short*)(lds + HK + off) = (unsigned short)((kb + 0x7fffu + ((kb >> 16) & 1u)) >> 16); } while (0)
              if (dir) {
#pragma unroll
                  for (int jj = 0; jj < 16; ++jj) HG_ELEM(15 - jj);
              } else {
#pragma unroll
                  for (int jj = 0; jj < 16; ++jj) HG_ELEM(jj);
              } }
#undef HG_ELEM
#pragma unroll
            for (int j = 0; j < 2; ++j) *(SC_LAS u32x4*)(lds + HV + vst0 + j * 8192) = vq[j];
            __syncthreads();
            if (n + 1 < 68) HG_GLOAD(n + 1);
            const bool need1 = dir ? true : (cb == 1);
            const bool use0 = dir ? (cb == 0) : true;
            f32x16 p0 = f32x16{}, p1 = f32x16{}, oT = f32x16{};
#pragma unroll
            for (int s8 = 0; s8 < 8; ++s8) {
                const unsigned ra = rb + ((32u * s8) ^ xk);
                const bf16x8 qf = *(const SC_LAS bf16x8*)(lds + ra + HQ + cb * 8192);
                const bf16x8 tf = *(const SC_LAS bf16x8*)(lds + ra + HT + dvb * 8192);
                oT = SC_MFMA(tf, qf, oT);
                if (use0) { const bf16x8 k0 = *(const SC_LAS bf16x8*)(lds + ra + HK); p0 = SC_MFMA(k0, qf, p0); }
                if (need1) { const bf16x8 k1 = *(const SC_LAS bf16x8*)(lds + ra + HK + 8192); p1 = SC_MFMA(k1, qf, p1); }
            }
#pragma unroll
            for (int r = 0; r < 16; ++r) { const int sr = crow(r, hi); const bool keep = dir ? (sr >= r32) : (sr <= r32);
                if (cb == 0) p0[r] = keep ? p0[r] : 0.f; else p1[r] = keep ? p1[r] : 0.f; }
            bf16x8 pa0, pa1, pa2, pa3; SC_PK4(p0, 0, pa0); SC_PK4(p0, 8, pa1); SC_PK4(p1, 0, pa2); SC_PK4(p1, 8, pa3);
            bf16x8 vf[4];
            { s16x4 l[4], hh[4];
#pragma unroll
              for (int kp = 0; kp < 4; ++kp) { l[kp] = trr(vtr0_i + (kp >> 1) * 8192 + (kp & 1) * 4096); hh[kp] = trr(vtr1_i + (kp >> 1) * 8192 + (kp & 1) * 4096); }
              asm volatile("s_waitcnt lgkmcnt(0)" : "+v"(l[0]), "+v"(l[1]), "+v"(l[2]), "+v"(l[3]), "+v"(hh[0]), "+v"(hh[1]), "+v"(hh[2]), "+v"(hh[3]) :: "memory");
#pragma unroll
              for (int kp = 0; kp < 4; ++kp) vf[kp] = SC_PK(l[kp], hh[kp]); }
            if (use0) { oT = SC_MFMA(vf[0], pa0, oT); oT = SC_MFMA(vf[1], pa1, oT); }
            if (need1) { oT = SC_MFMA(vf[2], pa2, oT); oT = SC_MFMA(vf[3], pa3, oT); }
            { bf16* op = Ob + (size_t)(chunk_base(n) + crow_i) * 2048 + dvb * 32 + 4 * hi;
#pragma unroll
              for (int g = 0; g < 4; ++g) { u32x2 w; w.x = cvtpk(oT[4 * g], oT[4 * g + 1]); w.y = cvtpk(oT[4 * g + 2], oT[4 * g + 3]); *(SC_GAS u32x2*)(op + 8 * g) = w; } }
#pragma unroll
            for (int j = 0; j < 2; ++j) {
                const unsigned cx = (((unsigned)(2 * cb + j) << 6) ^ q6) - q6;
                s16x4 l[4], hh[4];
#pragma unroll
                for (int kp = 0; kp < 4; ++kp) { l[kp] = trr(ktb0_i + cx + (kp >> 1) * 8192 + (kp & 1) * 4096); hh[kp] = trr(ktb1_i + cx + (kp >> 1) * 8192 + (kp & 1) * 4096); }
                asm volatile("s_waitcnt lgkmcnt(0)" : "+v"(l[0]), "+v"(l[1]), "+v"(l[2]), "+v"(l[3]), "+v"(hh[0]), "+v"(hh[1]), "+v"(hh[2]), "+v"(hh[3]) :: "memory");
#pragma unroll
                for (int kp = 0; kp < 4; ++kp) S[j] = SC_MFMA(SC_PK(l[kp], hh[kp]), vf[kp], S[j]);
#pragma unroll
                for (int g = 0; g < 4; ++g) { const f32x4s e4 = *(const SC_LAS f32x4s*)(etab + 32 * (2 * cb + j) + 8 * g + 4 * hi);
                    S[j][4 * g] *= e4[0]; S[j][4 * g + 1] *= e4[1]; S[j][4 * g + 2] *= e4[2]; S[j][4 * g + 3] *= e4[3]; }
            }
        }
#undef HG_GLOAD
#undef chunk_base
        __syncthreads();
    }
}
}

#define GAS __attribute__((address_space(1)))
#define LAS __attribute__((address_space(3)))
typedef unsigned short bf16;
typedef unsigned v4u __attribute__((ext_vector_type(4)));
typedef float f32x4 __attribute__((ext_vector_type(4)));
typedef short bf16x8 __attribute__((ext_vector_type(8)));
typedef GAS unsigned gu32;
typedef GAS unsigned long long gu64;
#define RLX_AGENT __ATOMIC_RELAXED, __HIP_MEMORY_SCOPE_AGENT
#define LDS_WAIT() asm volatile("s_waitcnt lgkmcnt(0)" ::: "memory")
#define VM_WAIT() asm volatile("s_waitcnt vmcnt(0)" ::: "memory")
__device__ __forceinline__ unsigned long long rt() { return __builtin_amdgcn_s_memrealtime(); }
__device__ __forceinline__ unsigned f2bf(float f) { unsigned u = __builtin_bit_cast(unsigned, f); return (u + 0x7fffu + ((u >> 16) & 1u)) >> 16; }
__device__ __forceinline__ unsigned pk2(float lo, float hi) { return f2bf(lo) | (f2bf(hi) << 16); }

#define XB_TMO      128
#define XB_XCNT(j)  (256  + 64 * (j))
#define XB_XSUB(j)  (1280 + 64 * (j))
#define XB_XGEN(j)  (2304 + 64 * (j))
#define XB_TOP      3328
#define XB_TOPGEN   3392
#define XCD_BAR_WORDS 3456
#define XB_SPIN_CAP (1u << 18)

__device__ __forceinline__ unsigned xb_ld(unsigned* p)              { return __hip_atomic_load(p, __ATOMIC_RELAXED, __HIP_MEMORY_SCOPE_AGENT); }
__device__ __forceinline__ unsigned xb_add(unsigned* p, unsigned v) { return __hip_atomic_fetch_add(p, v, __ATOMIC_RELAXED, __HIP_MEMORY_SCOPE_AGENT); }
__device__ __forceinline__ unsigned xb_xcc_id() { return (unsigned)__builtin_amdgcn_s_getreg((3 << 11) | 20) & 0xFu; }
#define XB_SPIN(cond, bar) do { unsigned _sp = 0; while (cond) { __builtin_amdgcn_s_sleep(1); \
    if ((++_sp & 255u) == 0u) { if (xb_ld(&(bar)[XB_TMO])) break; if (_sp > XB_SPIN_CAP) { atomicAdd(&(bar)[XB_TMO], 1u); break; } } } } while (0)

struct XcdBarrier {
    unsigned* bar; unsigned x;
    volatile LAS unsigned* st;
};

__device__ __forceinline__ XcdBarrier xcd_barrier_post(unsigned* bar, volatile LAS unsigned* st) {
    XcdBarrier b; b.bar = bar; b.x = xb_xcc_id(); b.st = st;
    if (threadIdx.x == 0) (void)xb_add(&bar[XB_XCNT(b.x)], 1u);
    return b;
}
__device__ __forceinline__ void xcd_barrier_complete(unsigned* bar, unsigned x, unsigned& nloc, unsigned& nx) {
    const unsigned G = gridDim.x * gridDim.y * gridDim.z;
    unsigned sum, cnt, mine, sp = 0u;
    for (;;) {
        sum = 0u; cnt = 0u; mine = 0u;
#pragma unroll
        for (unsigned j = 0; j < 16; ++j) { const unsigned c = xb_ld(&bar[XB_XCNT(j)]); sum += c; cnt += (c > 0u) ? 1u : 0u; mine = (j == x) ? c : mine; }
        if (sum == G) break;
        __builtin_amdgcn_s_sleep(1);
        if ((++sp & 255u) == 0u) { if (xb_ld(&bar[XB_TMO])) break; if (sp > XB_SPIN_CAP) { atomicAdd(&bar[XB_TMO], 1u); break; } }
    }
    nloc = mine > 0u ? mine : 1u; nx = cnt > 0u ? cnt : 1u;
}

__device__ __forceinline__ void xcd_barrier(const XcdBarrier& b) {
    asm volatile("s_waitcnt vmcnt(0)" ::: "memory");
    __syncthreads();
    if (threadIdx.x == 0) {
        unsigned* bar = b.bar;
        __builtin_amdgcn_s_waitcnt(0);
        unsigned nloc = b.st[0], nx = b.st[1];
        if (nloc == 0u) { xcd_barrier_complete(bar, b.x, nloc, nx); b.st[0] = nloc; b.st[1] = nx; }
        const unsigned old = xb_add(&bar[XB_XSUB(b.x)], 1u);
        const unsigned gen = old / nloc;
        if (old + 1u == (gen + 1u) * nloc) {
            __builtin_amdgcn_fence(__ATOMIC_RELEASE, "agent");
            asm volatile("s_waitcnt vmcnt(0)" ::: "memory");
            const unsigned og = xb_add(&bar[XB_TOP], 1u);
            const unsigned tg = og / nx;
            if (og + 1u == (tg + 1u) * nx) xb_add(&bar[XB_TOPGEN], 1u);
            else XB_SPIN(xb_ld(&bar[XB_TOPGEN]) == tg, bar);
            __builtin_amdgcn_fence(__ATOMIC_ACQUIRE, "agent");
            xb_add(&bar[XB_XGEN(b.x)], 1u);
            asm volatile("s_waitcnt vmcnt(0)" ::: "memory");
        } else {
            XB_SPIN(xb_ld(&bar[XB_XGEN(b.x)]) == gen, bar);
            __builtin_amdgcn_fence(__ATOMIC_ACQUIRE, "agent");
            asm volatile("s_waitcnt vmcnt(0)" ::: "memory");
        }
    }
    __syncthreads();
}
constexpr int DM = 2048, NBATCH = 4, SEQ = 4096, CTXL = 256, SROWS = SEQ + CTXL, MROWS = NBATCH * SROWS;
constexpr int FFH = 5632;
constexpr int RET_N = 12288, GQA_N = 3072, MLA_NP = 1280, MLA_NACT = 1088, MLA_QN = 3072, MLA_KVN = 4096, HG_N = 10240;
constexpr float LN_EPS = 1e-6f, DN_ALPHA = 1.681792830507429f;
constexpr int NWAVES = 8;
constexpr size_t MiB = 1u << 20;
constexpr size_t WS_CTL = 0, CTL_ZERO_BYTES = 1 * MiB;
constexpr size_t WS_MODS = 1 * MiB, WS_TAB = 2 * MiB;
constexpr size_t WS_W_RET_IN = 4 * MiB, WS_W_RET_OUT = 52 * MiB, WS_W_GQA_IN = 68 * MiB, WS_W_GQA_OUT = 80 * MiB, WS_W_MLA_IN = 88 * MiB, WS_W_MLA_QUP = 93 * MiB, WS_W_MLA_KVUP = 96 * MiB,
                 WS_W_MLA_OUT = 100 * MiB, WS_W_HG_IN = 108 * MiB, WS_W_HG_OUT = 148 * MiB, WS_W_FFN_IN = 156 * MiB, WS_W_FFN_OUT = 332 * MiB;
constexpr size_t FFN_IN_BYTES = 44 * MiB, FFN_OUT_BYTES = 22 * MiB;
constexpr size_t WS_X = 420 * MiB, WS_R1 = 556 * MiB, WS_PROJ = 692 * MiB, WS_SCY = 1100 * MiB, WS_YS = 1372 * MiB, WS_END = 1436 * MiB;
constexpr size_t PJ_MLA_Q = 0, PJ_MLA_KV = 102 * MiB, PJ_MLA_C = 238 * MiB, PJ_MLA_CQN = 281 * MiB, PJ_MLA_CKVN = 298 * MiB, PJ_MLA_KR = 315 * MiB;
constexpr int CW_BAR = 4096;
constexpr int TAB_R = 0, TAB_G = 64 * 64 * 2, TAB_M = TAB_G + 64 * 32 * 2, TAB_LB = TAB_M + 64 * 16 * 2;
constexpr int LDS_BYTES = 150528, MISC_OFF = LDS_BYTES - 512;

typedef __attribute__((ext_vector_type(4))) unsigned short bf16x4v;
typedef __attribute__((ext_vector_type(2))) unsigned u32x2v;
typedef __attribute__((ext_vector_type(2))) float f32x2v;

__device__ __forceinline__ float bf2f(unsigned short b) { return __uint_as_float(((unsigned)b) << 16); }
__device__ __forceinline__ float bflo(unsigned w) { return __uint_as_float(w << 16); }
__device__ __forceinline__ float bfhi(unsigned w) { return __uint_as_float(w & 0xffff0000u); }
__device__ __forceinline__ float wave_sum(float v) {
#pragma unroll
    for (int o = 1; o < 64; o <<= 1) v += __shfl_xor(v, o);
    return v;
}
__device__ __forceinline__ float silu_f(float x) { return x / (1.0f + __expf(-x)); }
__device__ __forceinline__ float sigmoid_f(float x) { return 1.0f / (1.0f + __expf(-x)); }
__device__ __forceinline__ void unpack8(const v4u w, float* f) { f[0] = bflo(w.x); f[1] = bfhi(w.x); f[2] = bflo(w.y); f[3] = bfhi(w.y); f[4] = bflo(w.z); f[5] = bfhi(w.z); f[6] = bflo(w.w); f[7] = bfhi(w.w); }
__device__ __forceinline__ v4u pack8(const float* f) { v4u w; w.x = pk2(f[0], f[1]); w.y = pk2(f[2], f[3]); w.z = pk2(f[4], f[5]); w.w = pk2(f[6], f[7]); return w; }

struct Args {
    const float *x, *c, *ctx, *c_ctx, *ada_w, *ada_b, *ln_g, *ln_b, *ffn_w_in, *ffn_w_out;
    const float *ret_w_in, *ret_df, *ret_db, *ret_w_out;
    const float *gqa_w_in, *gqa_qn, *gqa_kn, *gqa_w_out;
    const float *mla_w_in, *mla_qn, *mla_w_qup, *mla_kvn, *mla_w_kvup, *mla_w_out;
    const float *hg_w_in, *hg_lb_raw, *hg_on, *hg_w_out;
    float* out; unsigned char* ws; int ph_lo, ph_hi, use_bar, pad;
};

__device__ __forceinline__ void transpose_item(const float* W, int K, int Nact, bf16* WT, int k0, int n0, int act_n0, LAS float* scr, int lane) {
    if (act_n0 >= 0) {
#pragma unroll 8
        for (int i = 0; i < 32; ++i) { const int kk = 2 * i + (lane >> 5); scr[kk * 33 + (lane & 31)] = W[(size_t)(k0 + kk) * Nact + act_n0 + (lane & 31)]; }
    } else {
#pragma unroll 8
        for (int i = 0; i < 32; ++i) { const int kk = 2 * i + (lane >> 5); scr[kk * 33 + (lane & 31)] = 0.f; }
    }
    LDS_WAIT(); asm volatile("" ::: "memory");
    const int c = lane & 7;
#pragma unroll
    for (int j = 0; j < 4; ++j) { const int n = (lane >> 3) + 8 * j; const LAS float* s = scr + (8 * c) * 33 + n;
        v4u o; o.x = pk2(s[0 * 33], s[1 * 33]); o.y = pk2(s[2 * 33], s[3 * 33]); o.z = pk2(s[4 * 33], s[5 * 33]); o.w = pk2(s[6 * 33], s[7 * 33]);
        *(GAS v4u*)(WT + (size_t)(n0 + n) * K + k0 + 8 * c) = o; }
    LDS_WAIT(); asm volatile("" ::: "memory");
}
template <int PERMK> __device__ __forceinline__ void transpose_w(const float* W, int K, int Nact, int Nv, bf16* WT, int item, LAS float* scr, int lane) {
    const int nblk = Nv / 32, kb = item / nblk, nb = item % nblk, n0 = 32 * nb;
    int act = n0;
    if (PERMK == 1) { const int pn = n0 >> 8, rem = n0 & 255; act = (rem >> 7) * FFH + 128 * pn + (rem & 127); }
    if (PERMK == 2) { if (n0 >= Nact) act = -1; }
    transpose_item(W, K, Nact, WT, 64 * kb, n0, act, scr, lane);
}

struct RowInfo { int b, s, ctx, mi, gr, gc; };
__device__ __forceinline__ RowInfo row_info(int r) { RowInfo q; q.b = r / SROWS; q.s = r - q.b * SROWS; q.ctx = q.s < CTXL; q.mi = q.ctx ? 4 : q.b; const int t = q.s - CTXL; q.gr = t >> 6; q.gc = t & 63; return q; }

__device__ __forceinline__ void mods_unit(const Args& a, int l, int cg, LAS float* red, int tid, int lane, int wave) {
    float sreg[5][4];
#pragma unroll
    for (int j = 0; j < 5; ++j)
#pragma unroll
        for (int i = 0; i < 4; ++i) { const int k = 256 * wave + 64 * i + lane; const float cv = (j < 4) ? a.c[j * DM + k] : a.c_ctx[k]; sreg[j][i] = silu_f(cv); }
    f32x4 acc[5];
#pragma unroll
    for (int j = 0; j < 5; ++j) acc[j] = (f32x4){0.f, 0.f, 0.f, 0.f};
    const float* wp = a.ada_w + ((size_t)l * DM + 256 * wave) * 12288 + cg * 256 + 4 * lane;
#pragma unroll
    for (int i = 0; i < 4; ++i) {
#pragma unroll 8
        for (int kk = 0; kk < 64; ++kk) {
            const f32x4 w4 = *(const GAS f32x4*)(wp + (size_t)(64 * i + kk) * 12288);
#pragma unroll
            for (int j = 0; j < 5; ++j) { const float sj = __uint_as_float(__builtin_amdgcn_readlane(__float_as_uint(sreg[j][i]), kk)); acc[j] += sj * w4; }
        }
    }
#pragma unroll
    for (int j = 0; j < 5; ++j) *(LAS f32x4*)(red + (wave * 5 + j) * 256 + 4 * lane) = acc[j];
    __syncthreads();
    for (int o = tid; o < 1280; o += 512) { const int j = o >> 8, col = o & 255; float s = a.ada_b[l * 12288 + cg * 256 + col];
#pragma unroll
        for (int w = 0; w < 8; ++w) s += red[(w * 5 + j) * 256 + col];
        ((float*)(a.ws + WS_MODS))[(size_t)(l * 5 + j) * 12288 + cg * 256 + col] = s; }
    __syncthreads();
}
__device__ __forceinline__ void rope_tables(const Args& a, int gtid, int gthreads) {
    float* tab = (float*)(a.ws + WS_TAB);
    for (int i = gtid; i < 64 * 64 + 64 * 32 + 64 * 16; i += gthreads) {
        int nf, base, idx = i;
        if (idx < 64 * 64) { nf = 64; base = TAB_R; } else if (idx < 64 * 64 + 64 * 32) { idx -= 64 * 64; nf = 32; base = TAB_G; } else { idx -= 64 * 64 + 64 * 32; nf = 16; base = TAB_M; }
        const int pos = idx / nf, j = idx % nf;
        const float freq = powf(10000.0f, -(float)j / (float)nf);
        const float ang = (float)pos * freq;
        tab[base + 2 * idx] = cosf(ang); tab[base + 2 * idx + 1] = sinf(ang);
    }
    for (int col = gtid; col < 2048; col += gthreads) { const float r0 = a.hg_lb_raw[col], r1 = a.hg_lb_raw[2048 + col], r2 = a.hg_lb_raw[4096 + col], r3 = a.hg_lb_raw[6144 + col];
        const float mx = fmaxf(fmaxf(r0, r1), fmaxf(r2, r3)); const float e0 = expf(r0 - mx), e1 = expf(r1 - mx), e2 = expf(r2 - mx), e3 = expf(r3 - mx); const float sum = (e0 + e1) + (e2 + e3);
        const float p0 = e0 / sum, p1 = e1 / sum, p2 = e2 / sum, p3 = e3 / sum; tab[TAB_LB + col] = (((p0 + p1) + p2) + p3) - p0; }
}
__device__ __forceinline__ void init_rows(const Args& a, int gw, int NGW, int lane) {
    float* X = (float*)(a.ws + WS_X); bf16* H = (bf16*)(a.ws + WS_R1); const float* mods = (const float*)(a.ws + WS_MODS);
    for (int r = gw; r < MROWS; r += NGW) {
        const RowInfo q = row_info(r);
        const float* src = q.ctx ? a.ctx + ((size_t)q.b * CTXL + q.s) * DM : a.x + ((size_t)q.b * SEQ + (q.s - CTXL)) * DM;
        const float* mp = mods + (size_t)(0 * 5 + q.mi) * 12288;
#pragma unroll
        for (int j = 0; j < 8; ++j) { const int c = 4 * lane + 256 * j; const f32x4 v = *(const GAS f32x4*)(src + c);
            *(GAS f32x4*)(X + (size_t)r * DM + c) = v;
            const f32x4 sh = *(const GAS f32x4*)(mp + c), sc = *(const GAS f32x4*)(mp + 2048 + c);
            const f32x4 h = v * (1.0f + sc) + sh; u32x2v w; w.x = pk2(h[0], h[1]); w.y = pk2(h[2], h[3]);
            *(GAS u32x2v*)(H + (size_t)r * DM + c) = w; }
    }
}
__device__ __forceinline__ void ln_rows(const Args& a, int l, int which, int gw, int NGW, int lane) {
    float* X = (float*)(a.ws + WS_X); const float* Y = (const float*)(a.ws + WS_SCY); const float* YS = (const float*)(a.ws + WS_YS); bf16* H = (bf16*)(a.ws + WS_R1); const float* mods = (const float*)(a.ws + WS_MODS);
    const int nsplit = which ? 4 : 8;
    const float* lng = a.ln_g + (size_t)(l * 2 + which) * DM; const float* lnb = a.ln_b + (size_t)(l * 2 + which) * DM;
    const bool last = (l == 3 && which == 1);
    const int gate_i = which ? 5 : 2, nl = which ? l + 1 : l, nsh = which ? 0 : 3, nsc = which ? 1 : 4;
    for (int r = gw; r < MROWS; r += NGW) {
        const RowInfo q = row_info(r);
        const float* gp = mods + (size_t)(l * 5 + q.mi) * 12288 + gate_i * 2048;
        if (q.ctx && l == 3) continue;
        f32x4 z[8]; float s = 0.f;
#pragma unroll
        for (int j = 0; j < 8; ++j) { const int c = 4 * lane + 256 * j; const f32x4 xv = *(const GAS f32x4*)(X + (size_t)r * DM + c), gv = *(const GAS f32x4*)(gp + c); f32x4 yv;
            if (q.ctx) { const float* ys = YS + (size_t)(q.b * CTXL + q.s) * DM + c; yv = *(const GAS f32x4*)ys;
                for (int ks = 1; ks < nsplit; ++ks) yv += *(const GAS f32x4*)(ys + (size_t)ks * 1024 * DM); }
            else yv = *(const GAS f32x4*)(Y + (size_t)r * DM + c);
            z[j] = DN_ALPHA * xv + gv * yv; s += (z[j][0] + z[j][1]) + (z[j][2] + z[j][3]); }
        const float mean = wave_sum(s) * (1.0f / DM); float s2 = 0.f;
#pragma unroll
        for (int j = 0; j < 8; ++j) { z[j] = z[j] - mean; s2 += (z[j][0] * z[j][0] + z[j][1] * z[j][1]) + (z[j][2] * z[j][2] + z[j][3] * z[j][3]); }
        const float rstd = 1.0f / sqrtf(wave_sum(s2) * (1.0f / DM) + LN_EPS);
        const float* mp = mods + (size_t)((last ? 0 : nl) * 5 + q.mi) * 12288;
#pragma unroll
        for (int j = 0; j < 8; ++j) { const int c = 4 * lane + 256 * j; const f32x4 g4 = *(const GAS f32x4*)(lng + c), b4 = *(const GAS f32x4*)(lnb + c);
            const f32x4 xn = z[j] * rstd * g4 + b4;
            if (last) { if (!q.ctx) *(GAS f32x4*)(a.out + ((size_t)q.b * SEQ + (q.s - CTXL)) * DM + c) = xn; }
            else { *(GAS f32x4*)(X + (size_t)r * DM + c) = xn;
                const f32x4 sh = *(const GAS f32x4*)(mp + nsh * 2048 + c), sc = *(const GAS f32x4*)(mp + nsc * 2048 + c);
                const f32x4 h = xn * (1.0f + sc) + sh; u32x2v w; w.x = pk2(h[0], h[1]); w.y = pk2(h[2], h[3]);
                *(GAS u32x2v*)(H + (size_t)r * DM + c) = w; } }
    }
}
__device__ __forceinline__ void ret_rope_rows(const Args& a, int gw, int NGW, int lane) {
    bf16* P = (bf16*)(a.ws + WS_PROJ); const float* tab = (const float*)(a.ws + WS_TAB) + TAB_R;
    for (int r = gw; r < MROWS; r += NGW) {
        const RowInfo q = row_info(r);
#pragma unroll
        for (int i = 0; i < 4; ++i) { const int it = lane + 64 * i, tensor = it >> 7, head = (it >> 4) & 7, half = (it >> 3) & 1, grp = it & 7;
            bf16* p1 = P + (size_t)r * RET_N + tensor * 2048 + head * 256 + half * 128 + grp * 8; bf16* p2 = p1 + 64;
            if (q.ctx && tensor == 0) continue;
            float x1[8], x2[8]; unpack8(*(const GAS v4u*)p1, x1); unpack8(*(const GAS v4u*)p2, x2);
            const float ksc = tensor ? 0.0625f : 1.0f;
            float o1[8], o2[8];
            if (!q.ctx) { const int pos = half ? q.gc : q.gr; const float* tp = tab + (pos * 64 + grp * 8) * 2;
#pragma unroll
                for (int e = 0; e < 8; ++e) { const float cs = tp[2 * e], sn = tp[2 * e + 1]; o1[e] = (x1[e] * cs - x2[e] * sn) * ksc; o2[e] = (x1[e] * sn + x2[e] * cs) * ksc; } }
            else {
#pragma unroll
                for (int e = 0; e < 8; ++e) { o1[e] = x1[e] * ksc; o2[e] = x2[e] * ksc; } }
            *(GAS v4u*)p1 = pack8(o1); *(GAS v4u*)p2 = pack8(o2); }
    }
}
__device__ __forceinline__ void gqa_normrope_rows(const Args& a, int gw, int NGW, int lane) {
    bf16* P = (bf16*)(a.ws + WS_PROJ); const float* tab = (const float*)(a.ws + WS_TAB) + TAB_G;
    const int li = lane & 15, hsub = lane >> 4;
    const int half = li >> 3, second = (li >> 2) & 1, fj0 = (li & 3) * 8;
    for (int r = gw; r < MROWS; r += NGW) {
        const RowInfo q = row_info(r);
#pragma unroll
        for (int pass = 0; pass < 5; ++pass) { const int head = pass * 4 + hsub;
            bf16* p = P + (size_t)r * GQA_N + head * 128 + li * 8;
            const float* gain = (head < 16 ? a.gqa_qn : a.gqa_kn) + li * 8;
            float x[8]; unpack8(*(const GAS v4u*)p, x);
            float ss = 0.f;
#pragma unroll
            for (int e = 0; e < 8; ++e) ss += x[e] * x[e];
            ss += __shfl_xor(ss, 1); ss += __shfl_xor(ss, 2); ss += __shfl_xor(ss, 4); ss += __shfl_xor(ss, 8);
            const float rs = 1.0f / sqrtf(ss * (1.0f / 128.0f) + LN_EPS);
#pragma unroll
            for (int e = 0; e < 8; ++e) x[e] = x[e] * rs * gain[e];
            float o[8];
            if (!q.ctx) { const int pos = half ? q.gc : q.gr; const float* tp = tab + (pos * 32 + fj0) * 2;
#pragma unroll
                for (int e = 0; e < 8; ++e) { const float other = __shfl_xor(x[e], 4); const float cs = tp[2 * e], sn = tp[2 * e + 1];
                    o[e] = second ? (other * sn + x[e] * cs) : (x[e] * cs - other * sn); } }
            else {
#pragma unroll
                for (int e = 0; e < 8; ++e) o[e] = x[e]; }
            *(GAS v4u*)p = pack8(o); }
    }
}
__device__ __forceinline__ void mla_norm_rows(const Args& a, int gw, int NGW, int lane) {
    const bf16* C = (const bf16*)(a.ws + WS_PROJ + PJ_MLA_C); bf16* CQN = (bf16*)(a.ws + WS_PROJ + PJ_MLA_CQN); bf16* CKVN = (bf16*)(a.ws + WS_PROJ + PJ_MLA_CKVN); bf16* KR = (bf16*)(a.ws + WS_PROJ + PJ_MLA_KR);
    const float* tab = (const float*)(a.ws + WS_TAB) + TAB_M;
    for (int r = gw; r < MROWS; r += NGW) {
        const RowInfo q = row_info(r);
#pragma unroll
        for (int t = 0; t < 2; ++t) { float x[8]; unpack8(*(const GAS v4u*)(C + (size_t)r * MLA_NP + t * 512 + lane * 8), x);
            float ss = 0.f;
#pragma unroll
            for (int e = 0; e < 8; ++e) ss += x[e] * x[e];
            const float rs = 1.0f / sqrtf(wave_sum(ss) * (1.0f / 512.0f) + LN_EPS);
            const float* gain = (t ? a.mla_kvn : a.mla_qn) + lane * 8; float o[8];
#pragma unroll
            for (int e = 0; e < 8; ++e) o[e] = x[e] * rs * gain[e];
            *(GAS v4u*)((t ? CKVN : CQN) + (size_t)r * 512 + lane * 8) = pack8(o); }
        { const float xv = bf2f(C[(size_t)r * MLA_NP + 1024 + lane]); const float other = __shfl_xor(xv, 16);
          float ov = xv;
          if (!q.ctx) { const int half = lane >> 5, second = (lane >> 4) & 1, fj = lane & 15; const int pos = half ? q.gc : q.gr; const float cs = tab[(pos * 16 + fj) * 2], sn = tab[(pos * 16 + fj) * 2 + 1];
              ov = second ? (other * sn + xv * cs) : (xv * cs - other * sn); }
          KR[(size_t)r * 64 + lane] = (bf16)f2bf(ov); }
    }
}
__device__ __forceinline__ void mla_qrope_rows(const Args& a, int gw, int NGW, int lane) {
    bf16* Q = (bf16*)(a.ws + WS_PROJ + PJ_MLA_Q); const float* tab = (const float*)(a.ws + WS_TAB) + TAB_M;
    const int li = lane & 7, hsub = lane >> 3;
    const int half = li >> 2, second = (li >> 1) & 1, fj0 = (li & 1) * 8;
    for (int r = gw; r < MROWS; r += NGW) {
        const RowInfo q = row_info(r);
        if (q.ctx) continue;
#pragma unroll
        for (int pass = 0; pass < 2; ++pass) { const int head = pass * 8 + hsub;
            bf16* p = Q + (size_t)r * MLA_QN + head * 192 + 128 + li * 8;
            float x[8]; unpack8(*(const GAS v4u*)p, x);
            const int pos = half ? q.gc : q.gr; const float* tp = tab + (pos * 16 + fj0) * 2; float o[8];
#pragma unroll
            for (int e = 0; e < 8; ++e) { const float other = __shfl_xor(x[e], 2); const float cs = tp[2 * e], sn = tp[2 * e + 1];
                o[e] = second ? (other * sn + x[e] * cs) : (x[e] * cs - other * sn); }
            *(GAS v4u*)p = pack8(o); }
    }
}
__device__ __forceinline__ void ret_readout_rows(const Args& a, int gw, int NGW, int lane) {
    const bf16* SO = (const bf16*)(a.ws + WS_SCY); const bf16* P = (const bf16*)(a.ws + WS_PROJ); bf16* A2 = (bf16*)(a.ws + WS_R1);
    for (int r = gw; r < MROWS; r += NGW) {
#pragma unroll
        for (int h = 0; h < 8; ++h) { const int c = h * 512 + lane * 8;
            float f[8], b[8], g[8]; unpack8(*(const GAS v4u*)(SO + (size_t)r * 4096 + c), f); unpack8(*(const GAS v4u*)(SO + ((size_t)MROWS + r) * 4096 + c), b);
            unpack8(*(const GAS v4u*)(P + (size_t)r * RET_N + 8192 + c), g);
            float ss = 0.f;
#pragma unroll
            for (int e = 0; e < 8; ++e) { f[e] += b[e]; ss += f[e] * f[e]; }
            const float rs = 1.0f / sqrtf(wave_sum(ss) * (1.0f / 512.0f) + LN_EPS); float o[8];
#pragma unroll
            for (int e = 0; e < 8; ++e) o[e] = f[e] * rs * silu_f(g[e]);
            *(GAS v4u*)(A2 + (size_t)r * 4096 + c) = pack8(o); }
    }
}
__device__ __forceinline__ void hg_readout_rows(const Args& a, int gw, int NGW, int lane) {
    const bf16* SO = (const bf16*)(a.ws + WS_SCY); const bf16* P = (const bf16*)(a.ws + WS_PROJ); bf16* A2 = (bf16*)(a.ws + WS_R1);
    const int li = lane & 15;
    for (int r = gw; r < MROWS; r += NGW) {
#pragma unroll
        for (int pass = 0; pass < 4; ++pass) { const int c = pass * 512 + lane * 8;
            float f[8], b[8], g[8]; unpack8(*(const GAS v4u*)(SO + (size_t)r * 2048 + c), f); unpack8(*(const GAS v4u*)(SO + ((size_t)MROWS + r) * 2048 + c), b);
            unpack8(*(const GAS v4u*)(P + (size_t)r * HG_N + 8192 + c), g);
            float ss = 0.f;
#pragma unroll
            for (int e = 0; e < 8; ++e) { f[e] += b[e]; ss += f[e] * f[e]; }
            ss += __shfl_xor(ss, 1); ss += __shfl_xor(ss, 2); ss += __shfl_xor(ss, 4); ss += __shfl_xor(ss, 8);
            const float rs = 1.0f / sqrtf(ss * (1.0f / 128.0f) + LN_EPS); const float* gain = a.hg_on + li * 8; float o[8];
#pragma unroll
            for (int e = 0; e < 8; ++e) o[e] = f[e] * rs * gain[e] * silu_f(g[e]);
            *(GAS v4u*)(A2 + (size_t)r * 2048 + c) = pack8(o); }
    }
}
__device__ __forceinline__ void hg_prep_rows(const Args& a, int gw, int NGW, int lane) {
    bf16* P = (bf16*)(a.ws + WS_PROJ); const float* lbt = (const float*)(a.ws + WS_TAB) + TAB_LB;
    for (int r = gw; r < MROWS; r += NGW) {
#pragma unroll
        for (int pass = 0; pass < 12; ++pass) { const int c = pass * 512 + lane * 8;
            bf16* p = P + (size_t)r * HG_N + c; float x[8], o[8]; unpack8(*(const GAS v4u*)p, x);
            if (pass < 4) {
#pragma unroll
                for (int e = 0; e < 8; ++e) o[e] = silu_f(x[e]); }
            else { const float* lb = lbt + (c & 2047);
#pragma unroll
                for (int e = 0; e < 8; ++e) o[e] = (1.0f - lb[e]) / (1.0f + __expf(x[e])); }
            *(GAS v4u*)p = pack8(o); }
    }
}
__device__ __forceinline__ int scan_row(int p, int dir) { return dir ? (p < CTXL ? CTXL - 1 - p : SROWS + CTXL - 1 - p) : p; }
__device__ __forceinline__ void ret_scan_simple(const Args& a, LAS unsigned char* lds, int tid) {
    const bf16* P = (const bf16*)(a.ws + WS_PROJ); bf16* SO = (bf16*)(a.ws + WS_SCY);
    LAS float* qs = (LAS float*)lds; LAS float* ks = qs + 16 * 256; LAS float* vsm = ks + 16 * 256; LAS float* op = vsm + 16 * 128;
    const int dv = tid & 127, g = tid >> 7;
    for (int u = blockIdx.x; u < 256; u += gridDim.x) {
        const int b = u >> 6, h = (u >> 3) & 7, dir = (u >> 2) & 1, vs = u & 3;
        const float gamma = expf((dir ? a.ret_db : a.ret_df)[h]);
        float S[64];
#pragma unroll
        for (int j = 0; j < 64; ++j) S[j] = 0.f;
        for (int p0 = 0; p0 < SROWS; p0 += 16) {
            { const int pp = tid >> 5, ch = tid & 31; const size_t row = (size_t)b * SROWS + scan_row(p0 + pp, dir);
              float f[8]; unpack8(*(const GAS v4u*)(P + row * RET_N + h * 256 + ch * 8), f);
              *(LAS f32x4*)(qs + pp * 256 + ch * 8) = (f32x4){f[0], f[1], f[2], f[3]}; *(LAS f32x4*)(qs + pp * 256 + ch * 8 + 4) = (f32x4){f[4], f[5], f[6], f[7]};
              unpack8(*(const GAS v4u*)(P + row * RET_N + 2048 + h * 256 + ch * 8), f);
              *(LAS f32x4*)(ks + pp * 256 + ch * 8) = (f32x4){f[0], f[1], f[2], f[3]}; *(LAS f32x4*)(ks + pp * 256 + ch * 8 + 4) = (f32x4){f[4], f[5], f[6], f[7]};
              const u32x2v w = *(const GAS u32x2v*)(P + row * RET_N + 4096 + h * 512 + vs * 128 + ch * 4);
              *(LAS f32x4*)(vsm + pp * 128 + ch * 4) = (f32x4){bflo(w.x), bfhi(w.x), bflo(w.y), bfhi(w.y)}; }
            __syncthreads();
            for (int pp = 0; pp < 16; ++pp) {
                const float vv = vsm[pp * 128 + dv]; float acc = 0.f;
#pragma unroll
                for (int j4 = 0; j4 < 16; ++j4) { const f32x4 k4 = *(const LAS f32x4*)(ks + pp * 256 + 64 * g + 4 * j4), q4 = *(const LAS f32x4*)(qs + pp * 256 + 64 * g + 4 * j4);
#pragma unroll
                    for (int e = 0; e < 4; ++e) { S[4 * j4 + e] = fmaf(gamma, S[4 * j4 + e], k4[e] * vv); acc = fmaf(q4[e], S[4 * j4 + e], acc); } }
                op[(pp * 4 + g) * 128 + dv] = acc;
            }
            __syncthreads();
#pragma unroll
            for (int i = 0; i < 4; ++i) { const int idx = tid + 512 * i, pp = idx >> 7, d = idx & 127;
                const float o = (op[(pp * 4 + 0) * 128 + d] + op[(pp * 4 + 1) * 128 + d]) + (op[(pp * 4 + 2) * 128 + d] + op[(pp * 4 + 3) * 128 + d]);
                const size_t row = (size_t)b * SROWS + scan_row(p0 + pp, dir);
                SO[((size_t)dir * MROWS + row) * 4096 + h * 512 + vs * 128 + d] = (bf16)f2bf(o); }
        }
        __syncthreads();
    }
}
__device__ __forceinline__ void hg_scan_simple(const Args& a, LAS unsigned char* lds, int tid) {
    const bf16* P = (const bf16*)(a.ws + WS_PROJ); bf16* SO = (bf16*)(a.ws + WS_SCY);
    LAS float* qs = (LAS float*)lds; LAS float* fs = qs + 16 * 128; LAS float* kk = fs + 16 * 128; LAS float* is = kk + 16 * 128; LAS float* op = is + 16 * 64; LAS float* lbs = op + 16 * 8 * 64;
    const int dv = tid & 63, g8 = tid >> 6;
    for (int u = blockIdx.x; u < 256; u += gridDim.x) {
        const int b = u >> 6, h = (u >> 2) & 15, dir = (u >> 1) & 1, vs = u & 1;
        if (tid < 128) { const int col = h * 128 + tid; const float r0 = a.hg_lb_raw[col], r1 = a.hg_lb_raw[2048 + col], r2 = a.hg_lb_raw[4096 + col], r3 = a.hg_lb_raw[6144 + col];
            const float mx = fmaxf(fmaxf(r0, r1), fmaxf(r2, r3)); const float e0 = expf(r0 - mx), e1 = expf(r1 - mx), e2 = expf(r2 - mx), e3 = expf(r3 - mx); const float sum = (e0 + e1) + (e2 + e3);
            const float p0 = e0 / sum, p1 = e1 / sum, p2 = e2 / sum, p3 = e3 / sum; lbs[tid] = (((p0 + p1) + p2) + p3) - p0; }
        __syncthreads();
        float S[16];
#pragma unroll
        for (int j = 0; j < 16; ++j) S[j] = 0.f;
        for (int p0 = 0; p0 < SROWS; p0 += 16) {
            { const int pp = tid >> 5, ch = tid & 31; const size_t row = (size_t)b * SROWS + scan_row(p0 + pp, dir);
              const u32x2v wq = *(const GAS u32x2v*)(P + row * HG_N + h * 128 + ch * 4), wf = *(const GAS u32x2v*)(P + row * HG_N + (dir ? 4096 : 2048) + h * 128 + ch * 4);
              const float qv[4] = {bflo(wq.x), bfhi(wq.x), bflo(wq.y), bfhi(wq.y)}, fv[4] = {bflo(wf.x), bfhi(wf.x), bflo(wf.y), bfhi(wf.y)};
              f32x4 qo, fo, ko;
#pragma unroll
              for (int e = 0; e < 4; ++e) { const float lb = lbs[ch * 4 + e]; const float f = lb + (1.0f - lb) * sigmoid_f(fv[e]); qo[e] = silu_f(qv[e]); fo[e] = f; ko[e] = 1.0f - f; }
              *(LAS f32x4*)(qs + pp * 128 + ch * 4) = qo; *(LAS f32x4*)(fs + pp * 128 + ch * 4) = fo; *(LAS f32x4*)(kk + pp * 128 + ch * 4) = ko;
              const unsigned wi = *(const GAS unsigned*)(P + row * HG_N + 6144 + h * 128 + vs * 64 + ch * 2);
              *(LAS f32x2v*)(is + pp * 64 + ch * 2) = (f32x2v){bflo(wi), bfhi(wi)}; }
            __syncthreads();
            for (int pp = 0; pp < 16; ++pp) {
                const float iv = is[pp * 64 + dv]; float acc = 0.f;
#pragma unroll
                for (int j4 = 0; j4 < 4; ++j4) { const f32x4 f4 = *(const LAS f32x4*)(fs + pp * 128 + 16 * g8 + 4 * j4), k4 = *(const LAS f32x4*)(kk + pp * 128 + 16 * g8 + 4 * j4), q4 = *(const LAS f32x4*)(qs + pp * 128 + 16 * g8 + 4 * j4);
#pragma unroll
                    for (int e = 0; e < 4; ++e) { S[4 * j4 + e] = fmaf(f4[e], S[4 * j4 + e], k4[e] * iv); acc = fmaf(q4[e], S[4 * j4 + e], acc); } }
                op[(pp * 8 + g8) * 64 + dv] = acc;
            }
            __syncthreads();
#pragma unroll
            for (int i = 0; i < 2; ++i) { const int idx = tid + 512 * i, pp = idx >> 6, d = idx & 63; float o = 0.f;
#pragma unroll
                for (int w = 0; w < 8; ++w) o += op[(pp * 8 + w) * 64 + d];
                const size_t row = (size_t)b * SROWS + scan_row(p0 + pp, dir);
                SO[((size_t)dir * MROWS + row) * 2048 + h * 128 + vs * 64 + d] = (bf16)f2bf(o); }
        }
        __syncthreads();
    }
}
constexpr int NPH = 2 + 11 * 4;
#define IN(k) (lo <= (k) && (k) < hi)
#define SEAM(k) do { if (a.use_bar && hi > (k) + 1) xcd_barrier(bar); } while (0)
template <int l> __device__ __forceinline__ void run_layer(const Args& a, LAS unsigned char* lds, const XcdBarrier& bar, int tid, int lane, int wave, int G, int gw, int NGW) {
    const int lo = a.ph_lo, hi = a.ph_hi; unsigned char* ws = a.ws;
    bf16* const H = (bf16*)(ws + WS_R1); bf16* const PROJ = (bf16*)(ws + WS_PROJ); float* const Y = (float*)(ws + WS_SCY);
        const int pb = 2 + 11 * l;
        if (IN(pb)) {
            const bf16* Bt; int N; bf16* O;
            if (l == 0) { Bt = (const bf16*)(ws + WS_W_RET_IN); N = RET_N; O = PROJ; }
            else if (l == 1) { Bt = (const bf16*)(ws + WS_W_GQA_IN); N = GQA_N; O = PROJ; }
            else if (l == 2) { Bt = (const bf16*)(ws + WS_W_MLA_IN); N = MLA_NP; O = (bf16*)(ws + WS_PROJ + PJ_MLA_C); }
            else { Bt = (const bf16*)(ws + WS_W_HG_IN); N = HG_N; O = PROJ; }
            pg8::Gemm g{H, Bt, MROWS, N, DM}; pg8::StaticOrder S; S.init(MROWS, N, DM, G, (int)blockIdx.x); pg8::EpiBf16P E{O, N};
            pg8::gemm_phase<pg8::EpiBf16P, pg8::StaticOrder, true, true>(lds, g, S, E);
            SEAM(pb);
        }
        if (IN(pb + 1)) {
            if (l == 0) ret_rope_rows(a, gw, NGW, lane); else if (l == 1) gqa_normrope_rows(a, gw, NGW, lane); else if (l == 2) mla_norm_rows(a, gw, NGW, lane); else hg_prep_rows(a, gw, NGW, lane);
            SEAM(pb + 1);
        }
        if (IN(pb + 2) && l == 2) {
            { pg8::Gemm g{(const bf16*)(ws + WS_PROJ + PJ_MLA_CQN), (const bf16*)(ws + WS_W_MLA_QUP), MROWS, MLA_QN, 512}; pg8::StaticOrder S; S.init(MROWS, MLA_QN, 512, G, (int)blockIdx.x);
              pg8::EpiBf16P E{(bf16*)(ws + WS_PROJ + PJ_MLA_Q), MLA_QN}; pg8::gemm_phase<pg8::EpiBf16P, pg8::StaticOrder, true, true>(lds, g, S, E); }
            { pg8::Gemm g{(const bf16*)(ws + WS_PROJ + PJ_MLA_CKVN), (const bf16*)(ws + WS_W_MLA_KVUP), MROWS, MLA_KVN, 512}; pg8::StaticOrder S; S.init(MROWS, MLA_KVN, 512, G, (int)blockIdx.x);
              pg8::EpiBf16P E{(bf16*)(ws + WS_PROJ + PJ_MLA_KV), MLA_KVN}; pg8::gemm_phase<pg8::EpiBf16P, pg8::StaticOrder, true, true>(lds, g, S, E); }
            SEAM(pb + 2);
        }
        if (IN(pb + 3) && l == 2) { mla_qrope_rows(a, gw, NGW, lane); SEAM(pb + 3); }
        if (IN(pb + 4)) {
            if (l == 0) scan::ret_scan_mfma((const bf16*)(ws + WS_PROJ), (bf16*)(ws + WS_SCY), a.ret_df, a.ret_db, lds, tid);
            else if (l == 3) scan::hg_scan_mfma((const bf16*)(ws + WS_PROJ), (bf16*)(ws + WS_SCY), lds, tid);
            else {
                bf16* const A2 = (bf16*)(ws + WS_R1);
                for (int uidx = blockIdx.x; uidx < 1088; uidx += G) {
                    int b, h, qb, ctxu = 0;
                    if (uidx < 1024) { const int x = uidx & 7, y = (uidx >> 3) & 31, rnd = uidx >> 8;
                        if (l == 1) { const int combo = 2 * x + (y >> 4), w = (y & 15) + 16 * rnd; b = combo >> 2; h = (combo & 3) * 4 + (w >> 4); qb = w & 15; }
                        else { const int combo = 2 * x + (y >> 4) + 16 * rnd; b = combo >> 4; h = combo & 15; qb = y & 15; } }
                    else { const int c = uidx - 1024; b = c >> 4; h = c & 15; qb = 0; ctxu = 1; }
                    const size_t rb = (size_t)b * SROWS, r0 = rb + (ctxu ? 0 : CTXL + qb * 256); const int seq = ctxu ? CTXL : SROWS;
                    if (l == 1) { const bf16* QKV = PROJ; const int kvh = h >> 2;
                        att::attn_unit<8, 8, 2, GQA_N, GQA_N, GQA_N, GQA_N, DM>(QKV + r0 * GQA_N + h * 128, QKV + rb * GQA_N + 2048 + kvh * 128, QKV + rb * GQA_N + 2048 + kvh * 128,
                                             QKV + rb * GQA_N + 2560 + kvh * 128, A2 + r0 * DM + h * 128, seq, 0.08838834764831845f * 1.4426950408889634f, 8.0f / 0.08838834764831845f, (ATT_LAS char*)lds); }
                    else { const bf16* Q = (const bf16*)(ws + WS_PROJ + PJ_MLA_Q); const bf16* KV = (const bf16*)(ws + WS_PROJ + PJ_MLA_KV); const bf16* KR = (const bf16*)(ws + WS_PROJ + PJ_MLA_KR);
                        att::attn_unit<12, 4, 1, MLA_QN, MLA_KVN, 64, MLA_KVN, DM>(Q + r0 * MLA_QN + h * 192, KV + rb * MLA_KVN + h * 256, KR + rb * 64,
                                              KV + rb * MLA_KVN + h * 256 + 128, A2 + r0 * DM + h * 128, seq, 0.07216878364870323f * 1.4426950408889634f, 8.0f / 0.07216878364870323f, (ATT_LAS char*)lds); }
                }
            }
            SEAM(pb + 4);
        }
        if (IN(pb + 5) && (l == 0 || l == 3)) { if (l == 0) ret_readout_rows(a, gw, NGW, lane); else hg_readout_rows(a, gw, NGW, lane); SEAM(pb + 5); }
        if (IN(pb + 6)) {
            const bf16* Bt = (const bf16*)(ws + (l == 0 ? WS_W_RET_OUT : l == 1 ? WS_W_GQA_OUT : l == 2 ? WS_W_MLA_OUT : WS_W_HG_OUT)); const int K = (l == 0) ? 4096 : DM;
            const int nsplit = (l == 3) ? 0 : 8;
            pg8::Gemm g{(const bf16*)(ws + WS_R1), Bt, MROWS, DM, K}; pg8::LatCtxOrder S; S.init(K, G, (int)blockIdx.x, nsplit); pg8::EpiF32P E{Y, DM, (float*)(ws + WS_YS), nsplit};
            pg8::gemm_phase<pg8::EpiF32P, pg8::LatCtxOrder, true, true>(lds, g, S, E);
            SEAM(pb + 6);
        }
        if (IN(pb + 7)) { ln_rows(a, l, 0, gw, NGW, lane); SEAM(pb + 7); }
        if (IN(pb + 8)) {
            pg8::Gemm g{H, (const bf16*)(ws + WS_W_FFN_IN + l * FFN_IN_BYTES), MROWS, 2 * FFH, DM}; pg8::StaticOrder S; S.init(MROWS, 2 * FFH, DM, G, (int)blockIdx.x); pg8::EpiSwiglu E{PROJ, FFH};
            pg8::gemm_phase<pg8::EpiSwiglu, pg8::StaticOrder, true, true>(lds, g, S, E);
            SEAM(pb + 8);
        }
        if (IN(pb + 9)) {
            const int nsplit = (l == 3) ? 0 : 4;
            pg8::Gemm g{PROJ, (const bf16*)(ws + WS_W_FFN_OUT + l * FFN_OUT_BYTES), MROWS, DM, FFH}; pg8::LatCtxOrder S; S.init(FFH, G, (int)blockIdx.x, nsplit); pg8::EpiF32P E{Y, DM, (float*)(ws + WS_YS), nsplit};
            pg8::gemm_phase<pg8::EpiF32P, pg8::LatCtxOrder, true, true>(lds, g, S, E);
            SEAM(pb + 9);
        }
        if (IN(pb + 10)) { ln_rows(a, l, 1, gw, NGW, lane); SEAM(pb + 10); }
    }
__global__ void __launch_bounds__(NWAVES * 64, 2) mk_fwd(Args a) {
    extern __shared__ __attribute__((aligned(16))) unsigned char lds_raw[];
    LAS unsigned char* lds = (LAS unsigned char*)lds_raw;
    const int tid = threadIdx.x, lane = tid & 63, wave = __builtin_amdgcn_readfirstlane(tid >> 6);
    const int G = gridDim.x, gw = blockIdx.x * NWAVES + wave, NGW = G * NWAVES;
    volatile LAS unsigned* MISC = (volatile LAS unsigned*)(lds + MISC_OFF);
    if (tid < 128) ((LAS unsigned*)(lds + MISC_OFF))[tid] = 0u;
    __syncthreads();
    gu32* ctl = (gu32*)(a.ws + WS_CTL);
    XcdBarrier bar; bar.bar = (unsigned*)ctl + CW_BAR; bar.x = 0; bar.st = nullptr;
    if (a.use_bar) bar = xcd_barrier_post((unsigned*)ctl + CW_BAR, MISC + 8);
    const int lo = a.ph_lo, hi = a.ph_hi;
    unsigned char* ws = a.ws;
    bf16* const H = (bf16*)(ws + WS_R1); bf16* const PROJ = (bf16*)(ws + WS_PROJ); float* const Y = (float*)(ws + WS_SCY);

    if (IN(0)) {
        LAS float* scr = (LAS float*)(lds + wave * 16384);
        constexpr int I_RI = 32 * (RET_N / 32), I_RO = 64 * 64, I_GI = 32 * (GQA_N / 32), I_GO = 32 * 64, I_MI = 32 * (MLA_NP / 32), I_MQ = 8 * (MLA_QN / 32), I_MK = 8 * (MLA_KVN / 32), I_MO = 32 * 64,
                      I_HI = 32 * (HG_N / 32), I_HO = 32 * 64, I_FI = 32 * (2 * FFH / 32), I_FO = (FFH / 64) * 64;
        constexpr int NITEMS = I_RI + I_RO + I_GI + I_GO + I_MI + I_MQ + I_MK + I_MO + I_HI + I_HO + 4 * I_FI + 4 * I_FO;
        for (int it = gw; it < NITEMS; it += NGW) {
            int r = it;
            if (r < I_RI) { transpose_w<0>(a.ret_w_in, DM, RET_N, RET_N, (bf16*)(ws + WS_W_RET_IN), r, scr, lane); continue; } r -= I_RI;
            if (r < I_RO) { transpose_w<0>(a.ret_w_out, 4096, DM, DM, (bf16*)(ws + WS_W_RET_OUT), r, scr, lane); continue; } r -= I_RO;
            if (r < I_GI) { transpose_w<0>(a.gqa_w_in, DM, GQA_N, GQA_N, (bf16*)(ws + WS_W_GQA_IN), r, scr, lane); continue; } r -= I_GI;
            if (r < I_GO) { transpose_w<0>(a.gqa_w_out, DM, DM, DM, (bf16*)(ws + WS_W_GQA_OUT), r, scr, lane); continue; } r -= I_GO;
            if (r < I_MI) { transpose_w<2>(a.mla_w_in, DM, MLA_NACT, MLA_NP, (bf16*)(ws + WS_W_MLA_IN), r, scr, lane); continue; } r -= I_MI;
            if (r < I_MQ) { transpose_w<0>(a.mla_w_qup, 512, MLA_QN, MLA_QN, (bf16*)(ws + WS_W_MLA_QUP), r, scr, lane); continue; } r -= I_MQ;
            if (r < I_MK) { transpose_w<0>(a.mla_w_kvup, 512, MLA_KVN, MLA_KVN, (bf16*)(ws + WS_W_MLA_KVUP), r, scr, lane); continue; } r -= I_MK;
            if (r < I_MO) { transpose_w<0>(a.mla_w_out, DM, DM, DM, (bf16*)(ws + WS_W_MLA_OUT), r, scr, lane); continue; } r -= I_MO;
            if (r < I_HI) { transpose_w<0>(a.hg_w_in, DM, HG_N, HG_N, (bf16*)(ws + WS_W_HG_IN), r, scr, lane); continue; } r -= I_HI;
            if (r < I_HO) { transpose_w<0>(a.hg_w_out, DM, DM, DM, (bf16*)(ws + WS_W_HG_OUT), r, scr, lane); continue; } r -= I_HO;
            if (r < 4 * I_FI) { const int l = r / I_FI; transpose_w<1>(a.ffn_w_in + (size_t)l * DM * 2 * FFH, DM, 2 * FFH, 2 * FFH, (bf16*)(ws + WS_W_FFN_IN + l * FFN_IN_BYTES), r % I_FI, scr, lane); continue; } r -= 4 * I_FI;
            { const int l = r / I_FO; transpose_w<0>(a.ffn_w_out + (size_t)l * FFH * DM, FFH, DM, DM, (bf16*)(ws + WS_W_FFN_OUT + l * FFN_OUT_BYTES), r % I_FO, scr, lane); }
        }
        __syncthreads();
        for (int u = blockIdx.x; u < 192; u += G) mods_unit(a, u / 48, u % 48, (LAS float*)lds, tid, lane, wave);
        rope_tables(a, blockIdx.x * (NWAVES * 64) + tid, G * NWAVES * 64);
        SEAM(0);
    }
    if (IN(1)) { init_rows(a, gw, NGW, lane); SEAM(1); }

    run_layer<0>(a, lds, bar, tid, lane, wave, G, gw, NGW);
    run_layer<1>(a, lds, bar, tid, lane, wave, G, gw, NGW);
    run_layer<2>(a, lds, bar, tid, lane, wave, G, gw, NGW);
    run_layer<3>(a, lds, bar, tid, lane, wave, G, gw, NGW);
}

#ifndef MK_PER_PHASE
#define MK_PER_PHASE 0
#endif
extern "C" void kernel_launch(void* const* d_in, const int* in_sizes, int n_in, void* d_out, int out_size, void* d_ws, size_t ws_size, hipStream_t stream) {
    static int grid = 0;
    if (grid == 0) {
        if (n_in != 28 || out_size != NBATCH * SEQ * DM || ws_size < WS_END) { fprintf(stderr, "kernel_launch: unexpected shapes (n_in %d out %d ws %zu)\n", n_in, out_size, ws_size); grid = -1; return; }
        int dev = 0, cus = 0, per_cu = 0;
        if (hipGetDevice(&dev) != hipSuccess || hipDeviceGetAttribute(&cus, hipDeviceAttributeMultiprocessorCount, dev) != hipSuccess) { grid = -1; return; }
        if (hipFuncSetAttribute((const void*)mk_fwd, hipFuncAttributeMaxDynamicSharedMemorySize, LDS_BYTES) != hipSuccess) { fprintf(stderr, "kernel_launch: hipFuncSetAttribute failed\n"); grid = -1; return; }
        if (hipOccupancyMaxActiveBlocksPerMultiprocessor(&per_cu, (const void*)mk_fwd, NWAVES * 64, LDS_BYTES) != hipSuccess || per_cu < 1) { fprintf(stderr, "kernel_launch: occupancy query says %d\n", per_cu); }
        (void)hipGetLastError();
        grid = cus;
    }
    if (grid < 0) return;
    if (hipMemsetAsync((char*)d_ws + WS_CTL, 0, CTL_ZERO_BYTES, stream) != hipSuccess) return;
    Args a{};
    const float** ap = (const float**)&a;
    for (int i = 0; i < 28; ++i) ap[i] = (const float*)d_in[i];
    a.out = (float*)d_out; a.ws = (unsigned char*)d_ws; a.pad = 0;
#if MK_PER_PHASE
    for (int p = 0; p < NPH; ++p) { a.ph_lo = p; a.ph_hi = p + 1; a.use_bar = 0; hipLaunchKernelGGL(mk_fwd, dim3(grid), dim3(NWAVES * 64), LDS_BYTES, stream, a); }
#else
    a.ph_lo = 0; a.ph_hi = NPH; a.use_bar = 1;
    hipLaunchKernelGGL(mk_fwd, dim3(grid), dim3(NWAVES * 64), LDS_BYTES, stream, a);
#endif
    const hipError_t le = hipPeekAtLastError();
    if (le != hipSuccess) fprintf(stderr, "kernel_launch: launch failed: %s\n", hipGetErrorName(le));
}
```
